# Optimizing an MI355X kernel written in HIP

```python
import jax, jax.numpy as jnp
from jax import lax
import numpy as np

D_MODEL = 1024
BATCH = 4
SEQ = 4096
DEPTH = 1

D_MIX = 2 * D_MODEL
D_SSD = D_MIX // 2
SSD_HEAD_DIM = 64
SSD_HEADS = D_SSD // SSD_HEAD_DIM
SSD_GROUPS = 4
SSD_STATE = 128
SSD_CONV = 4
SSD_CHUNK = 128
D_POOL = D_MIX - D_SSD
POOL_WINDOWS = (2, 4, 8, 16)
POOL_GROUPS = len(POOL_WINDOWS)
POOL_GROUP_DIM = D_POOL // POOL_GROUPS
D_XBC = D_SSD + 2 * SSD_GROUPS * SSD_STATE
D_IN_PROJ = D_SSD + D_XBC + SSD_HEADS + D_POOL
D_FF = 2816
N_MOD = 9
FFN_RES = 0.5
EPS = 1e-6

kernel_name = "hybrid_ssd_pool_macaron_adaln"


def rms_norm(x, w):
    xf = x.astype(jnp.float32)
    y = xf * lax.rsqrt(jnp.mean(xf * xf, axis=-1, keepdims=True) + EPS)
    return (y * w.astype(jnp.float32)).astype(x.dtype)


def modulate(h, shift, scale):
    return h * (1 + scale[:, None, :]) + shift[:, None, :]


def swiglu(h, w_gate, w_up, w_down):
    return (jax.nn.silu(h @ w_gate) * (h @ w_up)) @ w_down


def causal_depthwise_conv(u, w, b):
    ch = u.shape[-1]
    y = lax.conv_general_dilated(
        u, w[:, None, :].astype(u.dtype), window_strides=(1,),
        padding=[(SSD_CONV - 1, 0)], dimension_numbers=('NWC', 'WIO', 'NWC'),
        feature_group_count=ch)
    return y + b.astype(u.dtype)


def ssd_chunked(xh, dt, a, bm, cm):
    bsz, L, H, P = xh.shape
    G, N = bm.shape[2], bm.shape[3]
    R = H // G
    Q = SSD_CHUNK
    NC = L // Q
    xdt = (xh * dt[..., None]).reshape(bsz, NC, Q, G, R, P)
    adt = jnp.transpose((dt * a).reshape(bsz, NC, Q, G, R), (0, 3, 4, 1, 2))
    a_cs = jnp.cumsum(adt, axis=-1)
    bc = bm.reshape(bsz, NC, Q, G, N)
    cc = cm.reshape(bsz, NC, Q, G, N)
    causal = jnp.tril(jnp.ones((Q, Q), dtype=bool))
    seg = a_cs[..., :, None] - a_cs[..., None, :]
    decay = jnp.exp(jnp.where(causal, seg, -jnp.inf))
    cb = jnp.einsum('bclgn,bcsgn->bgcls', cc, bc)
    scores = cb[:, :, None] * decay
    y_diag = jnp.einsum('bgrcls,bcsgrp->bclgrp', scores, xdt)
    ds = jnp.transpose(jnp.exp(a_cs[..., -1:] - a_cs), (0, 3, 4, 1, 2))
    states = jnp.einsum('bcsgn,bcsgrp->bcgrpn', bc, xdt * ds[..., None])
    chunk_decay = jnp.moveaxis(jnp.exp(a_cs[..., -1]), -1, 0)

    def step(h, inp):
        s, d = inp
        return h * d[..., None, None] + s, h

    h0 = jnp.zeros((bsz, G, R, P, N), states.dtype)
    _, prev = lax.scan(step, h0, (jnp.moveaxis(states, 1, 0), chunk_decay))
    prev = jnp.moveaxis(prev, 0, 1)
    sd = jnp.transpose(jnp.exp(a_cs), (0, 3, 4, 1, 2))
    y_off = jnp.einsum('bclgn,bcgrpn->bclgrp', cc, prev) * sd[..., None]
    return (y_diag + y_off).reshape(bsz, L, H, P)


def pool_mixer(u, pool_w, pool_b, pool_scale):
    bsz, L, _ = u.shape
    uf = u.astype(jnp.float32).reshape(bsz, L, POOL_GROUPS, POOL_GROUP_DIM)
    cs = jnp.cumsum(uf, axis=1)
    pos = jnp.arange(1, L + 1, dtype=jnp.float32)
    pooled = []
    for gi, w in enumerate(POOL_WINDOWS):
        shifted = jnp.pad(cs[:, :L - w, gi], ((0, 0), (w, 0), (0, 0)))
        cnt = jnp.minimum(pos, float(w))[None, :, None]
        pooled.append((cs[:, :, gi] - shifted) / cnt)
    diff = jnp.stack(pooled, axis=2) - uf
    out = jnp.einsum('blgc,gcd->blgd', diff, pool_w.astype(jnp.float32)) + pool_b.astype(jnp.float32)
    out = out.reshape(bsz, L, D_POOL) * pool_scale.astype(jnp.float32)
    return out.astype(u.dtype)


def token_mixer(h, w_in, conv_w, conv_b, dt_bias, a_log, d_skip, ssd_norm_w,
                pool_w, pool_b, pool_scale, w_out):
    bsz, L, _ = h.shape
    f32 = jnp.float32
    proj = h @ w_in
    z, xbc, dt_raw, u = jnp.split(
        proj, [D_SSD, D_SSD + D_XBC, D_SSD + D_XBC + SSD_HEADS], axis=-1)
    xbc = jax.nn.silu(causal_depthwise_conv(xbc, conv_w, conv_b))
    xs, bm, cm = jnp.split(xbc, [D_SSD, D_SSD + SSD_GROUPS * SSD_STATE], axis=-1)
    dt = jax.nn.softplus(dt_raw.astype(f32) + dt_bias.astype(f32))
    a = -jnp.exp(a_log.astype(f32))
    xh = xs.astype(f32).reshape(bsz, L, SSD_HEADS, SSD_HEAD_DIM)
    y = ssd_chunked(xh, dt, a,
                    bm.astype(f32).reshape(bsz, L, SSD_GROUPS, SSD_STATE),
                    cm.astype(f32).reshape(bsz, L, SSD_GROUPS, SSD_STATE))
    y = (y + d_skip.astype(f32)[:, None] * xh).reshape(bsz, L, D_SSD)
    yg = (y * jax.nn.silu(z.astype(f32))).reshape(bsz, L, SSD_GROUPS, D_SSD // SSD_GROUPS)
    yg = yg * lax.rsqrt(jnp.mean(yg * yg, axis=-1, keepdims=True) + EPS)
    y_ssd = (yg.reshape(bsz, L, D_SSD) * ssd_norm_w.astype(f32)).astype(h.dtype)
    y_pool = pool_mixer(u, pool_w, pool_b, pool_scale)
    return jnp.concatenate([y_ssd, y_pool], axis=-1) @ w_out


def setup_inputs(seed: int = 0) -> dict:
    key = jax.random.key(seed)
    ks = jax.random.split(key, 32)
    f32 = jnp.float32

    def normal(k, shape, scale):
        return jax.random.normal(k, shape, f32) * scale

    dt0 = jnp.exp(jax.random.uniform(ks[9], (DEPTH, SSD_HEADS), f32,
                                     minval=np.log(1e-3), maxval=np.log(1e-1)))
    return {
        "x": normal(ks[0], (BATCH, SEQ, D_MODEL), 1.0),
        "c": normal(ks[1], (BATCH, D_MODEL), 1.0),
        "w_ada": normal(ks[2], (DEPTH, D_MODEL, N_MOD * D_MODEL), 0.5 * D_MODEL ** -0.5),
        "b_ada": normal(ks[3], (DEPTH, N_MOD * D_MODEL), 0.02),
        "ffn1_norm": 1.0 + normal(ks[4], (DEPTH, D_MODEL), 0.02),
        "ffn1_w_gate": normal(ks[5], (DEPTH, D_MODEL, D_FF), D_MODEL ** -0.5),
        "ffn1_w_up": normal(ks[6], (DEPTH, D_MODEL, D_FF), D_MODEL ** -0.5),
        "ffn1_w_down": normal(ks[7], (DEPTH, D_FF, D_MODEL), D_FF ** -0.5),
        "mix_norm": 1.0 + normal(ks[8], (DEPTH, D_MODEL), 0.02),
        "w_in": normal(ks[10], (DEPTH, D_MODEL, D_IN_PROJ), D_MODEL ** -0.5),
        "conv_w": normal(ks[11], (DEPTH, SSD_CONV, D_XBC), SSD_CONV ** -0.5),
        "conv_b": normal(ks[12], (DEPTH, D_XBC), 0.02),
        "dt_bias": dt0 + jnp.log(-jnp.expm1(-dt0)),
        "a_log": jnp.log(jax.random.uniform(ks[13], (DEPTH, SSD_HEADS), f32, minval=1.0, maxval=16.0)),
        "d_skip": 1.0 + normal(ks[14], (DEPTH, SSD_HEADS), 0.02),
        "ssd_norm_w": 1.0 + normal(ks[15], (DEPTH, D_SSD), 0.02),
        "pool_w": normal(ks[16], (DEPTH, POOL_GROUPS, POOL_GROUP_DIM, POOL_GROUP_DIM), POOL_GROUP_DIM ** -0.5),
        "pool_b": normal(ks[17], (DEPTH, POOL_GROUPS, POOL_GROUP_DIM), 0.02),
        "pool_scale": 1.0 + normal(ks[18], (DEPTH, D_POOL), 0.02),
        "w_out": normal(ks[19], (DEPTH, D_MIX, D_MODEL), D_MIX ** -0.5),
        "ffn2_norm": 1.0 + normal(ks[20], (DEPTH, D_MODEL), 0.02),
        "ffn2_w_gate": normal(ks[21], (DEPTH, D_MODEL, D_FF), D_MODEL ** -0.5),
        "ffn2_w_up": normal(ks[22], (DEPTH, D_MODEL, D_FF), D_MODEL ** -0.5),
        "ffn2_w_down": normal(ks[23], (DEPTH, D_FF, D_MODEL), D_FF ** -0.5),
        "final_norm": 1.0 + normal(ks[24], (D_MODEL,), 0.02),
    }


def reference(x, c, w_ada, b_ada, ffn1_norm, ffn1_w_gate, ffn1_w_up, ffn1_w_down,
              mix_norm, w_in, conv_w, conv_b, dt_bias, a_log, d_skip, ssd_norm_w,
              pool_w, pool_b, pool_scale, w_out, ffn2_norm, ffn2_w_gate, ffn2_w_up,
              ffn2_w_down, final_norm):
    c_act = jax.nn.silu(c)
    for i in range(DEPTH):
        mod = c_act @ w_ada[i] + b_ada[i]
        sh1, sc1, g1, sh2, sc2, g2, sh3, sc3, g3 = jnp.split(mod, N_MOD, axis=-1)
        h = modulate(rms_norm(x, ffn1_norm[i]), sh1, sc1)
        x = x + FFN_RES * g1[:, None, :] * swiglu(h, ffn1_w_gate[i], ffn1_w_up[i], ffn1_w_down[i])
        h = modulate(rms_norm(x, mix_norm[i]), sh2, sc2)
        x = x + g2[:, None, :] * token_mixer(
            h, w_in[i], conv_w[i], conv_b[i], dt_bias[i], a_log[i], d_skip[i], ssd_norm_w[i],
            pool_w[i], pool_b[i], pool_scale[i], w_out[i])
        h = modulate(rms_norm(x, ffn2_norm[i]), sh3, sc3)
        x = x + FFN_RES * g3[:, None, :] * swiglu(h, ffn2_w_gate[i], ffn2_w_up[i], ffn2_w_down[i])
    return rms_norm(x, final_norm)
```

```cpp
#include <hip/hip_runtime.h>
#include <hip/hip_cooperative_groups.h>
#include <cstdio>
namespace cg = cooperative_groups;

#define LAS __attribute__((address_space(3)))
typedef unsigned short bf16_t;
typedef short bf16x8 __attribute__((ext_vector_type(8)));
typedef float f32x4 __attribute__((ext_vector_type(4)));
typedef float f32x2 __attribute__((ext_vector_type(2)));
typedef unsigned u32x4 __attribute__((ext_vector_type(4)));
typedef unsigned u32x2 __attribute__((ext_vector_type(2)));

constexpr int BATCH = 4, SEQ = 4096, D = 1024, M = BATCH * SEQ, FF = 2816, NPROJ = 4096, DINP = 4112, DXBC = 2048, NMOD = 9 * D;
constexpr int NCHUNK = 32, NHEAD = 16;
constexpr float EPS = 1e-6f;
constexpr int NWAVES = 8, NTHREADS = 512;
constexpr int LDS_BYTES = 147456;

constexpr size_t KiB = 1024, MiB = 1u << 20;
constexpr size_t WS_MOD = 0, WS_CDEC = 256 * KiB, WS_WDT = 512 * KiB, WS_DT = 2 * MiB;
constexpr size_t WS_WPOOL = 4 * MiB, WS_WOUT = WS_WPOOL + MiB / 2, WS_WGU2 = WS_WOUT + 4 * MiB, WS_WD2 = WS_WGU2 + 11 * MiB, WS_WGU1 = WS_WD2 + 11 * MiB / 2,
                 WS_WD1 = WS_WGU1 + 11 * MiB, WS_WIN = WS_WD1 + 11 * MiB / 2, WS_XR = WS_WIN + 8 * MiB, WS_R2 = WS_XR + 64 * MiB;
constexpr size_t WS_ACT = WS_R2, WS_Z = WS_R2, WS_XBC = WS_R2 + 32 * MiB, WS_U = WS_R2 + 96 * MiB, WS_YPOOL = WS_U, WS_END = WS_U + 32 * MiB;
static_assert(WS_END <= 256 * MiB, "ws map");
static_assert(WS_ACT + (size_t)M * FF * 2 <= 256 * MiB, "ws map act");
constexpr size_t DO_H = 0, DO_STATES = 32 * MiB;

__device__ __forceinline__ float wave_sum(float v) {
#pragma unroll
    for (int o = 1; o < 64; o <<= 1) v += __shfl_xor(v, o);
    return v;
}
typedef __bf16 bf16x2_t __attribute__((ext_vector_type(2)));
__device__ __forceinline__ unsigned cvt_pk_bf16(float lo, float hi) { f32x2 v = {lo, hi}; bf16x2_t r = __builtin_convertvector(v, bf16x2_t); return __builtin_bit_cast(unsigned, r); }
__device__ __forceinline__ float bf_lo(unsigned u) { return __uint_as_float(u << 16); }
__device__ __forceinline__ float bf_hi(unsigned u) { return __uint_as_float(u & 0xffff0000u); }
__device__ __forceinline__ float siluf(float x) { return x * __builtin_amdgcn_rcpf(1.f + __builtin_amdgcn_exp2f(-1.44269504f * x)); }
#define LDS_WAIT() asm volatile("s_waitcnt lgkmcnt(0)" ::: "memory")

namespace pg8 {
constexpr int BM = 256, BK = 64, HALF = 128, HTB = HALF * BK * 2, STAGE_BYTES = 8 * HTB, NXCD = 8, WGM = 8;
__device__ __forceinline__ int lds_byte(int r, int c) { const int st = (r >> 4) * 2 + (c >> 5), rr = r & 15, cc = c & 31, ob = rr * 64 + cc * 2; return st * 1024 + (ob ^ (((ob >> 9) & 1) << 5)); }
__device__ __forceinline__ void stage_rc(int b, int& R, int& C) { const int st = b / 1024, sb = b % 1024, swz = sb ^ (((sb >> 9) & 1) << 5); R = (st >> 1) * 16 + swz / 64; C = (st & 1) * 32 + (swz % 64) / 2; }
struct Unit { int pm, pn; };
struct Gemm { const bf16_t* A; const bf16_t* A2; const bf16_t* Bt; int M, N, K, lda, ldb, ksplit, a_pn_off; };
struct StaticOrder {
    int nM, nN, nwg, G, c;
    __device__ void init(int M_, int N_, int G_, int c_) { nM = M_ / BM; nN = N_ / BM; nwg = nM * nN; G = G_; c = c_; }
    __device__ bool next(int i, Unit& u) const {
        const long L = (long)i * G + c; if (L >= nwg) return false;
        int wgid = (int)L; { const int q = nwg / NXCD, r = nwg % NXCD, xcd = wgid % NXCD, off = wgid / NXCD; wgid = (xcd < r ? xcd * (q + 1) : r * (q + 1) + (xcd - r) * q) + off; }
        const int nig = WGM * nN, gid = wgid / nig, fm = gid * WGM, gsz = (nM - fm) < WGM ? (nM - fm) : WGM;
        u.pm = fm + ((wgid % nig) % gsz); u.pn = (wgid % nig) / gsz; return true;
    }
};
template <class Epi>
__device__ __forceinline__ void gemm_phase(LAS unsigned char* lds, const Gemm g, const StaticOrder& S, const Epi& E) {
    int tid = threadIdx.x; asm volatile("" : "+v"(tid));
    const int wid = __builtin_amdgcn_readfirstlane(tid >> 6), lane = tid & 63, wr = wid >> 2, wc = wid & 3, fr = lane & 15, fq = lane >> 4;
    int nt = g.K / BK, ksplit = g.ksplit;
    asm volatile("" : "+s"(nt), "+s"(ksplit));
    unsigned voffA[2], voffB[2];
#pragma unroll
    for (int i = 0; i < 2; ++i) { int R, C; stage_rc(tid * 16 + i * 8192, R, C); voffA[i] = (unsigned)(R * g.lda + C) * 2u; voffB[i] = (unsigned)(R * g.ldb + C) * 2u; }
    const size_t kstep = (size_t)(BK * 2);
    const size_t hstepA = (size_t)HALF * g.lda * 2, hstepB = (size_t)HALF * g.ldb * 2;
    const size_t tstepA = 2 * hstepA, tstepB = 2 * hstepB;
    const unsigned ldsw = (unsigned)wid * 1024u;
    const int aoff = lds_byte(wr * 64 + fr, fq * 8), boff = lds_byte(wc * 32 + fr, fq * 8);
#define PG8_SA(b, h) (((b) * 2 + (h)) * HTB)
#define PG8_SB(b, h) ((4 + (b) * 2 + (h)) * HTB)
#define PG8_STAGE(bufoff, gbase, voff) do { _Pragma("unroll") for (int _i = 0; _i < 2; ++_i) \
        __builtin_amdgcn_global_load_lds((const unsigned*)((const char*)(gbase) + (voff)[_i]), (LAS unsigned*)(lds + (bufoff) + ldsw + _i * 8192), 16, 0, 0); } while (0)
#define PG8_LDA(dst, b, h) do { _Pragma("unroll") for (int m = 0; m < 4; ++m) _Pragma("unroll") for (int k = 0; k < 2; ++k) dst[m][k] = *(const LAS bf16x8*)(lds + PG8_SA(b, h) + aoff + m * 2048 + k * 1024); } while (0)
#define PG8_LDB(dst, b, h) do { _Pragma("unroll") for (int n = 0; n < 2; ++n) _Pragma("unroll") for (int k = 0; k < 2; ++k) dst[n][k] = *(const LAS bf16x8*)(lds + PG8_SB(b, h) + boff + n * 2048 + k * 1024); } while (0)
#define PG8_MMA(ai, bj, At, Bt) do { __builtin_amdgcn_s_setprio(1); _Pragma("unroll") for (int m = 0; m < 4; ++m) _Pragma("unroll") for (int n = 0; n < 2; ++n) _Pragma("unroll") for (int k = 0; k < 2; ++k) \
        acc[ai][bj][m][n] = __builtin_amdgcn_mfma_f32_16x16x32_bf16(Bt[n][k], At[m][k], acc[ai][bj][m][n], 0, 0, 0); __builtin_amdgcn_s_setprio(0); } while (0)
#define PG8_WAIT_V(n) asm volatile("s_waitcnt vmcnt(" #n ")" ::: "memory")
#define PG8_WAIT_L(n) asm volatile("s_waitcnt lgkmcnt(" #n ")" ::: "memory")
#define PG8_BAR __builtin_amdgcn_s_barrier()
#define PG8_SCHED __builtin_amdgcn_sched_barrier(0)
#define PG8_TILEA(c1, c2, t) ((t) < ksplit ? (c1) + (size_t)(t) * kstep : (c2) + (size_t)((t) - ksplit) * kstep)
    Unit cur, nxt; int ui = 0;
    if (!S.next(0, cur)) return;
    f32x4 acc[2][2][4][2];
#pragma unroll
    for (int a = 0; a < 2; ++a)
#pragma unroll
        for (int b = 0; b < 2; ++b)
#pragma unroll
            for (int m = 0; m < 4; ++m)
#pragma unroll
                for (int n = 0; n < 2; ++n) acc[a][b][m][n] = (f32x4){0.f, 0.f, 0.f, 0.f};
    bf16x8 At[4][2], B0[2][2], B1[2][2];
    const char* cA = (const char*)g.A + (size_t)cur.pm * tstepA + (size_t)cur.pn * g.a_pn_off * 2;
    const char* cA2 = (const char*)g.A2 + (size_t)cur.pm * tstepA + (size_t)cur.pn * g.a_pn_off * 2;
    const char* cB = (const char*)g.Bt + (size_t)cur.pn * tstepB;
    PG8_STAGE(PG8_SB(0, 0), cB, voffB); PG8_STAGE(PG8_SA(0, 0), cA, voffA); PG8_STAGE(PG8_SB(0, 1), cB + hstepB, voffB); PG8_STAGE(PG8_SA(0, 1), cA + hstepA, voffA);
    if (wr == 1) PG8_BAR;
    PG8_WAIT_V(4); PG8_BAR;
    PG8_STAGE(PG8_SB(1, 0), cB + kstep, voffB); PG8_STAGE(PG8_SA(1, 0), cA + kstep, voffA); PG8_STAGE(PG8_SB(1, 1), cB + hstepB + kstep, voffB);
    PG8_WAIT_V(6); PG8_BAR;
    for (;;) {
        const bool has_next = S.next(ui + 1, nxt);
        const char* nA = has_next ? (const char*)g.A + (size_t)nxt.pm * tstepA + (size_t)nxt.pn * g.a_pn_off * 2 : cA;
        const char* nA2 = has_next ? (const char*)g.A2 + (size_t)nxt.pm * tstepA + (size_t)nxt.pn * g.a_pn_off * 2 : cA2;
        const char* nB = has_next ? (const char*)g.Bt + (size_t)nxt.pn * tstepB : cB;
        for (int t = 0; t < nt; t += 2) {
            const bool last = (t == nt - 2);
            const char* a1 = PG8_TILEA(cA, cA2, t + 1);
            const char* a2 = last ? nA : PG8_TILEA(cA, cA2, t + 2); const char* b2 = last ? nB : cB + (size_t)(t + 2) * kstep;
            const char* a3 = a2 + kstep; const char* b3 = b2 + kstep;
            PG8_LDB(B0, 0, 0); PG8_SCHED; PG8_LDA(At, 0, 0); PG8_STAGE(PG8_SA(1, 1), a1 + hstepA, voffA);
            PG8_WAIT_L(8); PG8_BAR; PG8_WAIT_L(0); PG8_MMA(0, 0, At, B0); PG8_BAR; PG8_SCHED;
            PG8_LDB(B1, 0, 1); PG8_STAGE(PG8_SB(0, 0), b2, voffB);
            PG8_BAR; PG8_WAIT_L(0); PG8_MMA(0, 1, At, B1); PG8_BAR;
            PG8_LDA(At, 0, 1); PG8_STAGE(PG8_SA(0, 0), a2, voffA);
            PG8_BAR; PG8_WAIT_L(0); PG8_MMA(1, 0, At, B0); PG8_BAR; PG8_SCHED;
            PG8_STAGE(PG8_SB(0, 1), b2 + hstepB, voffB);
            PG8_WAIT_V(6); PG8_BAR; PG8_MMA(1, 1, At, B1); PG8_BAR;
            PG8_LDB(B0, 1, 0); PG8_SCHED; PG8_LDA(At, 1, 0); PG8_STAGE(PG8_SA(0, 1), a2 + hstepA, voffA);
            PG8_WAIT_L(8); PG8_BAR; PG8_WAIT_L(0); PG8_MMA(0, 0, At, B0); PG8_BAR; PG8_SCHED;
            PG8_LDB(B1, 1, 1); PG8_STAGE(PG8_SB(1, 0), b3, voffB);
            PG8_BAR; PG8_WAIT_L(0); PG8_MMA(0, 1, At, B1); PG8_BAR;
            PG8_LDA(At, 1, 1); PG8_STAGE(PG8_SA(1, 0), a3, voffA);
            PG8_BAR; PG8_WAIT_L(0); PG8_MMA(1, 0, At, B0); PG8_BAR; PG8_SCHED;
            PG8_STAGE(PG8_SB(1, 1), b3 + hstepB, voffB);
            PG8_WAIT_V(6); PG8_BAR; PG8_MMA(1, 1, At, B1); PG8_BAR;
        }
        E(acc, cur, wr, wc, fr, fq);
        if (!has_next) break;
#pragma unroll
        for (int a = 0; a < 2; ++a)
#pragma unroll
            for (int b = 0; b < 2; ++b)
#pragma unroll
                for (int m = 0; m < 4; ++m)
#pragma unroll
                    for (int n = 0; n < 2; ++n) acc[a][b][m][n] = (f32x4){0.f, 0.f, 0.f, 0.f};
        cur = nxt; cA = nA; cA2 = nA2; cB = nB; ++ui;
    }
    PG8_WAIT_V(0);
    if (wr == 0) PG8_BAR;
    PG8_BAR;
#undef PG8_SA
#undef PG8_SB
#undef PG8_STAGE
#undef PG8_LDA
#undef PG8_LDB
#undef PG8_MMA
#undef PG8_WAIT_V
#undef PG8_WAIT_L
#undef PG8_BAR
#undef PG8_SCHED
#undef PG8_TILEA
}

struct EpiSwiGLU {
    bf16_t* O;
    __device__ __forceinline__ void operator()(const f32x4 (&acc)[2][2][4][2], const Unit& u, int wr, int wc, int fr, int fq) const {
        const int row0 = u.pm * BM + wr * 64 + fr, col0 = u.pn * HALF + wc * 32 + 4 * fq;
#pragma unroll
        for (int ai = 0; ai < 2; ++ai)
#pragma unroll
            for (int m = 0; m < 4; ++m) { bf16_t* rowp = O + (size_t)(row0 + ai * HALF + m * 16) * FF + col0;
#pragma unroll
                for (int n = 0; n < 2; ++n) { const f32x4 gt = acc[ai][0][m][n], up = acc[ai][1][m][n];
                    u32x2 w; w.x = cvt_pk_bf16(siluf(gt[0]) * up[0], siluf(gt[1]) * up[1]); w.y = cvt_pk_bf16(siluf(gt[2]) * up[2], siluf(gt[3]) * up[3]);
                    *(u32x2*)(rowp + n * 16) = w; } }
    }
};
struct EpiResid {
    const float* base; float* out; const float* gate; float scale;
    __device__ __forceinline__ void operator()(const f32x4 (&acc)[2][2][4][2], const Unit& u, int wr, int wc, int fr, int fq) const {
        const int row0 = u.pm * BM + wr * 64 + fr, col0 = u.pn * BM + wc * 32 + 4 * fq, b = u.pm >> 4;
        f32x4 gv[2][2];
#pragma unroll
        for (int bj = 0; bj < 2; ++bj)
#pragma unroll
            for (int n = 0; n < 2; ++n) gv[bj][n] = *(const f32x4*)(gate + (size_t)b * NMOD + col0 + bj * HALF + n * 16) * scale;
#pragma unroll
        for (int ai = 0; ai < 2; ++ai)
#pragma unroll
            for (int m = 0; m < 4; ++m) { const size_t off = (size_t)(row0 + ai * HALF + m * 16) * D + col0;
#pragma unroll
                for (int bj = 0; bj < 2; ++bj)
#pragma unroll
                    for (int n = 0; n < 2; ++n) { const f32x4 bs = *(const f32x4*)(base + off + bj * HALF + n * 16);
                        *(f32x4*)(out + off + bj * HALF + n * 16) = bs + gv[bj][n] * acc[ai][bj][m][n]; } }
    }
};
struct EpiSplit {
    bf16_t* Z; bf16_t* XBC; bf16_t* U;
    __device__ __forceinline__ void operator()(const f32x4 (&acc)[2][2][4][2], const Unit& u, int wr, int wc, int fr, int fq) const {
        bf16_t* basep; int ld, c0;
        if (u.pn < 4) { basep = Z; ld = 1024; c0 = u.pn * BM; } else if (u.pn < 12) { basep = XBC; ld = 2048; c0 = (u.pn - 4) * BM; } else { basep = U; ld = 1024; c0 = (u.pn - 12) * BM; }
        const int row0 = u.pm * BM + wr * 64 + fr, col0 = c0 + wc * 32 + 4 * fq;
#pragma unroll
        for (int ai = 0; ai < 2; ++ai)
#pragma unroll
            for (int m = 0; m < 4; ++m) { bf16_t* rowp = basep + (size_t)(row0 + ai * HALF + m * 16) * ld + col0;
#pragma unroll
                for (int bj = 0; bj < 2; ++bj)
#pragma unroll
                    for (int n = 0; n < 2; ++n) { const f32x4 v = acc[ai][bj][m][n]; u32x2 w; w.x = cvt_pk_bf16(v[0], v[1]); w.y = cvt_pk_bf16(v[2], v[3]);
                        *(u32x2*)(rowp + bj * HALF + n * 16) = w; } }
    }
};
struct EpiPool {
    bf16_t* O; const float* bias; const float* scl;
    __device__ __forceinline__ void operator()(const f32x4 (&acc)[2][2][4][2], const Unit& u, int wr, int wc, int fr, int fq) const {
        const int row0 = u.pm * BM + wr * 64 + fr, col0 = u.pn * BM + wc * 32 + 4 * fq;
        f32x4 bv[2][2], sv[2][2];
#pragma unroll
        for (int bj = 0; bj < 2; ++bj)
#pragma unroll
            for (int n = 0; n < 2; ++n) { bv[bj][n] = *(const f32x4*)(bias + col0 + bj * HALF + n * 16); sv[bj][n] = *(const f32x4*)(scl + col0 + bj * HALF + n * 16); }
#pragma unroll
        for (int ai = 0; ai < 2; ++ai)
#pragma unroll
            for (int m = 0; m < 4; ++m) { bf16_t* rowp = O + (size_t)(row0 + ai * HALF + m * 16) * 1024 + col0;
#pragma unroll
                for (int bj = 0; bj < 2; ++bj)
#pragma unroll
                    for (int n = 0; n < 2; ++n) { const f32x4 v = (acc[ai][bj][m][n] + bv[bj][n]) * sv[bj][n]; u32x2 w; w.x = cvt_pk_bf16(v[0], v[1]); w.y = cvt_pk_bf16(v[2], v[3]);
                        *(u32x2*)(rowp + bj * HALF + n * 16) = w; } }
    }
};
}

struct Args { const float* in[25]; float* out; unsigned char* ws; int ph_lo, ph_hi; };
enum { I_X = 0, I_C, I_WADA, I_BADA, I_N1, I_G1, I_U1, I_D1, I_NMIX, I_WIN, I_CONVW, I_CONVB, I_DTB, I_ALOG, I_DSKIP, I_SSDNW, I_POOLW, I_POOLB, I_POOLS, I_WOUT, I_N2, I_G2, I_U2, I_D2, I_NF };

__device__ __forceinline__ void p0_transpose_item(const float* W, int ldw, int K, bf16_t* WT, int dst_row0, int n0, int k0, LAS float* scr, int lane) {
#pragma unroll 8
    for (int i = 0; i < 32; ++i) { const int kk = 2 * i + (lane >> 5); scr[kk * 33 + (lane & 31)] = W[(size_t)(k0 + kk) * ldw + n0 + (lane & 31)]; }
    LDS_WAIT();
    const int c = lane & 7;
#pragma unroll
    for (int j = 0; j < 4; ++j) { const int n = (lane >> 3) + 8 * j; const LAS float* s = scr + (8 * c) * 33 + n;
        u32x4 o; o.x = cvt_pk_bf16(s[0 * 33], s[1 * 33]); o.y = cvt_pk_bf16(s[2 * 33], s[3 * 33]); o.z = cvt_pk_bf16(s[4 * 33], s[5 * 33]); o.w = cvt_pk_bf16(s[6 * 33], s[7 * 33]);
        *(u32x4*)(WT + (size_t)(dst_row0 + n) * K + k0 + 8 * c) = o; }
    LDS_WAIT();
}
__device__ __forceinline__ void p0_mat_item(const float* W, int ldw, int K, int nb, int csrc, bf16_t* WT, int drow_base, int mode, int it, LAS float* scr, int lane) {
    const int kb = it / nb, nbi = it % nb, n0 = 32 * nbi;
    int drow = drow_base + n0;
    if (mode == 1) drow = (n0 >> 7) * 256 + (n0 & 127) + drow_base;
    p0_transpose_item(W, ldw, K, WT, drow, csrc + n0, 64 * kb, scr, lane);
}
__device__ __forceinline__ void p0_phase(const Args& a, LAS unsigned char* lds, int tid, int lane, int wave, int G) {
    unsigned char* ws = a.ws;
    {
        LAS float* cact = (LAS float*)(lds + 69632);
        LAS float* red = (LAS float*)(lds + 69632 + 16384);
        if ((int)blockIdx.x < NMOD / 64) {
            for (int i = tid; i < 4 * D; i += NTHREADS) { const float cv = a.in[I_C][i]; cact[i] = cv / (1.f + __expf(-cv)); }
            __syncthreads();
        }
        for (int it = blockIdx.x; it < NMOD / 64; it += G) {
            const int j = it * 64 + lane, kb = wave * 128;
            float s0 = 0.f, s1 = 0.f, s2 = 0.f, s3 = 0.f;
            const float* wp = a.in[I_WADA] + (size_t)kb * NMOD + j;
#pragma unroll 8
            for (int k = 0; k < 128; ++k) { const float wv = wp[(size_t)k * NMOD];
                s0 += cact[kb + k] * wv; s1 += cact[D + kb + k] * wv; s2 += cact[2 * D + kb + k] * wv; s3 += cact[3 * D + kb + k] * wv; }
            red[(wave * 4 + 0) * 64 + lane] = s0; red[(wave * 4 + 1) * 64 + lane] = s1; red[(wave * 4 + 2) * 64 + lane] = s2; red[(wave * 4 + 3) * 64 + lane] = s3;
            __syncthreads();
            if (wave < 4) { float t = a.in[I_BADA][j];
#pragma unroll
                for (int w = 0; w < 8; ++w) t += red[(w * 4 + wave) * 64 + lane];
                ((float*)(ws + WS_MOD))[wave * NMOD + j] = t; }
            __syncthreads();
        }
    }
    for (int idx = blockIdx.x * NTHREADS + tid; idx < 16 * D; idx += G * NTHREADS) { const int k = idx >> 4, j = idx & 15; ((float*)(ws + WS_WDT))[j * D + k] = a.in[I_WIN][(size_t)k * DINP + 3072 + j]; }
    LAS float* scr = (LAS float*)(lds + wave * 8448);
    const int gw = blockIdx.x * NWAVES + wave, NGW = G * NWAVES;
    constexpr int I_GU = (D / 64) * (FF / 32), I_DN = (FF / 64) * (D / 32), I_ZZ = (D / 64) * 32, I_XB = (D / 64) * 64, I_OUT = (2048 / 64) * 32, I_PL = 4 * 8;
    constexpr int NITEMS = 4 * I_GU + 2 * I_DN + 2 * I_ZZ + I_XB + I_OUT + 4 * I_PL;
    for (int it = gw; it < NITEMS; it += NGW) {
        int r = it;
        if (r < I_GU) { p0_mat_item(a.in[I_G1], FF, D, FF / 32, 0, (bf16_t*)(ws + WS_WGU1), 0, 1, r, scr, lane); continue; } r -= I_GU;
        if (r < I_GU) { p0_mat_item(a.in[I_U1], FF, D, FF / 32, 0, (bf16_t*)(ws + WS_WGU1), 128, 1, r, scr, lane); continue; } r -= I_GU;
        if (r < I_DN) { p0_mat_item(a.in[I_D1], D, FF, D / 32, 0, (bf16_t*)(ws + WS_WD1), 0, 0, r, scr, lane); continue; } r -= I_DN;
        if (r < I_ZZ) { p0_mat_item(a.in[I_WIN], DINP, D, 32, 0, (bf16_t*)(ws + WS_WIN), 0, 0, r, scr, lane); continue; } r -= I_ZZ;
        if (r < I_XB) { p0_mat_item(a.in[I_WIN], DINP, D, 64, 1024, (bf16_t*)(ws + WS_WIN), 1024, 0, r, scr, lane); continue; } r -= I_XB;
        if (r < I_ZZ) { p0_mat_item(a.in[I_WIN], DINP, D, 32, 3088, (bf16_t*)(ws + WS_WIN), 3072, 0, r, scr, lane); continue; } r -= I_ZZ;
        if (r < I_OUT) { p0_mat_item(a.in[I_WOUT], D, 2048, 32, 0, (bf16_t*)(ws + WS_WOUT), 0, 0, r, scr, lane); continue; } r -= I_OUT;
        if (r < 4 * I_PL) { const int gq = r / I_PL; p0_mat_item(a.in[I_POOLW] + (size_t)gq * 65536, 256, 256, 8, 0, (bf16_t*)(ws + WS_WPOOL), gq * 256, 0, r % I_PL, scr, lane); continue; } r -= 4 * I_PL;
        if (r < I_GU) { p0_mat_item(a.in[I_G2], FF, D, FF / 32, 0, (bf16_t*)(ws + WS_WGU2), 0, 1, r, scr, lane); continue; } r -= I_GU;
        if (r < I_GU) { p0_mat_item(a.in[I_U2], FF, D, FF / 32, 0, (bf16_t*)(ws + WS_WGU2), 128, 1, r, scr, lane); continue; } r -= I_GU;
        p0_mat_item(a.in[I_D2], D, FF, D / 32, 0, (bf16_t*)(ws + WS_WD2), 0, 0, r, scr, lane);
    }
}

template <bool DTP>
__device__ __forceinline__ void norm_phase(LAS unsigned char* lds, const float* src, const float* nw, const float* mod, int sh_off, int sc_off, bf16_t* dst,
                                           const float* wdt, const float* dt_bias, float* DT, int tid, int lane, int wave, int G) {
    LAS f32x4* wl = (LAS f32x4*)lds;
    if (DTP) { for (int i = tid; i < 16 * D / 4; i += NTHREADS) wl[i] = ((const f32x4*)wdt)[i]; __syncthreads(); }
    const int gw = blockIdx.x * NWAVES + wave, NGW = G * NWAVES;
    for (int rg = gw; rg < M / 8; rg += NGW) {
        const int row0 = rg * 8, b = row0 >> 12;
        f32x4 Am[4], Bm[4];
#pragma unroll
        for (int j = 0; j < 4; ++j) { const int col = 4 * lane + 256 * j;
            const f32x4 w = *(const f32x4*)(nw + col), sc = *(const f32x4*)(mod + (size_t)b * NMOD + sc_off + col);
            Am[j] = w * (sc + 1.f); Bm[j] = *(const f32x4*)(mod + (size_t)b * NMOD + sh_off + col); }
#pragma unroll 1
        for (int half = 0; half < 2; ++half) {
            f32x4 o[4][4];
#pragma unroll
            for (int r = 0; r < 4; ++r) {
                const int row = row0 + half * 4 + r;
                float ss = 0.f;
#pragma unroll
                for (int j = 0; j < 4; ++j) { o[r][j] = *(const f32x4*)(src + (size_t)row * D + 4 * lane + 256 * j); ss += (o[r][j].x * o[r][j].x + o[r][j].y * o[r][j].y) + (o[r][j].z * o[r][j].z + o[r][j].w * o[r][j].w); }
                const float rstd = rsqrtf(wave_sum(ss) * (1.f / D) + EPS);
#pragma unroll
                for (int j = 0; j < 4; ++j) { o[r][j] = o[r][j] * rstd * Am[j] + Bm[j];
                    u32x2 w; w.x = cvt_pk_bf16(o[r][j].x, o[r][j].y); w.y = cvt_pk_bf16(o[r][j].z, o[r][j].w);
                    *(u32x2*)(dst + (size_t)row * D + 4 * lane + 256 * j) = w; }
            }
            if (DTP) {
                float mine = 0.f;
                __builtin_amdgcn_sched_barrier(0);
#pragma unroll 1
                for (int jj = 0; jj < 16; ++jj) {
                    f32x4 wv[4];
#pragma unroll
                    for (int j = 0; j < 4; ++j) wv[j] = wl[jj * 256 + 64 * j + lane];
#pragma unroll
                    for (int r = 0; r < 4; ++r) { float p = 0.f;
#pragma unroll
                        for (int j = 0; j < 4; ++j) p += (o[r][j].x * wv[j].x + o[r][j].y * wv[j].y) + (o[r][j].z * wv[j].z + o[r][j].w * wv[j].w);
                        const float t = wave_sum(p); if (lane == r * 16 + jj) mine = t; }
                }
                const float xv = mine + dt_bias[lane & 15];
                DT[(size_t)(row0 + half * 4 + (lane >> 4)) * 16 + (lane & 15)] = xv > 20.f ? xv : log1pf(__expf(xv));
            }
        }
    }
}
__device__ __forceinline__ void final_norm_phase(float* xio, const float* nw, int lane, int wave, int G) {
    const int gw = blockIdx.x * NWAVES + wave, NGW = G * NWAVES;
    f32x4 wv[4];
#pragma unroll
    for (int j = 0; j < 4; ++j) wv[j] = *(const f32x4*)(nw + 4 * lane + 256 * j);
    for (int row = gw; row < M; row += NGW) {
        f32x4 v[4]; float ss = 0.f;
#pragma unroll
        for (int j = 0; j < 4; ++j) { v[j] = *(const f32x4*)(xio + (size_t)row * D + 4 * lane + 256 * j); ss += (v[j].x * v[j].x + v[j].y * v[j].y) + (v[j].z * v[j].z + v[j].w * v[j].w); }
        const float rstd = rsqrtf(wave_sum(ss) * (1.f / D) + EPS);
#pragma unroll
        for (int j = 0; j < 4; ++j) *(f32x4*)(xio + (size_t)row * D + 4 * lane + 256 * j) = v[j] * rstd * wv[j];
    }
}

__device__ __forceinline__ void unpack8(const u32x4 v, float (&f)[8]) { f[0] = bf_lo(v.x); f[1] = bf_hi(v.x); f[2] = bf_lo(v.y); f[3] = bf_hi(v.y); f[4] = bf_lo(v.z); f[5] = bf_hi(v.z); f[6] = bf_lo(v.w); f[7] = bf_hi(v.w); }
__device__ __forceinline__ void diff_item(const bf16_t* U, bf16_t* DIFF, int item, int tid) {
    const int oct = tid & 127, sub = tid >> 7, t0 = item * 32 + sub * 8, pos0 = t0 & (SEQ - 1), w = 2 << (oct >> 5);
    const bf16_t* up = U + (size_t)t0 * 1024 + oct * 8;
    float S[8], f[8];
#pragma unroll
    for (int e = 0; e < 8; ++e) S[e] = 0.f;
    for (int j = 1; j <= w; ++j) if (pos0 - j >= 0) { unpack8(*(const u32x4*)(up - (size_t)j * 1024), f);
#pragma unroll
        for (int e = 0; e < 8; ++e) S[e] += f[e]; }
#pragma unroll
    for (int i = 0; i < 8; ++i) {
        const int pos = pos0 + i;
        unpack8(*(const u32x4*)(up + (size_t)i * 1024), f);
#pragma unroll
        for (int e = 0; e < 8; ++e) S[e] += f[e];
        if (pos >= w) { float q[8]; unpack8(*(const u32x4*)(up + (size_t)(i - w) * 1024), q);
#pragma unroll
            for (int e = 0; e < 8; ++e) S[e] -= q[e]; }
        const float inv = 1.f / (float)(pos + 1 < w ? pos + 1 : w);
        u32x4 o; o.x = cvt_pk_bf16(S[0] * inv - f[0], S[1] * inv - f[1]); o.y = cvt_pk_bf16(S[2] * inv - f[2], S[3] * inv - f[3]);
        o.z = cvt_pk_bf16(S[4] * inv - f[4], S[5] * inv - f[5]); o.w = cvt_pk_bf16(S[6] * inv - f[6], S[7] * inv - f[7]);
        *(u32x4*)(DIFF + (size_t)(t0 + i) * 1024 + oct * 8) = o;
    }
}

constexpr int LP = 272;
constexpr int L_C = 0, L_B = 128 * LP, L_XT = 2 * 128 * LP, L_ACS = L_XT + 4 * 64 * LP, L_DTV = L_ACS + 2048, L_SSD_END = L_DTV + 2048;
static_assert(L_SSD_END <= LDS_BYTES, "ssd lds");

__device__ __forceinline__ void ssd_cumsum(LAS unsigned char* lds, const float* DT, const float* a_log, int T0, int g, int lane, int wave) {
    if (wave < 4) {
        const int h = 4 * g + wave; const float av = -__expf(a_log[h]);
        const int t = 2 * lane;
        const float d0 = DT[(size_t)(T0 + t) * 16 + h], d1 = DT[(size_t)(T0 + t + 1) * 16 + h];
        const float v0 = d0 * av, v1 = d1 * av, s = v0 + v1;
        float inc = s;
#pragma unroll
        for (int o = 1; o < 64; o <<= 1) { const float n = __shfl_up(inc, o); if (lane >= o) inc += n; }
        const float exc = inc - s;
        LAS float* acs = (LAS float*)(lds + L_ACS) + wave * 128; LAS float* dtv = (LAS float*)(lds + L_DTV) + wave * 128;
        acs[t] = exc + v0; acs[t + 1] = exc + s; dtv[t] = d0; dtv[t + 1] = d1;
    }
}
template <int MODE>
__device__ __forceinline__ void ssd_stage(LAS unsigned char* lds, const bf16_t* XBC, const float* conv_w, const float* conv_b, int T0, int c, int g, int tid) {
    const LAS float* acs = (const LAS float*)(lds + L_ACS); const LAS float* dtv = (const LAS float*)(lds + L_DTV);
    constexpr int O_LO = (MODE == 0) ? 16 : 0, NO = 64 - O_LO;
#pragma unroll 1
    for (int task = tid; task < NO * 16; task += NTHREADS) {
        const int o = O_LO + task % NO, sg = task / NO;
        const int ch = (o < 16) ? (1536 + g * 128 + o * 8) : (o < 32) ? (1024 + g * 128 + (o - 16) * 8) : (g * 256 + (o - 32) * 8);
        float w[4][8], bs[8];
#pragma unroll
        for (int k = 0; k < 4; ++k) { const f32x4 w0 = *(const f32x4*)(conv_w + k * DXBC + ch), w1 = *(const f32x4*)(conv_w + k * DXBC + ch + 4);
            w[k][0] = w0.x; w[k][1] = w0.y; w[k][2] = w0.z; w[k][3] = w0.w; w[k][4] = w1.x; w[k][5] = w1.y; w[k][6] = w1.z; w[k][7] = w1.w; }
        { const f32x4 b0 = *(const f32x4*)(conv_b + ch), b1 = *(const f32x4*)(conv_b + ch + 4);
          bs[0] = b0.x; bs[1] = b0.y; bs[2] = b0.z; bs[3] = b0.w; bs[4] = b1.x; bs[5] = b1.y; bs[6] = b1.z; bs[7] = b1.w; }
        const bf16_t* src = XBC + ((size_t)(T0 + sg * 8) - 3) * DXBC + ch;
        float out[8][8];
#pragma unroll
        for (int i = 0; i < 8; ++i)
#pragma unroll
            for (int e = 0; e < 8; ++e) out[i][e] = bs[e];
#pragma unroll
        for (int rr = 0; rr < 11; ++rr) {
            const bool valid = (c * 128 + sg * 8 - 3 + rr) >= 0;
            u32x4 rv = (u32x4){0u, 0u, 0u, 0u};
            if (valid) rv = *(const u32x4*)(src + (size_t)rr * DXBC);
            float f[8]; unpack8(rv, f);
#pragma unroll
            for (int k = 0; k < 4; ++k) { const int i = rr - k;
                if (i >= 0 && i < 8) {
#pragma unroll
                    for (int e = 0; e < 8; ++e) out[i][e] += w[k][e] * f[e]; } }
        }
#pragma unroll
        for (int i = 0; i < 8; ++i)
#pragma unroll
            for (int e = 0; e < 8; ++e) out[i][e] = siluf(out[i][e]);
        if (o >= 32) {
            const int r = (o - 32) >> 3, p0 = ((o - 32) & 7) * 8;
            float sc[8];
#pragma unroll
            for (int i = 0; i < 8; ++i) { const int s = sg * 8 + i; sc[i] = dtv[r * 128 + s]; if (MODE == 0) sc[i] *= __expf(acs[r * 128 + 127] - acs[r * 128 + s]); }
#pragma unroll
            for (int e = 0; e < 8; ++e) { u32x4 v; v.x = cvt_pk_bf16(out[0][e] * sc[0], out[1][e] * sc[1]); v.y = cvt_pk_bf16(out[2][e] * sc[2], out[3][e] * sc[3]);
                v.z = cvt_pk_bf16(out[4][e] * sc[4], out[5][e] * sc[5]); v.w = cvt_pk_bf16(out[6][e] * sc[6], out[7][e] * sc[7]);
                *(LAS u32x4*)(lds + L_XT + (r * 64 + p0 + e) * LP + sg * 16) = v; }
        } else if (MODE == 0) {
            const int n0 = (o - 16) * 8;
#pragma unroll
            for (int e = 0; e < 8; ++e) { u32x4 v; v.x = cvt_pk_bf16(out[0][e], out[1][e]); v.y = cvt_pk_bf16(out[2][e], out[3][e]); v.z = cvt_pk_bf16(out[4][e], out[5][e]); v.w = cvt_pk_bf16(out[6][e], out[7][e]);
                *(LAS u32x4*)(lds + L_C + (n0 + e) * LP + sg * 16) = v; }
        } else {
            const int base = (o < 16) ? L_C : L_B, n0 = (o & 15) * 8;
#pragma unroll
            for (int i = 0; i < 8; ++i) { u32x4 v; v.x = cvt_pk_bf16(out[i][0], out[i][1]); v.y = cvt_pk_bf16(out[i][2], out[i][3]); v.z = cvt_pk_bf16(out[i][4], out[i][5]); v.w = cvt_pk_bf16(out[i][6], out[i][7]);
                *(LAS u32x4*)(lds + base + (sg * 8 + i) * LP + n0 * 2) = v; }
        }
    }
}
#define MFMA16(a, b, c) __builtin_amdgcn_mfma_f32_16x16x32_bf16((a), (b), (c), 0, 0, 0)
#define LFRAG(base, row, kk) (*(const LAS bf16x8*)(lds + (base) + (row) * LP + (kk) * 2))

__device__ __forceinline__ void ssd_states_item(const Args& a, LAS unsigned char* lds, int item, int tid, int lane, int wave) {
    const int g = item & 3, c = (item >> 2) & 31, b = item >> 7, T0 = b * SEQ + c * 128, fr = lane & 15, fq = lane >> 4;
    const float* DT = (const float*)(a.ws + WS_DT);
    __syncthreads();
    ssd_cumsum(lds, DT, a.in[I_ALOG], T0, g, lane, wave);
    __syncthreads();
    if (tid < 4) ((float*)(a.ws + WS_CDEC))[(b * 32 + c) * 16 + 4 * g + tid] = __expf(((const LAS float*)(lds + L_ACS))[tid * 128 + 127]);
    ssd_stage<0>(lds, (const bf16_t*)(a.ws + WS_XBC), a.in[I_CONVW], a.in[I_CONVB], T0, c, g, tid);
    __syncthreads();
    const int r = wave >> 1, p0 = (wave & 1) * 32;
    f32x4 st[2][8];
#pragma unroll
    for (int pf = 0; pf < 2; ++pf)
#pragma unroll
        for (int nf = 0; nf < 8; ++nf) st[pf][nf] = (f32x4){0.f, 0.f, 0.f, 0.f};
#pragma unroll
    for (int ks = 0; ks < 4; ++ks) {
        bf16x8 xf[2];
#pragma unroll
        for (int pf = 0; pf < 2; ++pf) xf[pf] = LFRAG(L_XT, r * 64 + p0 + pf * 16 + fr, ks * 32 + fq * 8);
#pragma unroll
        for (int nf = 0; nf < 8; ++nf) { const bf16x8 bf = LFRAG(L_C, nf * 16 + fr, ks * 32 + fq * 8);
#pragma unroll
            for (int pf = 0; pf < 2; ++pf) st[pf][nf] = MFMA16(bf, xf[pf], st[pf][nf]); }
    }
    bf16_t* SP = (bf16_t*)((unsigned char*)a.out + DO_STATES) + ((size_t)((b * 32 + c) * 16 + 4 * g + r) * 64) * 128;
#ifndef DBG_ST
#define DBG_ST 0
#endif
#if DBG_ST == 1
#pragma unroll
    for (int pf = 0; pf < 2; ++pf)
#pragma unroll
        for (int nf = 0; nf < 8; ++nf) st[pf][nf] = (f32x4){1.f, 2.f, 3.f, 4.f};
#elif DBG_ST == 2
#pragma unroll
    for (int pf = 0; pf < 2; ++pf)
#pragma unroll
        for (int nf = 0; nf < 8; ++nf) { const bf16x8 q = LFRAG(L_XT, r * 64 + p0 + pf * 16 + fr, (nf & 3) * 32 + fq * 8); st[pf][nf] = (f32x4){(float)q[0], (float)q[1], (float)q[6], (float)q[7]}; }
#elif DBG_ST == 3
#pragma unroll
    for (int pf = 0; pf < 2; ++pf)
#pragma unroll
        for (int nf = 0; nf < 8; ++nf) { const bf16x8 q = LFRAG(L_C, nf * 16 + fr, (pf * 2) * 32 + fq * 8); st[pf][nf] = (f32x4){(float)q[0], (float)q[1], (float)q[6], (float)q[7]}; }
#endif
#pragma unroll
    for (int pf = 0; pf < 2; ++pf)
#pragma unroll
        for (int nf = 0; nf < 8; ++nf) { const f32x4 v = st[pf][nf]; u32x2 w; w.x = cvt_pk_bf16(v[0], v[1]); w.y = cvt_pk_bf16(v[2], v[3]);
            *(u32x2*)(SP + (size_t)(p0 + pf * 16 + fr) * 128 + nf * 16 + fq * 4) = w; }
}

__device__ __forceinline__ void scan_phase(const Args& a, int tid, int G) {
    bf16_t* SP = (bf16_t*)((unsigned char*)a.out + DO_STATES);
    const float* CD = (const float*)(a.ws + WS_CDEC);
    for (int task = blockIdx.x * NTHREADS + tid; task < BATCH * NHEAD * 64 * 32; task += G * NTHREADS) {
        const int n4 = task & 31, p = (task >> 5) & 63, h = (task >> 11) & 15, b = task >> 15;
        u32x2* base = (u32x2*)(SP + ((size_t)((b * 32) * 16 + h) * 64 + p) * 128 + n4 * 4);
        constexpr size_t cstride = (size_t)16 * 64 * 128 / 4;
        float r0 = 0.f, r1 = 0.f, r2 = 0.f, r3 = 0.f;
#pragma unroll 1
        for (int c0 = 0; c0 < 32; c0 += 8) {
            u32x2 sv[8];
#pragma unroll
            for (int c = 0; c < 8; ++c) sv[c] = base[(c0 + c) * cstride];
#pragma unroll
            for (int c = 0; c < 8; ++c) {
                const float dec = CD[(b * 32 + c0 + c) * 16 + h];
                u32x2 o; o.x = cvt_pk_bf16(r0, r1); o.y = cvt_pk_bf16(r2, r3); base[(c0 + c) * cstride] = o;
                r0 = r0 * dec + bf_lo(sv[c].x); r1 = r1 * dec + bf_hi(sv[c].x); r2 = r2 * dec + bf_lo(sv[c].y); r3 = r3 * dec + bf_hi(sv[c].y);
            }
        }
    }
}

__device__ __forceinline__ void ssd_out_item(const Args& a, LAS unsigned char* lds, int item, int tid, int lane, int wave) {
    const int g = item & 3, c = (item >> 2) & 31, b = item >> 7, T0 = b * SEQ + c * 128, fr = lane & 15, fq = lane >> 4;
    const float* DT = (const float*)(a.ws + WS_DT);
    const LAS float* acs = (const LAS float*)(lds + L_ACS); const LAS float* dtv = (const LAS float*)(lds + L_DTV);
    __syncthreads();
    ssd_cumsum(lds, DT, a.in[I_ALOG], T0, g, lane, wave);
    __syncthreads();
    ssd_stage<1>(lds, (const bf16_t*)(a.ws + WS_XBC), a.in[I_CONVW], a.in[I_CONVB], T0, c, g, tid);
    __syncthreads();
    const int l0 = wave * 16, l = l0 + fr;
    f32x4 sacc[8];
#pragma unroll
    for (int sf = 0; sf < 8; ++sf) sacc[sf] = (f32x4){0.f, 0.f, 0.f, 0.f};
#pragma unroll
    for (int ks = 0; ks < 4; ++ks) { const bf16x8 cf = LFRAG(L_C, l, ks * 32 + fq * 8);
#pragma unroll
        for (int sf = 0; sf < 8; ++sf) { const bf16x8 bf = LFRAG(L_B, sf * 16 + fr, ks * 32 + fq * 8); sacc[sf] = MFMA16(bf, cf, sacc[sf]); } }
    __syncthreads();
    const int L_M = L_B + wave * 16 * LP;
    const bf16_t* PV = (const bf16_t*)((const unsigned char*)a.out + DO_STATES) + ((size_t)((b * 32 + c) * 16 + 4 * g) * 64) * 128;
    f32x4 y[4][4];
#pragma unroll
    for (int r = 0; r < 4; ++r) {
        const float al = acs[r * 128 + l];
#pragma unroll
        for (int pf = 0; pf < 4; ++pf) y[r][pf] = (f32x4){0.f, 0.f, 0.f, 0.f};
#pragma unroll
        for (int ks = 0; ks < 4; ++ks) {
            const bf16x8 cf = LFRAG(L_C, l, ks * 32 + fq * 8);
#pragma unroll
            for (int pf = 0; pf < 4; ++pf) {
                const bf16x8 pv = *(const bf16x8*)(PV + (size_t)(r * 64 + pf * 16 + fr) * 128 + ks * 32 + fq * 8);
                y[r][pf] = MFMA16(pv, cf, y[r][pf]);
            }
        }
        const float sd = __expf(al);
#pragma unroll
        for (int pf = 0; pf < 4; ++pf) y[r][pf] = y[r][pf] * sd;
#pragma unroll
        for (int sf = 0; sf < 8; ++sf) { const f32x4 as = *(const LAS f32x4*)(acs + r * 128 + sf * 16 + fq * 4); float mv[4];
#pragma unroll
            for (int jj = 0; jj < 4; ++jj) { const int s = sf * 16 + fq * 4 + jj; mv[jj] = (s <= l) ? sacc[sf][jj] * __expf(fminf(al - as[jj], 0.f)) : 0.f; }
            u32x2 w; w.x = cvt_pk_bf16(mv[0], mv[1]); w.y = cvt_pk_bf16(mv[2], mv[3]);
            *(LAS u32x2*)(lds + L_M + fr * LP + (sf * 16 + fq * 4) * 2) = w; }
        __syncthreads();
#pragma unroll
        for (int ks = 0; ks < 4; ++ks) {
            const bf16x8 mf = LFRAG(L_M, fr, ks * 32 + fq * 8);
#pragma unroll
            for (int pf = 0; pf < 4; ++pf) {
                const bf16x8 xf = LFRAG(L_XT, r * 64 + pf * 16 + fr, ks * 32 + fq * 8);
                y[r][pf] = MFMA16(xf, mf, y[r][pf]);
            }
        }
        __syncthreads();
    }
    const size_t tok = (size_t)(T0 + l);
    const bf16_t* Zp = (const bf16_t*)(a.ws + WS_Z) + tok * 1024 + g * 256;
    float ssq = 0.f;
#pragma unroll
    for (int r = 0; r < 4; ++r) {
        const float dsk = a.in[I_DSKIP][4 * g + r] / dtv[r * 128 + l];
#pragma unroll
        for (int pf = 0; pf < 4; ++pf) {
            const int p = pf * 16 + fq * 4;
            const u32x2 zz = *(const u32x2*)(Zp + r * 64 + p);
            const float zf[4] = {bf_lo(zz.x), bf_hi(zz.x), bf_lo(zz.y), bf_hi(zz.y)};
#pragma unroll
            for (int jj = 0; jj < 4; ++jj) {
                const float xdt = __uint_as_float((unsigned)(*(const LAS bf16_t*)(lds + L_XT + (r * 64 + p + jj) * LP + l * 2)) << 16);
                const float v = (y[r][pf][jj] + dsk * xdt) * siluf(zf[jj]);
                y[r][pf][jj] = v; ssq += v * v;
            }
        }
    }
    ssq += __shfl_xor(ssq, 16); ssq += __shfl_xor(ssq, 32);
    const float rstd = rsqrtf(ssq * (1.f / 256.f) + EPS);
    bf16_t* Yp = (bf16_t*)((unsigned char*)a.out + DO_H) + tok * 1024 + g * 256;
#pragma unroll
    for (int r = 0; r < 4; ++r)
#pragma unroll
        for (int pf = 0; pf < 4; ++pf) { const int p = pf * 16 + fq * 4; const f32x4 nwv = *(const f32x4*)(a.in[I_SSDNW] + g * 256 + r * 64 + p);
            u32x2 w; w.x = cvt_pk_bf16(y[r][pf][0] * rstd * nwv.x, y[r][pf][1] * rstd * nwv.y); w.y = cvt_pk_bf16(y[r][pf][2] * rstd * nwv.z, y[r][pf][3] * rstd * nwv.w);
            *(u32x2*)(Yp + r * 64 + p) = w; }
}

__global__ void __launch_bounds__(NTHREADS, 2) fwd_megakernel(Args a) {
    extern __shared__ __attribute__((aligned(16))) unsigned char lds_raw[];
    LAS unsigned char* lds = (LAS unsigned char*)lds_raw;
    cg::grid_group grid = cg::this_grid();
    const int G = gridDim.x;
#define PH_IDS() int tid = threadIdx.x; asm volatile("" : "+v"(tid)); const int lane = tid & 63, wave = __builtin_amdgcn_readfirstlane(tid >> 6); (void)lane; (void)wave
    unsigned char* ws = a.ws;
    const float* mod = (const float*)(ws + WS_MOD);
    bf16_t* H = (bf16_t*)((unsigned char*)a.out + DO_H);
    float* XR = (float*)(ws + WS_XR);
    const int lo = a.ph_lo, hi = a.ph_hi;
#ifndef ONLYPH
#define ONLYPH -1
#endif
#define IN(k) ((ONLYPH < 0 || ONLYPH == (k)) && lo <= (k) && (k) < hi)
#define SEAM(k) do { if (IN(k) && IN((k) + 1)) grid.sync(); } while (0)

    if (IN(0)) { PH_IDS(); p0_phase(a, lds, tid, lane, wave, G); }
    SEAM(0);
    if (IN(1)) { PH_IDS(); norm_phase<false>(lds, a.in[I_X], a.in[I_N1], mod, 0 * D, 1 * D, H, nullptr, nullptr, nullptr, tid, lane, wave, G); }
    SEAM(1);
    if (IN(2)) { pg8::Gemm g{H, H, (const bf16_t*)(ws + WS_WGU1), M, 2 * FF, D, D, D, 1 << 30, 0}; pg8::StaticOrder S; S.init(M, 2 * FF, G, blockIdx.x);
        pg8::EpiSwiGLU E{(bf16_t*)(ws + WS_ACT)}; pg8::gemm_phase(lds, g, S, E); }
    SEAM(2);
    if (IN(3)) { pg8::Gemm g{(const bf16_t*)(ws + WS_ACT), (const bf16_t*)(ws + WS_ACT), (const bf16_t*)(ws + WS_WD1), M, D, FF, FF, FF, 1 << 30, 0}; pg8::StaticOrder S; S.init(M, D, G, blockIdx.x);
        pg8::EpiResid E{a.in[I_X], XR, mod + 2 * D, 0.5f}; pg8::gemm_phase(lds, g, S, E); }
    SEAM(3);
    if (IN(4)) { PH_IDS(); norm_phase<true>(lds, XR, a.in[I_NMIX], mod, 3 * D, 4 * D, H, (const float*)(ws + WS_WDT), a.in[I_DTB], (float*)(ws + WS_DT), tid, lane, wave, G); }
    SEAM(4);
    if (IN(5)) { pg8::Gemm g{H, H, (const bf16_t*)(ws + WS_WIN), M, NPROJ, D, D, D, 1 << 30, 0}; pg8::StaticOrder S; S.init(M, NPROJ, G, blockIdx.x);
        pg8::EpiSplit E{(bf16_t*)(ws + WS_Z), (bf16_t*)(ws + WS_XBC), (bf16_t*)(ws + WS_U)}; pg8::gemm_phase(lds, g, S, E); }
    SEAM(5);
    if (IN(6)) { PH_IDS();
        for (int it = blockIdx.x; it < BATCH * NCHUNK * 4; it += G) ssd_states_item(a, lds, it, tid, lane, wave);
        for (int it = blockIdx.x; it < M / 32; it += G) diff_item((const bf16_t*)(ws + WS_U), H, it, tid);
    }
    SEAM(6);
    if (IN(7)) { PH_IDS();
        scan_phase(a, tid, G);
        __syncthreads();
        pg8::Gemm g{H, H, (const bf16_t*)(ws + WS_WPOOL), M, 1024, 256, 1024, 256, 1 << 30, 256}; pg8::StaticOrder S; S.init(M, 1024, G, blockIdx.x);
        pg8::EpiPool E{(bf16_t*)(ws + WS_YPOOL), a.in[I_POOLB], a.in[I_POOLS]}; pg8::gemm_phase(lds, g, S, E);
    }
    SEAM(7);
    if (IN(8)) { PH_IDS(); for (int it = blockIdx.x; it < BATCH * NCHUNK * 4; it += G) ssd_out_item(a, lds, it, tid, lane, wave); }
    SEAM(8);
    if (IN(9)) { __syncthreads();
        pg8::Gemm g{H, (const bf16_t*)(ws + WS_YPOOL), (const bf16_t*)(ws + WS_WOUT), M, D, 2048, 1024, 2048, 16, 0}; pg8::StaticOrder S; S.init(M, D, G, blockIdx.x);
        pg8::EpiResid E{XR, XR, mod + 5 * D, 1.0f}; pg8::gemm_phase(lds, g, S, E); }
    SEAM(9);
    if (IN(10)) { PH_IDS(); norm_phase<false>(lds, XR, a.in[I_N2], mod, 6 * D, 7 * D, H, nullptr, nullptr, nullptr, tid, lane, wave, G); }
    SEAM(10);
    if (IN(11)) { pg8::Gemm g{H, H, (const bf16_t*)(ws + WS_WGU2), M, 2 * FF, D, D, D, 1 << 30, 0}; pg8::StaticOrder S; S.init(M, 2 * FF, G, blockIdx.x);
        pg8::EpiSwiGLU E{(bf16_t*)(ws + WS_ACT)}; pg8::gemm_phase(lds, g, S, E); }
    SEAM(11);
    if (IN(12)) { pg8::Gemm g{(const bf16_t*)(ws + WS_ACT), (const bf16_t*)(ws + WS_ACT), (const bf16_t*)(ws + WS_WD2), M, D, FF, FF, FF, 1 << 30, 0}; pg8::StaticOrder S; S.init(M, D, G, blockIdx.x);
        pg8::EpiResid E{XR, a.out, mod + 8 * D, 0.5f}; pg8::gemm_phase(lds, g, S, E); }
    SEAM(12);
    if (IN(13)) { PH_IDS(); final_norm_phase(a.out, a.in[I_NF], lane, wave, G); }
#undef IN
#undef SEAM
}


#ifndef DBG_K
#define DBG_K -1
#endif
__global__ void dbg_dump(float* out, const void* src, int mode, int nch) {
    for (size_t i = (size_t)blockIdx.x * blockDim.x + threadIdx.x; i < (size_t)M * 1024; i += (size_t)gridDim.x * blockDim.x) {
        float v = 0.f;
        if (mode == 0) v = ((const float*)src)[i];
        else if (mode == 2) v = __uint_as_float((unsigned)((const bf16_t*)src)[i + (size_t)M * 1024] << 16);
        else for (int j = 0; j < nch; ++j) v += __uint_as_float((unsigned)((const bf16_t*)src)[i + (size_t)j * M * 1024] << 16);
        out[i] = v;
    }
}
extern "C" void kernel_launch(void* const* d_in, const int* in_sizes, int n_in, void* d_out, int out_size, void* d_ws, size_t ws_size, hipStream_t stream) {
    static int grid_blocks = 0;
    if (grid_blocks == 0) {
        int dev = 0, cus = 0, per_cu = 0;
        (void)hipGetDevice(&dev);
        (void)hipDeviceGetAttribute(&cus, hipDeviceAttributeMultiprocessorCount, dev);
        if (hipFuncSetAttribute((const void*)fwd_megakernel, hipFuncAttributeMaxDynamicSharedMemorySize, LDS_BYTES) != hipSuccess) { fprintf(stderr, "hipFuncSetAttribute failed\n"); grid_blocks = -1; return; }
        if (hipOccupancyMaxActiveBlocksPerMultiprocessor(&per_cu, (const void*)fwd_megakernel, NTHREADS, LDS_BYTES) != hipSuccess || per_cu < 1) { fprintf(stderr, "occupancy query: %d blocks/CU\n", per_cu); grid_blocks = -1; return; }
        grid_blocks = cus;
        if (n_in != 25 || ws_size < WS_END) { fprintf(stderr, "unexpected problem: n_in %d ws %zu\n", n_in, ws_size); grid_blocks = -1; return; }
    }
    if (grid_blocks < 0) return;
    Args a{};
    for (int i = 0; i < 25; ++i) a.in[i] = (const float*)d_in[i];
    a.out = (float*)d_out; a.ws = (unsigned char*)d_ws;
#ifndef MK_PER_PHASE
#define MK_PER_PHASE 0
#endif
#if MK_PER_PHASE
    const int kmax = (DBG_K >= 0) ? DBG_K : 13;
    for (int k = 0; k <= kmax; ++k) { a.ph_lo = k; a.ph_hi = k + 1; hipLaunchKernelGGL(fwd_megakernel, dim3(grid_blocks), dim3(NTHREADS), LDS_BYTES, stream, a); }
    if (DBG_K >= 0) {
        const unsigned char* ws = (const unsigned char*)d_ws; const void* src = ws + WS_XR; int mode = 0, nch = 1;
        if (DBG_K == 5) { src = ws + WS_Z; mode = 1; nch = 4; }
        if (DBG_K == 2) { src = ws + WS_ACT; mode = 1; nch = 2; }
        if (DBG_K == 6) { src = (const unsigned char*)d_out; mode = 2; nch = 1; }
        if (DBG_K == 7) { src = ws + WS_YPOOL; mode = 1; nch = 1; }
        if (DBG_K == 8) { src = d_out; mode = 1; nch = 1; }
        if (DBG_K == 1) { src = d_out; mode = 1; nch = 1; }
        if (DBG_K == 4) { src = ws + WS_DT; mode = 0; nch = 1; }
        if (src == (const void*)d_out) { (void)hipMemcpyAsync((unsigned char*)d_ws + WS_XR, d_out, 64 * MiB, hipMemcpyDeviceToDevice, stream); src = ws + WS_XR; }
        hipLaunchKernelGGL(dbg_dump, dim3(2048), dim3(256), 0, stream, (float*)d_out, src, mode, nch);
    }
#else
    a.ph_lo = 0; a.ph_hi = 14;
    void* args[] = {&a};
    hipError_t e = hipLaunchCooperativeKernel((const void*)fwd_megakernel, dim3(grid_blocks), dim3(NTHREADS), args, LDS_BYTES, stream);
    if (e != hipSuccess) fprintf(stderr, "cooperative launch failed: %s (grid %d)\n", hipGetErrorString(e), grid_blocks);
#endif
}
```

```cpp
#include <hip/hip_runtime.h>
#include <hip/hip_cooperative_groups.h>
#include <cstdio>
namespace cg = cooperative_groups;

#define LAS __attribute__((address_space(3)))
typedef unsigned short bf16_t;
typedef short bf16x8 __attribute__((ext_vector_type(8)));
typedef float f32x4 __attribute__((ext_vector_type(4)));
typedef float f32x2 __attribute__((ext_vector_type(2)));
typedef unsigned u32x4 __attribute__((ext_vector_type(4)));
typedef unsigned u32x2 __attribute__((ext_vector_type(2)));

constexpr int BATCH = 4, SEQ = 4096, D = 1024, M = BATCH * SEQ, FF = 2816, NPROJ = 4096, DINP = 4112, DXBC = 2048, NMOD = 9 * D;
constexpr int NCHUNK = 32, NHEAD = 16;
constexpr float EPS = 1e-6f;
constexpr int NWAVES = 8, NTHREADS = 512;
constexpr int LDS_BYTES = 147456;

constexpr size_t KiB = 1024, MiB = 1u << 20;
constexpr size_t WS_MOD = 0, WS_CDEC = 256 * KiB, WS_WDT = 512 * KiB, WS_BAR = 768 * KiB, BAR_BYTES = 16 * KiB, WS_DT = 2 * MiB;
constexpr size_t WS_WPOOL = 4 * MiB, WS_WOUT = WS_WPOOL + MiB / 2, WS_WGU2 = WS_WOUT + 4 * MiB, WS_WD2 = WS_WGU2 + 11 * MiB, WS_WGU1 = WS_WD2 + 11 * MiB / 2,
                 WS_WD1 = WS_WGU1 + 11 * MiB, WS_WIN = WS_WD1 + 11 * MiB / 2, WS_XR = WS_WIN + 8 * MiB, WS_R2 = WS_XR + 64 * MiB;
constexpr size_t WS_ACT = WS_R2, WS_Z = WS_R2, WS_XBC = WS_R2 + 32 * MiB, WS_U = WS_R2 + 96 * MiB, WS_YPOOL = WS_U, WS_END = WS_U + 32 * MiB;
static_assert(WS_END <= 256 * MiB, "ws map");
static_assert(WS_ACT + (size_t)M * FF * 2 <= 256 * MiB, "ws map act");
constexpr size_t DO_H = 0, DO_STATES = 32 * MiB;

__device__ __forceinline__ float wave_sum(float v) {
#pragma unroll
    for (int o = 1; o < 64; o <<= 1) v += __shfl_xor(v, o);
    return v;
}
typedef __bf16 bf16x2_t __attribute__((ext_vector_type(2)));
__device__ __forceinline__ unsigned cvt_pk_bf16(float lo, float hi) { f32x2 v = {lo, hi}; bf16x2_t r = __builtin_convertvector(v, bf16x2_t); return __builtin_bit_cast(unsigned, r); }
__device__ __forceinline__ float bf_lo(unsigned u) { return __uint_as_float(u << 16); }
__device__ __forceinline__ float bf_hi(unsigned u) { return __uint_as_float(u & 0xffff0000u); }
__device__ __forceinline__ float siluf(float x) { return x * __builtin_amdgcn_rcpf(1.f + __builtin_amdgcn_exp2f(-1.44269504f * x)); }
#define LDS_WAIT() asm volatile("s_waitcnt lgkmcnt(0)" ::: "memory")

namespace pg8 {
constexpr int BM = 256, BK = 64, HALF = 128, HTB = HALF * BK * 2, STAGE_BYTES = 8 * HTB, NXCD = 8, WGM = 8;
__device__ __forceinline__ int lds_byte(int r, int c) { const int st = (r >> 4) * 2 + (c >> 5), rr = r & 15, cc = c & 31, ob = rr * 64 + cc * 2; return st * 1024 + (ob ^ (((ob >> 9) & 1) << 5)); }
__device__ __forceinline__ void stage_rc(int b, int& R, int& C) { const int st = b / 1024, sb = b % 1024, swz = sb ^ (((sb >> 9) & 1) << 5); R = (st >> 1) * 16 + swz / 64; C = (st & 1) * 32 + (swz % 64) / 2; }
struct Unit { int pm, pn; };
struct Gemm { const bf16_t* A; const bf16_t* A2; const bf16_t* Bt; int M, N, K, lda, ldb, ksplit, a_pn_off; };
struct StaticOrder {
    int nM, nN, nwg, G, c;
    __device__ void init(int M_, int N_, int G_, int c_) { nM = M_ / BM; nN = N_ / BM; nwg = nM * nN; G = G_; c = c_; }
    __device__ bool next(int i, Unit& u) const {
        const long L = (long)i * G + c; if (L >= nwg) return false;
        int wgid = (int)L; { const int q = nwg / NXCD, r = nwg % NXCD, xcd = wgid % NXCD, off = wgid / NXCD; wgid = (xcd < r ? xcd * (q + 1) : r * (q + 1) + (xcd - r) * q) + off; }
        const int nig = WGM * nN, gid = wgid / nig, fm = gid * WGM, gsz = (nM - fm) < WGM ? (nM - fm) : WGM;
        u.pm = fm + ((wgid % nig) % gsz); u.pn = (wgid % nig) / gsz; return true;
    }
};
template <class Epi>
__device__ __forceinline__ void gemm_phase(LAS unsigned char* lds, const Gemm g, const StaticOrder& S, const Epi& E) {
    int tid = threadIdx.x; asm volatile("" : "+v"(tid));
    const int wid = __builtin_amdgcn_readfirstlane(tid >> 6), lane = tid & 63, wr = wid >> 2, wc = wid & 3, fr = lane & 15, fq = lane >> 4;
    int nt = g.K / BK, ksplit = g.ksplit;
    asm volatile("" : "+s"(nt), "+s"(ksplit));
    unsigned voffA[2], voffB[2];
#pragma unroll
    for (int i = 0; i < 2; ++i) { int R, C; stage_rc(tid * 16 + i * 8192, R, C); voffA[i] = (unsigned)(R * g.lda + C) * 2u; voffB[i] = (unsigned)(R * g.ldb + C) * 2u; }
    const size_t kstep = (size_t)(BK * 2);
    const size_t hstepA = (size_t)HALF * g.lda * 2, hstepB = (size_t)HALF * g.ldb * 2;
    const size_t tstepA = 2 * hstepA, tstepB = 2 * hstepB;
    const unsigned ldsw = (unsigned)wid * 1024u;
    const int aoff = lds_byte(wr * 64 + fr, fq * 8), boff = lds_byte(wc * 32 + fr, fq * 8);
#define PG8_SA(b, h) (((b) * 2 + (h)) * HTB)
#define PG8_SB(b, h) ((4 + (b) * 2 + (h)) * HTB)
#define PG8_STAGE(bufoff, gbase, voff) do { _Pragma("unroll") for (int _i = 0; _i < 2; ++_i) \
        __builtin_amdgcn_global_load_lds((const unsigned*)((const char*)(gbase) + (voff)[_i]), (LAS unsigned*)(lds + (bufoff) + ldsw + _i * 8192), 16, 0, 0); } while (0)
#define PG8_LDA(dst, b, h) do { _Pragma("unroll") for (int m = 0; m < 4; ++m) _Pragma("unroll") for (int k = 0; k < 2; ++k) dst[m][k] = *(const LAS bf16x8*)(lds + PG8_SA(b, h) + aoff + m * 2048 + k * 1024); } while (0)
#define PG8_LDB(dst, b, h) do { _Pragma("unroll") for (int n = 0; n < 2; ++n) _Pragma("unroll") for (int k = 0; k < 2; ++k) dst[n][k] = *(const LAS bf16x8*)(lds + PG8_SB(b, h) + boff + n * 2048 + k * 1024); } while (0)
#define PG8_MMA(ai, bj, At, Bt) do { __builtin_amdgcn_s_setprio(1); _Pragma("unroll") for (int m = 0; m < 4; ++m) _Pragma("unroll") for (int n = 0; n < 2; ++n) _Pragma("unroll") for (int k = 0; k < 2; ++k) \
        acc[ai][bj][m][n] = __builtin_amdgcn_mfma_f32_16x16x32_bf16(Bt[n][k], At[m][k], acc[ai][bj][m][n], 0, 0, 0); __builtin_amdgcn_s_setprio(0); } while (0)
#define PG8_WAIT_V(n) asm volatile("s_waitcnt vmcnt(" #n ")" ::: "memory")
#define PG8_WAIT_L(n) asm volatile("s_waitcnt lgkmcnt(" #n ")" ::: "memory")
#define PG8_BAR __builtin_amdgcn_s_barrier()
#define PG8_SCHED __builtin_amdgcn_sched_barrier(0)
#define PG8_TILEA(c1, c2, t) ((t) < ksplit ? (c1) + (size_t)(t) * kstep : (c2) + (size_t)((t) - ksplit) * kstep)
    Unit cur, nxt; int ui = 0;
    if (!S.next(0, cur)) return;
    f32x4 acc[2][2][4][2];
#pragma unroll
    for (int a = 0; a < 2; ++a)
#pragma unroll
        for (int b = 0; b < 2; ++b)
#pragma unroll
            for (int m = 0; m < 4; ++m)
#pragma unroll
                for (int n = 0; n < 2; ++n) acc[a][b][m][n] = (f32x4){0.f, 0.f, 0.f, 0.f};
    bf16x8 At[4][2], B0[2][2], B1[2][2];
    const char* cA = (const char*)g.A + (size_t)cur.pm * tstepA + (size_t)cur.pn * g.a_pn_off * 2;
    const char* cA2 = (const char*)g.A2 + (size_t)cur.pm * tstepA + (size_t)cur.pn * g.a_pn_off * 2;
    const char* cB = (const char*)g.Bt + (size_t)cur.pn * tstepB;
    PG8_STAGE(PG8_SB(0, 0), cB, voffB); PG8_STAGE(PG8_SA(0, 0), cA, voffA); PG8_STAGE(PG8_SB(0, 1), cB + hstepB, voffB); PG8_STAGE(PG8_SA(0, 1), cA + hstepA, voffA);
    if (wr == 1) PG8_BAR;
    PG8_WAIT_V(4); PG8_BAR;
    PG8_STAGE(PG8_SB(1, 0), cB + kstep, voffB); PG8_STAGE(PG8_SA(1, 0), cA + kstep, voffA); PG8_STAGE(PG8_SB(1, 1), cB + hstepB + kstep, voffB);
    PG8_WAIT_V(6); PG8_BAR;
    for (;;) {
        const bool has_next = S.next(ui + 1, nxt);
        const char* nA = has_next ? (const char*)g.A + (size_t)nxt.pm * tstepA + (size_t)nxt.pn * g.a_pn_off * 2 : cA;
        const char* nA2 = has_next ? (const char*)g.A2 + (size_t)nxt.pm * tstepA + (size_t)nxt.pn * g.a_pn_off * 2 : cA2;
        const char* nB = has_next ? (const char*)g.Bt + (size_t)nxt.pn * tstepB : cB;
        for (int t = 0; t < nt; t += 2) {
            const bool last = (t == nt - 2);
            const char* a1 = PG8_TILEA(cA, cA2, t + 1);
            const char* a2 = last ? nA : PG8_TILEA(cA, cA2, t + 2); const char* b2 = last ? nB : cB + (size_t)(t + 2) * kstep;
            const char* a3 = a2 + kstep; const char* b3 = b2 + kstep;
            PG8_LDB(B0, 0, 0); PG8_SCHED; PG8_LDA(At, 0, 0); PG8_STAGE(PG8_SA(1, 1), a1 + hstepA, voffA);
            PG8_WAIT_L(8); PG8_BAR; PG8_WAIT_L(0); PG8_MMA(0, 0, At, B0); PG8_BAR; PG8_SCHED;
            PG8_LDB(B1, 0, 1); PG8_STAGE(PG8_SB(0, 0), b2, voffB);
            PG8_BAR; PG8_WAIT_L(0); PG8_MMA(0, 1, At, B1); PG8_BAR;
            PG8_LDA(At, 0, 1); PG8_STAGE(PG8_SA(0, 0), a2, voffA);
            PG8_BAR; PG8_WAIT_L(0); PG8_MMA(1, 0, At, B0); PG8_BAR; PG8_SCHED;
            PG8_STAGE(PG8_SB(0, 1), b2 + hstepB, voffB);
            PG8_WAIT_V(6); PG8_BAR; PG8_MMA(1, 1, At, B1); PG8_BAR;
            PG8_LDB(B0, 1, 0); PG8_SCHED; PG8_LDA(At, 1, 0); PG8_STAGE(PG8_SA(0, 1), a2 + hstepA, voffA);
            PG8_WAIT_L(8); PG8_BAR; PG8_WAIT_L(0); PG8_MMA(0, 0, At, B0); PG8_BAR; PG8_SCHED;
            PG8_LDB(B1, 1, 1); PG8_STAGE(PG8_SB(1, 0), b3, voffB);
            PG8_BAR; PG8_WAIT_L(0); PG8_MMA(0, 1, At, B1); PG8_BAR;
            PG8_LDA(At, 1, 1); PG8_STAGE(PG8_SA(1, 0), a3, voffA);
            PG8_BAR; PG8_WAIT_L(0); PG8_MMA(1, 0, At, B0); PG8_BAR; PG8_SCHED;
            PG8_STAGE(PG8_SB(1, 1), b3 + hstepB, voffB);
            PG8_WAIT_V(6); PG8_BAR; PG8_MMA(1, 1, At, B1); PG8_BAR;
        }
        E(acc, cur, wr, wc, fr, fq);
        if (!has_next) break;
#pragma unroll
        for (int a = 0; a < 2; ++a)
#pragma unroll
            for (int b = 0; b < 2; ++b)
#pragma unroll
                for (int m = 0; m < 4; ++m)
#pragma unroll
                    for (int n = 0; n < 2; ++n) acc[a][b][m][n] = (f32x4){0.f, 0.f, 0.f, 0.f};
        cur = nxt; cA = nA; cA2 = nA2; cB = nB; ++ui;
    }
    PG8_WAIT_V(0);
    if (wr == 0) PG8_BAR;
    PG8_BAR;
#undef PG8_SA
#undef PG8_SB
#undef PG8_STAGE
#undef PG8_LDA
#undef PG8_LDB
#undef PG8_MMA
#undef PG8_WAIT_V
#undef PG8_WAIT_L
#undef PG8_BAR
#undef PG8_SCHED
#undef PG8_TILEA
}

struct EpiSwiGLU {
    bf16_t* O;
    __device__ __forceinline__ void operator()(const f32x4 (&acc)[2][2][4][2], const Unit& u, int wr, int wc, int fr, int fq) const {
        const int row0 = u.pm * BM + wr * 64 + fr, col0 = u.pn * HALF + wc * 32 + 4 * fq;
#pragma unroll
        for (int ai = 0; ai < 2; ++ai)
#pragma unroll
            for (int m = 0; m < 4; ++m) { bf16_t* rowp = O + (size_t)(row0 + ai * HALF + m * 16) * FF + col0;
#pragma unroll
                for (int n = 0; n < 2; ++n) { const f32x4 gt = acc[ai][0][m][n], up = acc[ai][1][m][n];
                    u32x2 w; w.x = cvt_pk_bf16(siluf(gt[0]) * up[0], siluf(gt[1]) * up[1]); w.y = cvt_pk_bf16(siluf(gt[2]) * up[2], siluf(gt[3]) * up[3]);
                    *(u32x2*)(rowp + n * 16) = w; } }
    }
};
struct EpiResid {
    const float* base; float* out; const float* gate; float scale;
    __device__ __forceinline__ void operator()(const f32x4 (&acc)[2][2][4][2], const Unit& u, int wr, int wc, int fr, int fq) const {
        const int row0 = u.pm * BM + wr * 64 + fr, col0 = u.pn * BM + wc * 32 + 4 * fq, b = u.pm >> 4;
        f32x4 gv[2][2];
#pragma unroll
        for (int bj = 0; bj < 2; ++bj)
#pragma unroll
            for (int n = 0; n < 2; ++n) gv[bj][n] = *(const f32x4*)(gate + (size_t)b * NMOD + col0 + bj * HALF + n * 16) * scale;
#pragma unroll
        for (int ai = 0; ai < 2; ++ai)
#pragma unroll
            for (int m = 0; m < 4; ++m) { const size_t off = (size_t)(row0 + ai * HALF + m * 16) * D + col0;
#pragma unroll
                for (int bj = 0; bj < 2; ++bj)
#pragma unroll
                    for (int n = 0; n < 2; ++n) { const f32x4 bs = *(const f32x4*)(base + off + bj * HALF + n * 16);
                        *(f32x4*)(out + off + bj * HALF + n * 16) = bs + gv[bj][n] * acc[ai][bj][m][n]; } }
    }
};
struct EpiSplit {
    bf16_t* Z; bf16_t* XBC; bf16_t* U;
    __device__ __forceinline__ void operator()(const f32x4 (&acc)[2][2][4][2], const Unit& u, int wr, int wc, int fr, int fq) const {
        bf16_t* basep; int ld, c0;
        if (u.pn < 4) { basep = Z; ld = 1024; c0 = u.pn * BM; } else if (u.pn < 12) { basep = XBC; ld = 2048; c0 = (u.pn - 4) * BM; } else { basep = U; ld = 1024; c0 = (u.pn - 12) * BM; }
        const int row0 = u.pm * BM + wr * 64 + fr, col0 = c0 + wc * 32 + 4 * fq;
#pragma unroll
        for (int ai = 0; ai < 2; ++ai)
#pragma unroll
            for (int m = 0; m < 4; ++m) { bf16_t* rowp = basep + (size_t)(row0 + ai * HALF + m * 16) * ld + col0;
#pragma unroll
                for (int bj = 0; bj < 2; ++bj)
#pragma unroll
                    for (int n = 0; n < 2; ++n) { const f32x4 v = acc[ai][bj][m][n]; u32x2 w; w.x = cvt_pk_bf16(v[0], v[1]); w.y = cvt_pk_bf16(v[2], v[3]);
                        *(u32x2*)(rowp + bj * HALF + n * 16) = w; } }
    }
};
struct EpiPool {
    bf16_t* O; const float* bias; const float* scl;
    __device__ __forceinline__ void operator()(const f32x4 (&acc)[2][2][4][2], const Unit& u, int wr, int wc, int fr, int fq) const {
        const int row0 = u.pm * BM + wr * 64 + fr, col0 = u.pn * BM + wc * 32 + 4 * fq;
        f32x4 bv[2][2], sv[2][2];
#pragma unroll
        for (int bj = 0; bj < 2; ++bj)
#pragma unroll
            for (int n = 0; n < 2; ++n) { bv[bj][n] = *(const f32x4*)(bias + col0 + bj * HALF + n * 16); sv[bj][n] = *(const f32x4*)(scl + col0 + bj * HALF + n * 16); }
#pragma unroll
        for (int ai = 0; ai < 2; ++ai)
#pragma unroll
            for (int m = 0; m < 4; ++m) { bf16_t* rowp = O + (size_t)(row0 + ai * HALF + m * 16) * 1024 + col0;
#pragma unroll
                for (int bj = 0; bj < 2; ++bj)
#pragma unroll
                    for (int n = 0; n < 2; ++n) { const f32x4 v = (acc[ai][bj][m][n] + bv[bj][n]) * sv[bj][n]; u32x2 w; w.x = cvt_pk_bf16(v[0], v[1]); w.y = cvt_pk_bf16(v[2], v[3]);
                        *(u32x2*)(rowp + bj * HALF + n * 16) = w; } }
    }
};
}

struct Args { const float* in[25]; float* out; unsigned char* ws; int ph_lo, ph_hi; };
enum { I_X = 0, I_C, I_WADA, I_BADA, I_N1, I_G1, I_U1, I_D1, I_NMIX, I_WIN, I_CONVW, I_CONVB, I_DTB, I_ALOG, I_DSKIP, I_SSDNW, I_POOLW, I_POOLB, I_POOLS, I_WOUT, I_N2, I_G2, I_U2, I_D2, I_NF };

__device__ __forceinline__ void p0_transpose_item(const float* W, int ldw, int K, bf16_t* WT, int dst_row0, int n0, int k0, LAS float* scr, int lane) {
#pragma unroll 8
    for (int i = 0; i < 32; ++i) { const int kk = 2 * i + (lane >> 5); scr[kk * 33 + (lane & 31)] = W[(size_t)(k0 + kk) * ldw + n0 + (lane & 31)]; }
    LDS_WAIT();
    const int c = lane & 7;
#pragma unroll
    for (int j = 0; j < 4; ++j) { const int n = (lane >> 3) + 8 * j; const LAS float* s = scr + (8 * c) * 33 + n;
        u32x4 o; o.x = cvt_pk_bf16(s[0 * 33], s[1 * 33]); o.y = cvt_pk_bf16(s[2 * 33], s[3 * 33]); o.z = cvt_pk_bf16(s[4 * 33], s[5 * 33]); o.w = cvt_pk_bf16(s[6 * 33], s[7 * 33]);
        *(u32x4*)(WT + (size_t)(dst_row0 + n) * K + k0 + 8 * c) = o; }
    LDS_WAIT();
}
__device__ __forceinline__ void p0_mat_item(const float* W, int ldw, int K, int nb, int csrc, bf16_t* WT, int drow_base, int mode, int it, LAS float* scr, int lane) {
    const int kb = it / nb, nbi = it % nb, n0 = 32 * nbi;
    int drow = drow_base + n0;
    if (mode == 1) drow = (n0 >> 7) * 256 + (n0 & 127) + drow_base;
    p0_transpose_item(W, ldw, K, WT, drow, csrc + n0, 64 * kb, scr, lane);
}
__device__ __forceinline__ void p0_phase(const Args& a, LAS unsigned char* lds, int tid, int lane, int wave, int G) {
    unsigned char* ws = a.ws;
    {
        LAS float* cact = (LAS float*)(lds + 69632);
        LAS float* red = (LAS float*)(lds + 69632 + 16384);
        if ((int)blockIdx.x < NMOD / 64) {
            for (int i = tid; i < 4 * D; i += NTHREADS) { const float cv = a.in[I_C][i]; cact[i] = cv / (1.f + __expf(-cv)); }
            __syncthreads();
        }
        for (int it = blockIdx.x; it < NMOD / 64; it += G) {
            const int j = it * 64 + lane, kb = wave * 128;
            float s0 = 0.f, s1 = 0.f, s2 = 0.f, s3 = 0.f;
            const float* wp = a.in[I_WADA] + (size_t)kb * NMOD + j;
#pragma unroll 8
            for (int k = 0; k < 128; ++k) { const float wv = wp[(size_t)k * NMOD];
                s0 += cact[kb + k] * wv; s1 += cact[D + kb + k] * wv; s2 += cact[2 * D + kb + k] * wv; s3 += cact[3 * D + kb + k] * wv; }
            red[(wave * 4 + 0) * 64 + lane] = s0; red[(wave * 4 + 1) * 64 + lane] = s1; red[(wave * 4 + 2) * 64 + lane] = s2; red[(wave * 4 + 3) * 64 + lane] = s3;
            __syncthreads();
            if (wave < 4) { float t = a.in[I_BADA][j];
#pragma unroll
                for (int w = 0; w < 8; ++w) t += red[(w * 4 + wave) * 64 + lane];
                ((float*)(ws + WS_MOD))[wave * NMOD + j] = t; }
            __syncthreads();
        }
    }
    for (int idx = blockIdx.x * NTHREADS + tid; idx < 16 * D; idx += G * NTHREADS) { const int k = idx >> 4, j = idx & 15; ((float*)(ws + WS_WDT))[j * D + k] = a.in[I_WIN][(size_t)k * DINP + 3072 + j]; }
    LAS float* scr = (LAS float*)(lds + wave * 8448);
    const int gw = blockIdx.x * NWAVES + wave, NGW = G * NWAVES;
    constexpr int I_GU = (D / 64) * (FF / 32), I_DN = (FF / 64) * (D / 32), I_ZZ = (D / 64) * 32, I_XB = (D / 64) * 64, I_OUT = (2048 / 64) * 32, I_PL = 4 * 8;
    constexpr int NITEMS = 4 * I_GU + 2 * I_DN + 2 * I_ZZ + I_XB + I_OUT + 4 * I_PL;
    for (int it = gw; it < NITEMS; it += NGW) {
        int r = it;
        if (r < I_GU) { p0_mat_item(a.in[I_G1], FF, D, FF / 32, 0, (bf16_t*)(ws + WS_WGU1), 0, 1, r, scr, lane); continue; } r -= I_GU;
        if (r < I_GU) { p0_mat_item(a.in[I_U1], FF, D, FF / 32, 0, (bf16_t*)(ws + WS_WGU1), 128, 1, r, scr, lane); continue; } r -= I_GU;
        if (r < I_DN) { p0_mat_item(a.in[I_D1], D, FF, D / 32, 0, (bf16_t*)(ws + WS_WD1), 0, 0, r, scr, lane); continue; } r -= I_DN;
        if (r < I_ZZ) { p0_mat_item(a.in[I_WIN], DINP, D, 32, 0, (bf16_t*)(ws + WS_WIN), 0, 0, r, scr, lane); continue; } r -= I_ZZ;
        if (r < I_XB) { p0_mat_item(a.in[I_WIN], DINP, D, 64, 1024, (bf16_t*)(ws + WS_WIN), 1024, 0, r, scr, lane); continue; } r -= I_XB;
        if (r < I_ZZ) { p0_mat_item(a.in[I_WIN], DINP, D, 32, 3088, (bf16_t*)(ws + WS_WIN), 3072, 0, r, scr, lane); continue; } r -= I_ZZ;
        if (r < I_OUT) { p0_mat_item(a.in[I_WOUT], D, 2048, 32, 0, (bf16_t*)(ws + WS_WOUT), 0, 0, r, scr, lane); continue; } r -= I_OUT;
        if (r < 4 * I_PL) { const int gq = r / I_PL; p0_mat_item(a.in[I_POOLW] + (size_t)gq * 65536, 256, 256, 8, 0, (bf16_t*)(ws + WS_WPOOL), gq * 256, 0, r % I_PL, scr, lane); continue; } r -= 4 * I_PL;
        if (r < I_GU) { p0_mat_item(a.in[I_G2], FF, D, FF / 32, 0, (bf16_t*)(ws + WS_WGU2), 0, 1, r, scr, lane); continue; } r -= I_GU;
        if (r < I_GU) { p0_mat_item(a.in[I_U2], FF, D, FF / 32, 0, (bf16_t*)(ws + WS_WGU2), 128, 1, r, scr, lane); continue; } r -= I_GU;
        p0_mat_item(a.in[I_D2], D, FF, D / 32, 0, (bf16_t*)(ws + WS_WD2), 0, 0, r, scr, lane);
    }
}

template <bool DTP>
__device__ __forceinline__ void norm_phase(LAS unsigned char* lds, const float* src, const float* nw, const float* mod, int sh_off, int sc_off, bf16_t* dst,
                                           const float* wdt, const float* dt_bias, float* DT, int tid, int lane, int wave, int G) {
    LAS f32x4* wl = (LAS f32x4*)lds;
    if (DTP) { for (int i = tid; i < 16 * D / 4; i += NTHREADS) wl[i] = ((const f32x4*)wdt)[i]; __syncthreads(); }
    const int gw = blockIdx.x * NWAVES + wave, NGW = G * NWAVES;
    for (int rg = gw; rg < M / 8; rg += NGW) {
        const int row0 = rg * 8, b = row0 >> 12;
        f32x4 Am[4], Bm[4];
#pragma unroll
        for (int j = 0; j < 4; ++j) { const int col = 4 * lane + 256 * j;
            const f32x4 w = *(const f32x4*)(nw + col), sc = *(const f32x4*)(mod + (size_t)b * NMOD + sc_off + col);
            Am[j] = w * (sc + 1.f); Bm[j] = *(const f32x4*)(mod + (size_t)b * NMOD + sh_off + col); }
#pragma unroll 1
        for (int half = 0; half < 2; ++half) {
            f32x4 o[4][4];
#pragma unroll
            for (int r = 0; r < 4; ++r) {
                const int row = row0 + half * 4 + r;
                float ss = 0.f;
#pragma unroll
                for (int j = 0; j < 4; ++j) { o[r][j] = *(const f32x4*)(src + (size_t)row * D + 4 * lane + 256 * j); ss += (o[r][j].x * o[r][j].x + o[r][j].y * o[r][j].y) + (o[r][j].z * o[r][j].z + o[r][j].w * o[r][j].w); }
                const float rstd = rsqrtf(wave_sum(ss) * (1.f / D) + EPS);
#pragma unroll
                for (int j = 0; j < 4; ++j) { o[r][j] = o[r][j] * rstd * Am[j] + Bm[j];
                    u32x2 w; w.x = cvt_pk_bf16(o[r][j].x, o[r][j].y); w.y = cvt_pk_bf16(o[r][j].z, o[r][j].w);
                    *(u32x2*)(dst + (size_t)row * D + 4 * lane + 256 * j) = w; }
            }
            if (DTP) {
                float mine = 0.f;
                __builtin_amdgcn_sched_barrier(0);
#pragma unroll 1
                for (int jj = 0; jj < 16; ++jj) {
                    f32x4 wv[4];
#pragma unroll
                    for (int j = 0; j < 4; ++j) wv[j] = wl[jj * 256 + 64 * j + lane];
#pragma unroll
                    for (int r = 0; r < 4; ++r) { float p = 0.f;
#pragma unroll
                        for (int j = 0; j < 4; ++j) p += (o[r][j].x * wv[j].x + o[r][j].y * wv[j].y) + (o[r][j].z * wv[j].z + o[r][j].w * wv[j].w);
                        const float t = wave_sum(p); if (lane == r * 16 + jj) mine = t; }
                }
                const float xv = mine + dt_bias[lane & 15];
                DT[(size_t)(row0 + half * 4 + (lane >> 4)) * 16 + (lane & 15)] = xv > 20.f ? xv : log1pf(__expf(xv));
            }
        }
    }
}
__device__ __forceinline__ void final_norm_phase(float* xio, const float* nw, int lane, int wave, int G) {
    const int gw = blockIdx.x * NWAVES + wave, NGW = G * NWAVES;
    f32x4 wv[4];
#pragma unroll
    for (int j = 0; j < 4; ++j) wv[j] = *(const f32x4*)(nw + 4 * lane + 256 * j);
    for (int row = gw; row < M; row += NGW) {
        f32x4 v[4]; float ss = 0.f;
#pragma unroll
        for (int j = 0; j < 4; ++j) { v[j] = *(const f32x4*)(xio + (size_t)row * D + 4 * lane + 256 * j); ss += (v[j].x * v[j].x + v[j].y * v[j].y) + (v[j].z * v[j].z + v[j].w * v[j].w); }
        const float rstd = rsqrtf(wave_sum(ss) * (1.f / D) + EPS);
#pragma unroll
        for (int j = 0; j < 4; ++j) *(f32x4*)(xio + (size_t)row * D + 4 * lane + 256 * j) = v[j] * rstd * wv[j];
    }
}

__device__ __forceinline__ void unpack8(const u32x4 v, float (&f)[8]) { f[0] = bf_lo(v.x); f[1] = bf_hi(v.x); f[2] = bf_lo(v.y); f[3] = bf_hi(v.y); f[4] = bf_lo(v.z); f[5] = bf_hi(v.z); f[6] = bf_lo(v.w); f[7] = bf_hi(v.w); }
__device__ __forceinline__ void diff_item(const bf16_t* U, bf16_t* DIFF, int item, int tid) {
    const int oct = tid & 127, sub = tid >> 7, t0 = item * 32 + sub * 8, pos0 = t0 & (SEQ - 1), w = 2 << (oct >> 5);
    const bf16_t* up = U + (size_t)t0 * 1024 + oct * 8;
    float S[8], f[8];
#pragma unroll
    for (int e = 0; e < 8; ++e) S[e] = 0.f;
    for (int j = 1; j <= w; ++j) if (pos0 - j >= 0) { unpack8(*(const u32x4*)(up - (size_t)j * 1024), f);
#pragma unroll
        for (int e = 0; e < 8; ++e) S[e] += f[e]; }
#pragma unroll
    for (int i = 0; i < 8; ++i) {
        const int pos = pos0 + i;
        unpack8(*(const u32x4*)(up + (size_t)i * 1024), f);
#pragma unroll
        for (int e = 0; e < 8; ++e) S[e] += f[e];
        if (pos >= w) { float q[8]; unpack8(*(const u32x4*)(up + (size_t)(i - w) * 1024), q);
#pragma unroll
            for (int e = 0; e < 8; ++e) S[e] -= q[e]; }
        const float inv = 1.f / (float)(pos + 1 < w ? pos + 1 : w);
        u32x4 o; o.x = cvt_pk_bf16(S[0] * inv - f[0], S[1] * inv - f[1]); o.y = cvt_pk_bf16(S[2] * inv - f[2], S[3] * inv - f[3]);
        o.z = cvt_pk_bf16(S[4] * inv - f[4], S[5] * inv - f[5]); o.w = cvt_pk_bf16(S[6] * inv - f[6], S[7] * inv - f[7]);
        *(u32x4*)(DIFF + (size_t)(t0 + i) * 1024 + oct * 8) = o;
    }
}

constexpr int LP = 272;
constexpr int L_C = 0, L_B = 128 * LP, L_XT = 2 * 128 * LP, L_ACS = L_XT + 4 * 64 * LP, L_DTV = L_ACS + 2048, L_SSD_END = L_DTV + 2048;
static_assert(L_SSD_END <= LDS_BYTES, "ssd lds");

__device__ __forceinline__ void ssd_cumsum(LAS unsigned char* lds, const float* DT, const float* a_log, int T0, int g, int lane, int wave) {
    if (wave < 4) {
        const int h = 4 * g + wave; const float av = -__expf(a_log[h]);
        const int t = 2 * lane;
        const float d0 = DT[(size_t)(T0 + t) * 16 + h], d1 = DT[(size_t)(T0 + t + 1) * 16 + h];
        const float v0 = d0 * av, v1 = d1 * av, s = v0 + v1;
        float inc = s;
#pragma unroll
        for (int o = 1; o < 64; o <<= 1) { const float n = __shfl_up(inc, o); if (lane >= o) inc += n; }
        const float exc = inc - s;
        LAS float* acs = (LAS float*)(lds + L_ACS) + wave * 128; LAS float* dtv = (LAS float*)(lds + L_DTV) + wave * 128;
        acs[t] = exc + v0; acs[t + 1] = exc + s; dtv[t] = d0; dtv[t + 1] = d1;
    }
}
template <int MODE>
__device__ __forceinline__ void ssd_stage(LAS unsigned char* lds, const bf16_t* XBC, const float* conv_w, const float* conv_b, int T0, int c, int g, int tid) {
    const LAS float* acs = (const LAS float*)(lds + L_ACS); const LAS float* dtv = (const LAS float*)(lds + L_DTV);
    constexpr int O_LO = (MODE == 0) ? 16 : 0, NO = 64 - O_LO;
#pragma unroll 1
    for (int task = tid; task < NO * 16; task += NTHREADS) {
        const int o = O_LO + task % NO, sg = task / NO;
        const int ch = (o < 16) ? (1536 + g * 128 + o * 8) : (o < 32) ? (1024 + g * 128 + (o - 16) * 8) : (g * 256 + (o - 32) * 8);
        float w[4][8], bs[8];
#pragma unroll
        for (int k = 0; k < 4; ++k) { const f32x4 w0 = *(const f32x4*)(conv_w + k * DXBC + ch), w1 = *(const f32x4*)(conv_w + k * DXBC + ch + 4);
            w[k][0] = w0.x; w[k][1] = w0.y; w[k][2] = w0.z; w[k][3] = w0.w; w[k][4] = w1.x; w[k][5] = w1.y; w[k][6] = w1.z; w[k][7] = w1.w; }
        { const f32x4 b0 = *(const f32x4*)(conv_b + ch), b1 = *(const f32x4*)(conv_b + ch + 4);
          bs[0] = b0.x; bs[1] = b0.y; bs[2] = b0.z; bs[3] = b0.w; bs[4] = b1.x; bs[5] = b1.y; bs[6] = b1.z; bs[7] = b1.w; }
        const bf16_t* src = XBC + ((size_t)(T0 + sg * 8) - 3) * DXBC + ch;
        float out[8][8];
#pragma unroll
        for (int i = 0; i < 8; ++i)
#pragma unroll
            for (int e = 0; e < 8; ++e) out[i][e] = bs[e];
#pragma unroll
        for (int rr = 0; rr < 11; ++rr) {
            const bool valid = (c * 128 + sg * 8 - 3 + rr) >= 0;
            u32x4 rv = (u32x4){0u, 0u, 0u, 0u};
            if (valid) rv = *(const u32x4*)(src + (size_t)rr * DXBC);
            float f[8]; unpack8(rv, f);
#pragma unroll
            for (int k = 0; k < 4; ++k) { const int i = rr - k;
                if (i >= 0 && i < 8) {
#pragma unroll
                    for (int e = 0; e < 8; ++e) out[i][e] += w[k][e] * f[e]; } }
        }
#pragma unroll
        for (int i = 0; i < 8; ++i)
#pragma unroll
            for (int e = 0; e < 8; ++e) out[i][e] = siluf(out[i][e]);
        if (o >= 32) {
            const int r = (o - 32) >> 3, p0 = ((o - 32) & 7) * 8;
            float sc[8];
#pragma unroll
            for (int i = 0; i < 8; ++i) { const int s = sg * 8 + i; sc[i] = dtv[r * 128 + s]; if (MODE == 0) sc[i] *= __expf(acs[r * 128 + 127] - acs[r * 128 + s]); }
#pragma unroll
            for (int e = 0; e < 8; ++e) { u32x4 v; v.x = cvt_pk_bf16(out[0][e] * sc[0], out[1][e] * sc[1]); v.y = cvt_pk_bf16(out[2][e] * sc[2], out[3][e] * sc[3]);
                v.z = cvt_pk_bf16(out[4][e] * sc[4], out[5][e] * sc[5]); v.w = cvt_pk_bf16(out[6][e] * sc[6], out[7][e] * sc[7]);
                *(LAS u32x4*)(lds + L_XT + (r * 64 + p0 + e) * LP + sg * 16) = v; }
        } else if (MODE == 0) {
            const int n0 = (o - 16) * 8;
#pragma unroll
            for (int e = 0; e < 8; ++e) { u32x4 v; v.x = cvt_pk_bf16(out[0][e], out[1][e]); v.y = cvt_pk_bf16(out[2][e], out[3][e]); v.z = cvt_pk_bf16(out[4][e], out[5][e]); v.w = cvt_pk_bf16(out[6][e], out[7][e]);
                *(LAS u32x4*)(lds + L_C + (n0 + e) * LP + sg * 16) = v; }
        } else {
            const int base = (o < 16) ? L_C : L_B, n0 = (o & 15) * 8;
#pragma unroll
            for (int i = 0; i < 8; ++i) { u32x4 v; v.x = cvt_pk_bf16(out[i][0], out[i][1]); v.y = cvt_pk_bf16(out[i][2], out[i][3]); v.z = cvt_pk_bf16(out[i][4], out[i][5]); v.w = cvt_pk_bf16(out[i][6], out[i][7]);
                *(LAS u32x4*)(lds + base + (sg * 8 + i) * LP + n0 * 2) = v; }
        }
    }
}
#define MFMA16(a, b, c) __builtin_amdgcn_mfma_f32_16x16x32_bf16((a), (b), (c), 0, 0, 0)
#define LFRAG(base, row, kk) (*(const LAS bf16x8*)(lds + (base) + (row) * LP + (kk) * 2))

__device__ __forceinline__ void ssd_states_item(const Args& a, LAS unsigned char* lds, int item, int tid, int lane, int wave) {
    const int g = item & 3, c = (item >> 2) & 31, b = item >> 7, T0 = b * SEQ + c * 128, fr = lane & 15, fq = lane >> 4;
    const float* DT = (const float*)(a.ws + WS_DT);
    __syncthreads();
    ssd_cumsum(lds, DT, a.in[I_ALOG], T0, g, lane, wave);
    __syncthreads();
    if (tid < 4) ((float*)(a.ws + WS_CDEC))[(b * 32 + c) * 16 + 4 * g + tid] = __expf(((const LAS float*)(lds + L_ACS))[tid * 128 + 127]);
    ssd_stage<0>(lds, (const bf16_t*)(a.ws + WS_XBC), a.in[I_CONVW], a.in[I_CONVB], T0, c, g, tid);
    __syncthreads();
    const int r = wave >> 1, p0 = (wave & 1) * 32;
    f32x4 st[2][8];
#pragma unroll
    for (int pf = 0; pf < 2; ++pf)
#pragma unroll
        for (int nf = 0; nf < 8; ++nf) st[pf][nf] = (f32x4){0.f, 0.f, 0.f, 0.f};
#pragma unroll
    for (int ks = 0; ks < 4; ++ks) {
        bf16x8 xf[2];
#pragma unroll
        for (int pf = 0; pf < 2; ++pf) xf[pf] = LFRAG(L_XT, r * 64 + p0 + pf * 16 + fr, ks * 32 + fq * 8);
#pragma unroll
        for (int nf = 0; nf < 8; ++nf) { const bf16x8 bf = LFRAG(L_C, nf * 16 + fr, ks * 32 + fq * 8);
#pragma unroll
            for (int pf = 0; pf < 2; ++pf) st[pf][nf] = MFMA16(bf, xf[pf], st[pf][nf]); }
    }
    bf16_t* SP = (bf16_t*)((unsigned char*)a.out + DO_STATES) + ((size_t)((b * 32 + c) * 16 + 4 * g + r) * 64) * 128;
#ifndef DBG_ST
#define DBG_ST 0
#endif
#if DBG_ST == 1
#pragma unroll
    for (int pf = 0; pf < 2; ++pf)
#pragma unroll
        for (int nf = 0; nf < 8; ++nf) st[pf][nf] = (f32x4){1.f, 2.f, 3.f, 4.f};
#elif DBG_ST == 2
#pragma unroll
    for (int pf = 0; pf < 2; ++pf)
#pragma unroll
        for (int nf = 0; nf < 8; ++nf) { const bf16x8 q = LFRAG(L_XT, r * 64 + p0 + pf * 16 + fr, (nf & 3) * 32 + fq * 8); st[pf][nf] = (f32x4){(float)q[0], (float)q[1], (float)q[6], (float)q[7]}; }
#elif DBG_ST == 3
#pragma unroll
    for (int pf = 0; pf < 2; ++pf)
#pragma unroll
        for (int nf = 0; nf < 8; ++nf) { const bf16x8 q = LFRAG(L_C, nf * 16 + fr, (pf * 2) * 32 + fq * 8); st[pf][nf] = (f32x4){(float)q[0], (float)q[1], (float)q[6], (float)q[7]}; }
#endif
#pragma unroll
    for (int pf = 0; pf < 2; ++pf)
#pragma unroll
        for (int nf = 0; nf < 8; ++nf) { const f32x4 v = st[pf][nf]; u32x2 w; w.x = cvt_pk_bf16(v[0], v[1]); w.y = cvt_pk_bf16(v[2], v[3]);
            *(u32x2*)(SP + (size_t)(p0 + pf * 16 + fr) * 128 + nf * 16 + fq * 4) = w; }
}

__device__ __forceinline__ void scan_phase(const Args& a, int tid, int G) {
    bf16_t* SP = (bf16_t*)((unsigned char*)a.out + DO_STATES);
    const float* CD = (const float*)(a.ws + WS_CDEC);
    for (int task = blockIdx.x * NTHREADS + tid; task < BATCH * NHEAD * 64 * 32; task += G * NTHREADS) {
        const int n4 = task & 31, p = (task >> 5) & 63, h = (task >> 11) & 15, b = task >> 15;
        u32x2* base = (u32x2*)(SP + ((size_t)((b * 32) * 16 + h) * 64 + p) * 128 + n4 * 4);
        constexpr size_t cstride = (size_t)16 * 64 * 128 / 4;
        float r0 = 0.f, r1 = 0.f, r2 = 0.f, r3 = 0.f;
#pragma unroll 1
        for (int c0 = 0; c0 < 32; c0 += 8) {
            u32x2 sv[8];
#pragma unroll
            for (int c = 0; c < 8; ++c) sv[c] = base[(c0 + c) * cstride];
#pragma unroll
            for (int c = 0; c < 8; ++c) {
                const float dec = CD[(b * 32 + c0 + c) * 16 + h];
                u32x2 o; o.x = cvt_pk_bf16(r0, r1); o.y = cvt_pk_bf16(r2, r3); base[(c0 + c) * cstride] = o;
                r0 = r0 * dec + bf_lo(sv[c].x); r1 = r1 * dec + bf_hi(sv[c].x); r2 = r2 * dec + bf_lo(sv[c].y); r3 = r3 * dec + bf_hi(sv[c].y);
            }
        }
    }
}

__device__ __forceinline__ void ssd_out_item(const Args& a, LAS unsigned char* lds, int item, int tid, int lane, int wave) {
    const int g = item & 3, c = (item >> 2) & 31, b = item >> 7, T0 = b * SEQ + c * 128, fr = lane & 15, fq = lane >> 4;
    const float* DT = (const float*)(a.ws + WS_DT);
    const LAS float* acs = (const LAS float*)(lds + L_ACS); const LAS float* dtv = (const LAS float*)(lds + L_DTV);
    __syncthreads();
    ssd_cumsum(lds, DT, a.in[I_ALOG], T0, g, lane, wave);
    __syncthreads();
    ssd_stage<1>(lds, (const bf16_t*)(a.ws + WS_XBC), a.in[I_CONVW], a.in[I_CONVB], T0, c, g, tid);
    __syncthreads();
    const int l0 = wave * 16, l = l0 + fr;
    f32x4 sacc[8];
#pragma unroll
    for (int sf = 0; sf < 8; ++sf) sacc[sf] = (f32x4){0.f, 0.f, 0.f, 0.f};
#pragma unroll
    for (int ks = 0; ks < 4; ++ks) { const bf16x8 cf = LFRAG(L_C, l, ks * 32 + fq * 8);
#pragma unroll
        for (int sf = 0; sf < 8; ++sf) { const bf16x8 bf = LFRAG(L_B, sf * 16 + fr, ks * 32 + fq * 8); sacc[sf] = MFMA16(bf, cf, sacc[sf]); } }
    __syncthreads();
    const int L_M = L_B + wave * 16 * LP;
    const bf16_t* PV = (const bf16_t*)((const unsigned char*)a.out + DO_STATES) + ((size_t)((b * 32 + c) * 16 + 4 * g) * 64) * 128;
    f32x4 y[4][4];
#pragma unroll
    for (int r = 0; r < 4; ++r) {
        const float al = acs[r * 128 + l];
#pragma unroll
        for (int pf = 0; pf < 4; ++pf) y[r][pf] = (f32x4){0.f, 0.f, 0.f, 0.f};
#pragma unroll
        for (int ks = 0; ks < 4; ++ks) {
            const bf16x8 cf = LFRAG(L_C, l, ks * 32 + fq * 8);
#pragma unroll
            for (int pf = 0; pf < 4; ++pf) {
                const bf16x8 pv = *(const bf16x8*)(PV + (size_t)(r * 64 + pf * 16 + fr) * 128 + ks * 32 + fq * 8);
                y[r][pf] = MFMA16(pv, cf, y[r][pf]);
            }
        }
        const float sd = __expf(al);
#pragma unroll
        for (int pf = 0; pf < 4; ++pf) y[r][pf] = y[r][pf] * sd;
#pragma unroll
        for (int sf = 0; sf < 8; ++sf) { const f32x4 as = *(const LAS f32x4*)(acs + r * 128 + sf * 16 + fq * 4); float mv[4];
#pragma unroll
            for (int jj = 0; jj < 4; ++jj) { const int s = sf * 16 + fq * 4 + jj; mv[jj] = (s <= l) ? sacc[sf][jj] * __expf(fminf(al - as[jj], 0.f)) : 0.f; }
            u32x2 w; w.x = cvt_pk_bf16(mv[0], mv[1]); w.y = cvt_pk_bf16(mv[2], mv[3]);
            *(LAS u32x2*)(lds + L_M + fr * LP + (sf * 16 + fq * 4) * 2) = w; }
        __syncthreads();
#pragma unroll
        for (int ks = 0; ks < 4; ++ks) {
            const bf16x8 mf = LFRAG(L_M, fr, ks * 32 + fq * 8);
#pragma unroll
            for (int pf = 0; pf < 4; ++pf) {
                const bf16x8 xf = LFRAG(L_XT, r * 64 + pf * 16 + fr, ks * 32 + fq * 8);
                y[r][pf] = MFMA16(xf, mf, y[r][pf]);
            }
        }
        __syncthreads();
    }
    const size_t tok = (size_t)(T0 + l);
    const bf16_t* Zp = (const bf16_t*)(a.ws + WS_Z) + tok * 1024 + g * 256;
    float ssq = 0.f;
#pragma unroll
    for (int r = 0; r < 4; ++r) {
        const float dsk = a.in[I_DSKIP][4 * g + r] / dtv[r * 128 + l];
#pragma unroll
        for (int pf = 0; pf < 4; ++pf) {
            const int p = pf * 16 + fq * 4;
            const u32x2 zz = *(const u32x2*)(Zp + r * 64 + p);
            const float zf[4] = {bf_lo(zz.x), bf_hi(zz.x), bf_lo(zz.y), bf_hi(zz.y)};
#pragma unroll
            for (int jj = 0; jj < 4; ++jj) {
                const float xdt = __uint_as_float((unsigned)(*(const LAS bf16_t*)(lds + L_XT + (r * 64 + p + jj) * LP + l * 2)) << 16);
                const float v = (y[r][pf][jj] + dsk * xdt) * siluf(zf[jj]);
                y[r][pf][jj] = v; ssq += v * v;
            }
        }
    }
    ssq += __shfl_xor(ssq, 16); ssq += __shfl_xor(ssq, 32);
    const float rstd = rsqrtf(ssq * (1.f / 256.f) + EPS);
    bf16_t* Yp = (bf16_t*)((unsigned char*)a.out + DO_H) + tok * 1024 + g * 256;
#pragma unroll
    for (int r = 0; r < 4; ++r)
#pragma unroll
        for (int pf = 0; pf < 4; ++pf) { const int p = pf * 16 + fq * 4; const f32x4 nwv = *(const f32x4*)(a.in[I_SSDNW] + g * 256 + r * 64 + p);
            u32x2 w; w.x = cvt_pk_bf16(y[r][pf][0] * rstd * nwv.x, y[r][pf][1] * rstd * nwv.y); w.y = cvt_pk_bf16(y[r][pf][2] * rstd * nwv.z, y[r][pf][3] * rstd * nwv.w);
            *(u32x2*)(Yp + r * 64 + p) = w; }
}


#define XB_TMO      128
#define XB_XCNT(j)  (256  + 64 * (j))
#define XB_XSUB(j)  (1280 + 64 * (j))
#define XB_XGEN(j)  (2304 + 64 * (j))
#define XB_TOP      3328
#define XB_TOPGEN   3392
#define XCD_BAR_WORDS 3456
#define XB_SPIN_CAP (1u << 18)
__device__ __forceinline__ unsigned xb_ld(unsigned* p)              { return __hip_atomic_load(p, __ATOMIC_RELAXED, __HIP_MEMORY_SCOPE_AGENT); }
__device__ __forceinline__ unsigned xb_add(unsigned* p, unsigned v) { return __hip_atomic_fetch_add(p, v, __ATOMIC_RELAXED, __HIP_MEMORY_SCOPE_AGENT); }
__device__ __forceinline__ unsigned xb_xcc_id() { return (unsigned)__builtin_amdgcn_s_getreg((3 << 11) | 20) & 0xFu; }
#define XB_SPIN(cond, bar) do { unsigned _sp = 0; while (cond) { __builtin_amdgcn_s_sleep(1); \
    if ((++_sp & 255u) == 0u) { if (xb_ld(&(bar)[XB_TMO])) break; if (_sp > XB_SPIN_CAP) { atomicAdd(&(bar)[XB_TMO], 1u); break; } } } } while (0)
struct XcdBarrier { unsigned* bar; unsigned x; volatile LAS unsigned* st; };
__device__ __forceinline__ XcdBarrier xcd_barrier_post(unsigned* bar, volatile LAS unsigned* st) {
    XcdBarrier b; b.bar = bar; b.x = xb_xcc_id(); b.st = st;
    if (threadIdx.x == 0) (void)xb_add(&bar[XB_XCNT(b.x)], 1u);
    return b;
}
__device__ __forceinline__ void xcd_barrier_complete(unsigned* bar, unsigned x, unsigned& nloc, unsigned& nx) {
    const unsigned G = gridDim.x * gridDim.y * gridDim.z;
    unsigned sum, cnt, mine, sp = 0u;
    for (;;) {
        sum = 0u; cnt = 0u; mine = 0u;
#pragma unroll
        for (unsigned j = 0; j < 16; ++j) { const unsigned c = xb_ld(&bar[XB_XCNT(j)]); sum += c; cnt += (c > 0u) ? 1u : 0u; mine = (j == x) ? c : mine; }
        if (sum == G) break;
        __builtin_amdgcn_s_sleep(1);
        if ((++sp & 255u) == 0u) { if (xb_ld(&bar[XB_TMO])) break; if (sp > XB_SPIN_CAP) { atomicAdd(&bar[XB_TMO], 1u); break; } }
    }
    nloc = mine > 0u ? mine : 1u; nx = cnt > 0u ? cnt : 1u;
}
__device__ __forceinline__ void xcd_barrier(const XcdBarrier& b) {
    asm volatile("s_waitcnt vmcnt(0)" ::: "memory");
    __syncthreads();
    if (threadIdx.x == 0) {
        unsigned* bar = b.bar;
        __builtin_amdgcn_s_waitcnt(0);
        unsigned nloc = b.st[0], nx = b.st[1];
        if (nloc == 0u) { xcd_barrier_complete(bar, b.x, nloc, nx); b.st[0] = nloc; b.st[1] = nx; }
        const unsigned old = xb_add(&bar[XB_XSUB(b.x)], 1u);
        const unsigned gen = old / nloc;
        if (old + 1u == (gen + 1u) * nloc) {
            __builtin_amdgcn_fence(__ATOMIC_RELEASE, "agent");
            asm volatile("s_waitcnt vmcnt(0)" ::: "memory");
            const unsigned og = xb_add(&bar[XB_TOP], 1u);
            const unsigned tg = og / nx;
            if (og + 1u == (tg + 1u) * nx) xb_add(&bar[XB_TOPGEN], 1u);
            else XB_SPIN(xb_ld(&bar[XB_TOPGEN]) == tg, bar);
            __builtin_amdgcn_fence(__ATOMIC_ACQUIRE, "agent");
            xb_add(&bar[XB_XGEN(b.x)], 1u);
            asm volatile("s_waitcnt vmcnt(0)" ::: "memory");
        } else {
            XB_SPIN(xb_ld(&bar[XB_XGEN(b.x)]) == gen, bar);
            __builtin_amdgcn_fence(__ATOMIC_ACQUIRE, "agent");
            asm volatile("s_waitcnt vmcnt(0)" ::: "memory");
        }
    }
    __syncthreads();
}

__global__ void __launch_bounds__(NTHREADS, 2) fwd_megakernel(Args a) {
    extern __shared__ __attribute__((aligned(16))) unsigned char lds_raw[];
    LAS unsigned char* lds = (LAS unsigned char*)lds_raw;
    cg::grid_group grid = cg::this_grid();
    const int G = gridDim.x;
#define PH_IDS() int tid = threadIdx.x; asm volatile("" : "+v"(tid)); const int lane = tid & 63, wave = __builtin_amdgcn_readfirstlane(tid >> 6); (void)lane; (void)wave
    unsigned char* ws = a.ws;
    const float* mod = (const float*)(ws + WS_MOD);
    bf16_t* H = (bf16_t*)((unsigned char*)a.out + DO_H);
    float* XR = (float*)(ws + WS_XR);
    const int lo = a.ph_lo, hi = a.ph_hi;
#ifndef ONLYPH
#define ONLYPH -1
#endif
#define IN(k) ((ONLYPH < 0 || ONLYPH == (k)) && lo <= (k) && (k) < hi)
    volatile LAS unsigned* bst = (volatile LAS unsigned*)(lds + LDS_BYTES - 64);
    if (threadIdx.x < 16) bst[threadIdx.x] = 0u;
    __syncthreads();
    XcdBarrier xbar = xcd_barrier_post((unsigned*)(ws + WS_BAR), bst);
    if (a.ph_hi > 1000) grid.sync();
#define SEAM(k) do { if (IN(k) && IN((k) + 1)) xcd_barrier(xbar); } while (0)
#ifndef DUP_MASK
#define DUP_MASK 0
#endif
#define REP(k) for (int rep_ = 0; rep_ < (((DUP_MASK >> (k)) & 1) ? 2 : 1); ++rep_, (rep_ < (((DUP_MASK >> (k)) & 1) ? 2 : 1) ? xcd_barrier(xbar) : (void)0))

    if (IN(0)) REP(0) { PH_IDS(); p0_phase(a, lds, tid, lane, wave, G); }
    SEAM(0);
    if (IN(1)) REP(1) { PH_IDS(); norm_phase<false>(lds, a.in[I_X], a.in[I_N1], mod, 0 * D, 1 * D, H, nullptr, nullptr, nullptr, tid, lane, wave, G); }
    SEAM(1);
    if (IN(2)) REP(2) { pg8::Gemm g{H, H, (const bf16_t*)(ws + WS_WGU1), M, 2 * FF, D, D, D, 1 << 30, 0}; pg8::StaticOrder S; S.init(M, 2 * FF, G, blockIdx.x);
        pg8::EpiSwiGLU E{(bf16_t*)(ws + WS_ACT)}; pg8::gemm_phase(lds, g, S, E); }
    SEAM(2);
    if (IN(3)) REP(3) { pg8::Gemm g{(const bf16_t*)(ws + WS_ACT), (const bf16_t*)(ws + WS_ACT), (const bf16_t*)(ws + WS_WD1), M, D, FF, FF, FF, 1 << 30, 0}; pg8::StaticOrder S; S.init(M, D, G, blockIdx.x);
        pg8::EpiResid E{a.in[I_X], XR, mod + 2 * D, 0.5f}; pg8::gemm_phase(lds, g, S, E); }
    SEAM(3);
    if (IN(4)) REP(4) { PH_IDS(); norm_phase<true>(lds, XR, a.in[I_NMIX], mod, 3 * D, 4 * D, H, (const float*)(ws + WS_WDT), a.in[I_DTB], (float*)(ws + WS_DT), tid, lane, wave, G); }
    SEAM(4);
    if (IN(5)) REP(5) { pg8::Gemm g{H, H, (const bf16_t*)(ws + WS_WIN), M, NPROJ, D, D, D, 1 << 30, 0}; pg8::StaticOrder S; S.init(M, NPROJ, G, blockIdx.x);
        pg8::EpiSplit E{(bf16_t*)(ws + WS_Z), (bf16_t*)(ws + WS_XBC), (bf16_t*)(ws + WS_U)}; pg8::gemm_phase(lds, g, S, E); }
    SEAM(5);
    if (IN(6)) REP(6) { PH_IDS();
        for (int it = blockIdx.x; it < BATCH * NCHUNK * 4; it += G) ssd_states_item(a, lds, it, tid, lane, wave);
        for (int it = blockIdx.x; it < M / 32; it += G) diff_item((const bf16_t*)(ws + WS_U), H, it, tid);
    }
    SEAM(6);
    if (IN(7)) REP(7) { PH_IDS();
        scan_phase(a, tid, G);
        __syncthreads();
        pg8::Gemm g{H, H, (const bf16_t*)(ws + WS_WPOOL), M, 1024, 256, 1024, 256, 1 << 30, 256}; pg8::StaticOrder S; S.init(M, 1024, G, blockIdx.x);
        pg8::EpiPool E{(bf16_t*)(ws + WS_YPOOL), a.in[I_POOLB], a.in[I_POOLS]}; pg8::gemm_phase(lds, g, S, E);
    }
    SEAM(7);
    if (IN(8)) REP(8) { PH_IDS(); for (int it = blockIdx.x; it < BATCH * NCHUNK * 4; it += G) ssd_out_item(a, lds, it, tid, lane, wave); }
    SEAM(8);
    if (IN(9)) REP(9) { __syncthreads();
        pg8::Gemm g{H, (const bf16_t*)(ws + WS_YPOOL), (const bf16_t*)(ws + WS_WOUT), M, D, 2048, 1024, 2048, 16, 0}; pg8::StaticOrder S; S.init(M, D, G, blockIdx.x);
        pg8::EpiResid E{XR, XR, mod + 5 * D, 1.0f}; pg8::gemm_phase(lds, g, S, E); }
    SEAM(9);
    if (IN(10)) REP(10) { PH_IDS(); norm_phase<false>(lds, XR, a.in[I_N2], mod, 6 * D, 7 * D, H, nullptr, nullptr, nullptr, tid, lane, wave, G); }
    SEAM(10);
    if (IN(11)) REP(11) { pg8::Gemm g{H, H, (const bf16_t*)(ws + WS_WGU2), M, 2 * FF, D, D, D, 1 << 30, 0}; pg8::StaticOrder S; S.init(M, 2 * FF, G, blockIdx.x);
        pg8::EpiSwiGLU E{(bf16_t*)(ws + WS_ACT)}; pg8::gemm_phase(lds, g, S, E); }
    SEAM(11);
    if (IN(12)) REP(12) { pg8::Gemm g{(const bf16_t*)(ws + WS_ACT), (const bf16_t*)(ws + WS_ACT), (const bf16_t*)(ws + WS_WD2), M, D, FF, FF, FF, 1 << 30, 0}; pg8::StaticOrder S; S.init(M, D, G, blockIdx.x);
        pg8::EpiResid E{XR, a.out, mod + 8 * D, 0.5f}; pg8::gemm_phase(lds, g, S, E); }
    SEAM(12);
    if (IN(13)) REP(13) { PH_IDS(); final_norm_phase(a.out, a.in[I_NF], lane, wave, G); }
#undef IN
#undef SEAM
}


#ifndef DBG_K
#define DBG_K -1
#endif
__global__ void dbg_dump(float* out, const void* src, int mode, int nch) {
    for (size_t i = (size_t)blockIdx.x * blockDim.x + threadIdx.x; i < (size_t)M * 1024; i += (size_t)gridDim.x * blockDim.x) {
        float v = 0.f;
        if (mode == 0) v = ((const float*)src)[i];
        else if (mode == 2) v = __uint_as_float((unsigned)((const bf16_t*)src)[i + (size_t)M * 1024] << 16);
        else for (int j = 0; j < nch; ++j) v += __uint_as_float((unsigned)((const bf16_t*)src)[i + (size_t)j * M * 1024] << 16);
        out[i] = v;
    }
}
extern "C" void kernel_launch(void* const* d_in, const int* in_sizes, int n_in, void* d_out, int out_size, void* d_ws, size_t ws_size, hipStream_t stream) {
    static int grid_blocks = 0;
    if (grid_blocks == 0) {
        int dev = 0, cus = 0, per_cu = 0;
        (void)hipGetDevice(&dev);
        (void)hipDeviceGetAttribute(&cus, hipDeviceAttributeMultiprocessorCount, dev);
        if (hipFuncSetAttribute((const void*)fwd_megakernel, hipFuncAttributeMaxDynamicSharedMemorySize, LDS_BYTES) != hipSuccess) { fprintf(stderr, "hipFuncSetAttribute failed\n"); grid_blocks = -1; return; }
        if (hipOccupancyMaxActiveBlocksPerMultiprocessor(&per_cu, (const void*)fwd_megakernel, NTHREADS, LDS_BYTES) != hipSuccess || per_cu < 1) { fprintf(stderr, "occupancy query: %d blocks/CU\n", per_cu); grid_blocks = -1; return; }
        grid_blocks = cus;
        if (n_in != 25 || ws_size < WS_END) { fprintf(stderr, "unexpected problem: n_in %d ws %zu\n", n_in, ws_size); grid_blocks = -1; return; }
    }
    if (grid_blocks < 0) return;
    Args a{};
    for (int i = 0; i < 25; ++i) a.in[i] = (const float*)d_in[i];
    a.out = (float*)d_out; a.ws = (unsigned char*)d_ws;
    (void)hipMemsetAsync((unsigned char*)d_ws + WS_BAR, 0, BAR_BYTES, stream);
#ifndef MK_PER_PHASE
#define MK_PER_PHASE 0
#endif
#if MK_PER_PHASE
    const int kmax = (DBG_K >= 0) ? DBG_K : 13;
    for (int k = 0; k <= kmax; ++k) { a.ph_lo = k; a.ph_hi = k + 1; hipLaunchKernelGGL(fwd_megakernel, dim3(grid_blocks), dim3(NTHREADS), LDS_BYTES, stream, a); }
    if (DBG_K >= 0) {
        const unsigned char* ws = (const unsigned char*)d_ws; const void* src = ws + WS_XR; int mode = 0, nch = 1;
        if (DBG_K == 5) { src = ws + WS_Z; mode = 1; nch = 4; }
        if (DBG_K == 2) { src = ws + WS_ACT; mode = 1; nch = 2; }
        if (DBG_K == 6) { src = (const unsigned char*)d_out; mode = 2; nch = 1; }
        if (DBG_K == 7) { src = ws + WS_YPOOL; mode = 1; nch = 1; }
        if (DBG_K == 8) { src = d_out; mode = 1; nch = 1; }
        if (DBG_K == 1) { src = d_out; mode = 1; nch = 1; }
        if (DBG_K == 4) { src = ws + WS_DT; mode = 0; nch = 1; }
        if (src == (const void*)d_out) { (void)hipMemcpyAsync((unsigned char*)d_ws + WS_XR, d_out, 64 * MiB, hipMemcpyDeviceToDevice, stream); src = ws + WS_XR; }
        hipLaunchKernelGGL(dbg_dump, dim3(2048), dim3(256), 0, stream, (float*)d_out, src, mode, nch);
    }
#else
    a.ph_lo = 0; a.ph_hi = 14;
    void* args[] = {&a};
    hipError_t e = hipLaunchCooperativeKernel((const void*)fwd_megakernel, dim3(grid_blocks), dim3(NTHREADS), args, LDS_BYTES, stream);
    if (e != hipSuccess) fprintf(stderr, "cooperative launch failed: %s (grid %d)\n", hipGetErrorString(e), grid_blocks);
#endif
}
```

```cpp
#include <hip/hip_runtime.h>
#include <hip/hip_cooperative_groups.h>
#include <cstdio>
namespace cg = cooperative_groups;

#define LAS __attribute__((address_space(3)))
typedef unsigned short bf16_t;
typedef short bf16x8 __attribute__((ext_vector_type(8)));
typedef float f32x4 __attribute__((ext_vector_type(4)));
typedef float f32x2 __attribute__((ext_vector_type(2)));
typedef unsigned u32x4 __attribute__((ext_vector_type(4)));
typedef unsigned u32x2 __attribute__((ext_vector_type(2)));

constexpr int BATCH = 4, SEQ = 4096, D = 1024, M = BATCH * SEQ, FF = 2816, NPROJ = 4096, DINP = 4112, DXBC = 2048, NMOD = 9 * D;
constexpr int NCHUNK = 32, NHEAD = 16;
constexpr float EPS = 1e-6f;
constexpr int NWAVES = 8, NTHREADS = 512;
constexpr int LDS_BYTES = 147456;

constexpr size_t KiB = 1024, MiB = 1u << 20;
constexpr size_t WS_MOD = 0, WS_CDEC = 256 * KiB, WS_WDT = 512 * KiB, WS_BAR = 768 * KiB, BAR_BYTES = 16 * KiB, WS_DT = 2 * MiB;
constexpr size_t WS_WPOOL = 4 * MiB, WS_WOUT = WS_WPOOL + MiB / 2, WS_WGU2 = WS_WOUT + 4 * MiB, WS_WD2 = WS_WGU2 + 11 * MiB, WS_WGU1 = WS_WD2 + 11 * MiB / 2,
                 WS_WD1 = WS_WGU1 + 11 * MiB, WS_WIN = WS_WD1 + 11 * MiB / 2, WS_XR = WS_WIN + 8 * MiB, WS_R2 = WS_XR + 64 * MiB;
constexpr size_t WS_ACT = WS_R2, WS_Z = WS_R2, WS_XBC = WS_R2 + 32 * MiB, WS_U = WS_R2 + 96 * MiB, WS_YPOOL = WS_U, WS_END = WS_U + 32 * MiB;
static_assert(WS_END <= 256 * MiB, "ws map");
static_assert(WS_ACT + (size_t)M * FF * 2 <= 256 * MiB, "ws map act");
constexpr size_t DO_H = 0, DO_STATES = 32 * MiB;

__device__ __forceinline__ float wave_sum(float v) {
#pragma unroll
    for (int o = 1; o < 64; o <<= 1) v += __shfl_xor(v, o);
    return v;
}
typedef __bf16 bf16x2_t __attribute__((ext_vector_type(2)));
__device__ __forceinline__ unsigned cvt_pk_bf16(float lo, float hi) { f32x2 v = {lo, hi}; bf16x2_t r = __builtin_convertvector(v, bf16x2_t); return __builtin_bit_cast(unsigned, r); }
__device__ __forceinline__ float bf_lo(unsigned u) { return __uint_as_float(u << 16); }
__device__ __forceinline__ float bf_hi(unsigned u) { return __uint_as_float(u & 0xffff0000u); }
__device__ __forceinline__ float siluf(float x) { return x * __builtin_amdgcn_rcpf(1.f + __builtin_amdgcn_exp2f(-1.44269504f * x)); }
#define LDS_WAIT() asm volatile("s_waitcnt lgkmcnt(0)" ::: "memory")

namespace pg8 {
constexpr int BM = 256, BK = 64, HALF = 128, HTB = HALF * BK * 2, STAGE_BYTES = 8 * HTB, NXCD = 8, WGM = 8;
__device__ __forceinline__ int lds_byte(int r, int c) { const int st = (r >> 4) * 2 + (c >> 5), rr = r & 15, cc = c & 31, ob = rr * 64 + cc * 2; return st * 1024 + (ob ^ (((ob >> 9) & 1) << 5)); }
__device__ __forceinline__ void stage_rc(int b, int& R, int& C) { const int st = b / 1024, sb = b % 1024, swz = sb ^ (((sb >> 9) & 1) << 5); R = (st >> 1) * 16 + swz / 64; C = (st & 1) * 32 + (swz % 64) / 2; }
struct Unit { int pm, pn; };
struct Gemm { const bf16_t* A; const bf16_t* A2; const bf16_t* Bt; int M, N, K, lda, ldb, ksplit, a_pn_off; };
struct StaticOrder {
    int nM, nN, nwg, G, c;
    __device__ void init(int M_, int N_, int G_, int c_) { nM = M_ / BM; nN = N_ / BM; nwg = nM * nN; G = G_; c = c_; }
    __device__ bool next(int i, Unit& u) const {
        const long L = (long)i * G + c; if (L >= nwg) return false;
        int wgid = (int)L; { const int q = nwg / NXCD, r = nwg % NXCD, xcd = wgid % NXCD, off = wgid / NXCD; wgid = (xcd < r ? xcd * (q + 1) : r * (q + 1) + (xcd - r) * q) + off; }
        const int nig = WGM * nN, gid = wgid / nig, fm = gid * WGM, gsz = (nM - fm) < WGM ? (nM - fm) : WGM;
        u.pm = fm + ((wgid % nig) % gsz); u.pn = (wgid % nig) / gsz; return true;
    }
};
template <class Epi>
__device__ __forceinline__ void gemm_phase(LAS unsigned char* lds, const Gemm g, const StaticOrder& S, const Epi& E) {
    int tid = threadIdx.x; asm volatile("" : "+v"(tid));
    const int wid = __builtin_amdgcn_readfirstlane(tid >> 6), lane = tid & 63, wr = wid >> 2, wc = wid & 3, fr = lane & 15, fq = lane >> 4;
    int nt = g.K / BK, ksplit = g.ksplit;
    asm volatile("" : "+s"(nt), "+s"(ksplit));
    unsigned voffA[2], voffB[2];
#pragma unroll
    for (int i = 0; i < 2; ++i) { int R, C; stage_rc(tid * 16 + i * 8192, R, C); voffA[i] = (unsigned)(R * g.lda + C) * 2u; voffB[i] = (unsigned)(R * g.ldb + C) * 2u; }
    const size_t kstep = (size_t)(BK * 2);
    const size_t hstepA = (size_t)HALF * g.lda * 2, hstepB = (size_t)HALF * g.ldb * 2;
    const size_t tstepA = 2 * hstepA, tstepB = 2 * hstepB;
    const unsigned ldsw = (unsigned)wid * 1024u;
    const int aoff = lds_byte(wr * 64 + fr, fq * 8), boff = lds_byte(wc * 32 + fr, fq * 8);
#define PG8_SA(b, h) (((b) * 2 + (h)) * HTB)
#define PG8_SB(b, h) ((4 + (b) * 2 + (h)) * HTB)
#define PG8_STAGE(bufoff, gbase, voff) do { _Pragma("unroll") for (int _i = 0; _i < 2; ++_i) \
        __builtin_amdgcn_global_load_lds((const unsigned*)((const char*)(gbase) + (voff)[_i]), (LAS unsigned*)(lds + (bufoff) + ldsw + _i * 8192), 16, 0, 0); } while (0)
#define PG8_LDA(dst, b, h) do { _Pragma("unroll") for (int m = 0; m < 4; ++m) _Pragma("unroll") for (int k = 0; k < 2; ++k) dst[m][k] = *(const LAS bf16x8*)(lds + PG8_SA(b, h) + aoff + m * 2048 + k * 1024); } while (0)
#define PG8_LDB(dst, b, h) do { _Pragma("unroll") for (int n = 0; n < 2; ++n) _Pragma("unroll") for (int k = 0; k < 2; ++k) dst[n][k] = *(const LAS bf16x8*)(lds + PG8_SB(b, h) + boff + n * 2048 + k * 1024); } while (0)
#define PG8_MMA(ai, bj, At, Bt) do { __builtin_amdgcn_s_setprio(1); _Pragma("unroll") for (int m = 0; m < 4; ++m) _Pragma("unroll") for (int n = 0; n < 2; ++n) _Pragma("unroll") for (int k = 0; k < 2; ++k) \
        acc[ai][bj][m][n] = __builtin_amdgcn_mfma_f32_16x16x32_bf16(Bt[n][k], At[m][k], acc[ai][bj][m][n], 0, 0, 0); __builtin_amdgcn_s_setprio(0); } while (0)
#define PG8_WAIT_V(n) asm volatile("s_waitcnt vmcnt(" #n ")" ::: "memory")
#define PG8_WAIT_L(n) asm volatile("s_waitcnt lgkmcnt(" #n ")" ::: "memory")
#define PG8_BAR __builtin_amdgcn_s_barrier()
#define PG8_SCHED __builtin_amdgcn_sched_barrier(0)
#define PG8_TILEA(c1, c2, t) ((t) < ksplit ? (c1) + (size_t)(t) * kstep : (c2) + (size_t)((t) - ksplit) * kstep)
    Unit cur, nxt; int ui = 0;
    if (!S.next(0, cur)) return;
    f32x4 acc[2][2][4][2];
#pragma unroll
    for (int a = 0; a < 2; ++a)
#pragma unroll
        for (int b = 0; b < 2; ++b)
#pragma unroll
            for (int m = 0; m < 4; ++m)
#pragma unroll
                for (int n = 0; n < 2; ++n) acc[a][b][m][n] = (f32x4){0.f, 0.f, 0.f, 0.f};
    bf16x8 At[4][2], B0[2][2], B1[2][2];
    const char* cA = (const char*)g.A + (size_t)cur.pm * tstepA + (size_t)cur.pn * g.a_pn_off * 2;
    const char* cA2 = (const char*)g.A2 + (size_t)cur.pm * tstepA + (size_t)cur.pn * g.a_pn_off * 2;
    const char* cB = (const char*)g.Bt + (size_t)cur.pn * tstepB;
    PG8_STAGE(PG8_SB(0, 0), cB, voffB); PG8_STAGE(PG8_SA(0, 0), cA, voffA); PG8_STAGE(PG8_SB(0, 1), cB + hstepB, voffB); PG8_STAGE(PG8_SA(0, 1), cA + hstepA, voffA);
    if (wr == 1) PG8_BAR;
    PG8_WAIT_V(4); PG8_BAR;
    PG8_STAGE(PG8_SB(1, 0), cB + kstep, voffB); PG8_STAGE(PG8_SA(1, 0), cA + kstep, voffA); PG8_STAGE(PG8_SB(1, 1), cB + hstepB + kstep, voffB);
    PG8_WAIT_V(6); PG8_BAR;
    for (;;) {
        const bool has_next = S.next(ui + 1, nxt);
        const char* nA = has_next ? (const char*)g.A + (size_t)nxt.pm * tstepA + (size_t)nxt.pn * g.a_pn_off * 2 : cA;
        const char* nA2 = has_next ? (const char*)g.A2 + (size_t)nxt.pm * tstepA + (size_t)nxt.pn * g.a_pn_off * 2 : cA2;
        const char* nB = has_next ? (const char*)g.Bt + (size_t)nxt.pn * tstepB : cB;
        for (int t = 0; t < nt; t += 2) {
            const bool last = (t == nt - 2);
            const char* a1 = PG8_TILEA(cA, cA2, t + 1);
            const char* a2 = last ? nA : PG8_TILEA(cA, cA2, t + 2); const char* b2 = last ? nB : cB + (size_t)(t + 2) * kstep;
            const char* a3 = a2 + kstep; const char* b3 = b2 + kstep;
            PG8_LDB(B0, 0, 0); PG8_SCHED; PG8_LDA(At, 0, 0); PG8_STAGE(PG8_SA(1, 1), a1 + hstepA, voffA);
            PG8_WAIT_L(8); PG8_BAR; PG8_WAIT_L(0); PG8_MMA(0, 0, At, B0); PG8_BAR; PG8_SCHED;
            PG8_LDB(B1, 0, 1); PG8_STAGE(PG8_SB(0, 0), b2, voffB);
            PG8_BAR; PG8_WAIT_L(0); PG8_MMA(0, 1, At, B1); PG8_BAR;
            PG8_LDA(At, 0, 1); PG8_STAGE(PG8_SA(0, 0), a2, voffA);
            PG8_BAR; PG8_WAIT_L(0); PG8_MMA(1, 0, At, B0); PG8_BAR; PG8_SCHED;
            PG8_STAGE(PG8_SB(0, 1), b2 + hstepB, voffB);
            PG8_WAIT_V(6); PG8_BAR; PG8_MMA(1, 1, At, B1); PG8_BAR;
            PG8_LDB(B0, 1, 0); PG8_SCHED; PG8_LDA(At, 1, 0); PG8_STAGE(PG8_SA(0, 1), a2 + hstepA, voffA);
            PG8_WAIT_L(8); PG8_BAR; PG8_WAIT_L(0); PG8_MMA(0, 0, At, B0); PG8_BAR; PG8_SCHED;
            PG8_LDB(B1, 1, 1); PG8_STAGE(PG8_SB(1, 0), b3, voffB);
            PG8_BAR; PG8_WAIT_L(0); PG8_MMA(0, 1, At, B1); PG8_BAR;
            PG8_LDA(At, 1, 1); PG8_STAGE(PG8_SA(1, 0), a3, voffA);
            PG8_BAR; PG8_WAIT_L(0); PG8_MMA(1, 0, At, B0); PG8_BAR; PG8_SCHED;
            PG8_STAGE(PG8_SB(1, 1), b3 + hstepB, voffB);
            PG8_WAIT_V(6); PG8_BAR; PG8_MMA(1, 1, At, B1); PG8_BAR;
        }
        E(acc, cur, wr, wc, fr, fq);
        if (!has_next) break;
#pragma unroll
        for (int a = 0; a < 2; ++a)
#pragma unroll
            for (int b = 0; b < 2; ++b)
#pragma unroll
                for (int m = 0; m < 4; ++m)
#pragma unroll
                    for (int n = 0; n < 2; ++n) acc[a][b][m][n] = (f32x4){0.f, 0.f, 0.f, 0.f};
        cur = nxt; cA = nA; cA2 = nA2; cB = nB; ++ui;
    }
    PG8_WAIT_V(0);
    if (wr == 0) PG8_BAR;
    PG8_BAR;
#undef PG8_SA
#undef PG8_SB
#undef PG8_STAGE
#undef PG8_LDA
#undef PG8_LDB
#undef PG8_MMA
#undef PG8_WAIT_V
#undef PG8_WAIT_L
#undef PG8_BAR
#undef PG8_SCHED
#undef PG8_TILEA
}

struct EpiSwiGLU {
    bf16_t* O;
    __device__ __forceinline__ void operator()(const f32x4 (&acc)[2][2][4][2], const Unit& u, int wr, int wc, int fr, int fq) const {
        const int row0 = u.pm * BM + wr * 64 + fr, col0 = u.pn * HALF + wc * 32 + 4 * fq;
#pragma unroll
        for (int ai = 0; ai < 2; ++ai)
#pragma unroll
            for (int m = 0; m < 4; ++m) { bf16_t* rowp = O + (size_t)(row0 + ai * HALF + m * 16) * FF + col0;
#pragma unroll
                for (int n = 0; n < 2; ++n) { const f32x4 gt = acc[ai][0][m][n], up = acc[ai][1][m][n];
                    u32x2 w; w.x = cvt_pk_bf16(siluf(gt[0]) * up[0], siluf(gt[1]) * up[1]); w.y = cvt_pk_bf16(siluf(gt[2]) * up[2], siluf(gt[3]) * up[3]);
                    *(u32x2*)(rowp + n * 16) = w; } }
    }
};
struct EpiResid {
    const float* base; float* out; const float* gate; float scale;
    __device__ __forceinline__ void operator()(const f32x4 (&acc)[2][2][4][2], const Unit& u, int wr, int wc, int fr, int fq) const {
        const int row0 = u.pm * BM + wr * 64 + fr, col0 = u.pn * BM + wc * 32 + 4 * fq, b = u.pm >> 4;
        f32x4 gv[2][2];
#pragma unroll
        for (int bj = 0; bj < 2; ++bj)
#pragma unroll
            for (int n = 0; n < 2; ++n) gv[bj][n] = *(const f32x4*)(gate + (size_t)b * NMOD + col0 + bj * HALF + n * 16) * scale;
#pragma unroll
        for (int ai = 0; ai < 2; ++ai)
#pragma unroll
            for (int m = 0; m < 4; ++m) { const size_t off = (size_t)(row0 + ai * HALF + m * 16) * D + col0;
#pragma unroll
                for (int bj = 0; bj < 2; ++bj)
#pragma unroll
                    for (int n = 0; n < 2; ++n) { const f32x4 bs = *(const f32x4*)(base + off + bj * HALF + n * 16);
                        *(f32x4*)(out + off + bj * HALF + n * 16) = bs + gv[bj][n] * acc[ai][bj][m][n]; } }
    }
};
struct EpiSplit {
    bf16_t* Z; bf16_t* XBC; bf16_t* U;
    __device__ __forceinline__ void operator()(const f32x4 (&acc)[2][2][4][2], const Unit& u, int wr, int wc, int fr, int fq) const {
        bf16_t* basep; int ld, c0;
        if (u.pn < 4) { basep = Z; ld = 1024; c0 = u.pn * BM; } else if (u.pn < 12) { basep = XBC; ld = 2048; c0 = (u.pn - 4) * BM; } else { basep = U; ld = 1024; c0 = (u.pn - 12) * BM; }
        const int row0 = u.pm * BM + wr * 64 + fr, col0 = c0 + wc * 32 + 4 * fq;
#pragma unroll
        for (int ai = 0; ai < 2; ++ai)
#pragma unroll
            for (int m = 0; m < 4; ++m) { bf16_t* rowp = basep + (size_t)(row0 + ai * HALF + m * 16) * ld + col0;
#pragma unroll
                for (int bj = 0; bj < 2; ++bj)
#pragma unroll
                    for (int n = 0; n < 2; ++n) { const f32x4 v = acc[ai][bj][m][n]; u32x2 w; w.x = cvt_pk_bf16(v[0], v[1]); w.y = cvt_pk_bf16(v[2], v[3]);
                        *(u32x2*)(rowp + bj * HALF + n * 16) = w; } }
    }
};
struct EpiPool {
    bf16_t* O; const float* bias; const float* scl;
    __device__ __forceinline__ void operator()(const f32x4 (&acc)[2][2][4][2], const Unit& u, int wr, int wc, int fr, int fq) const {
        const int row0 = u.pm * BM + wr * 64 + fr, col0 = u.pn * BM + wc * 32 + 4 * fq;
        f32x4 bv[2][2], sv[2][2];
#pragma unroll
        for (int bj = 0; bj < 2; ++bj)
#pragma unroll
            for (int n = 0; n < 2; ++n) { bv[bj][n] = *(const f32x4*)(bias + col0 + bj * HALF + n * 16); sv[bj][n] = *(const f32x4*)(scl + col0 + bj * HALF + n * 16); }
#pragma unroll
        for (int ai = 0; ai < 2; ++ai)
#pragma unroll
            for (int m = 0; m < 4; ++m) { bf16_t* rowp = O + (size_t)(row0 + ai * HALF + m * 16) * 1024 + col0;
#pragma unroll
                for (int bj = 0; bj < 2; ++bj)
#pragma unroll
                    for (int n = 0; n < 2; ++n) { const f32x4 v = (acc[ai][bj][m][n] + bv[bj][n]) * sv[bj][n]; u32x2 w; w.x = cvt_pk_bf16(v[0], v[1]); w.y = cvt_pk_bf16(v[2], v[3]);
                        *(u32x2*)(rowp + bj * HALF + n * 16) = w; } }
    }
};
}

struct Args { const float* in[25]; float* out; unsigned char* ws; int ph_lo, ph_hi; };
enum { I_X = 0, I_C, I_WADA, I_BADA, I_N1, I_G1, I_U1, I_D1, I_NMIX, I_WIN, I_CONVW, I_CONVB, I_DTB, I_ALOG, I_DSKIP, I_SSDNW, I_POOLW, I_POOLB, I_POOLS, I_WOUT, I_N2, I_G2, I_U2, I_D2, I_NF };

__device__ __forceinline__ void p0_transpose_item(const float* W, int ldw, int K, bf16_t* WT, int dst_row0, int n0, int k0, LAS float* scr, int lane) {
    const int lr = lane >> 3, lc = (lane & 7) * 4;
    f32x4 v[8];
#pragma unroll
    for (int i = 0; i < 8; ++i) v[i] = *(const f32x4*)(W + (size_t)(k0 + 8 * i + lr) * ldw + n0 + lc);
#pragma unroll
    for (int i = 0; i < 8; ++i) { LAS float* d = scr + (8 * i + lr) * 33 + lc; d[0] = v[i].x; d[1] = v[i].y; d[2] = v[i].z; d[3] = v[i].w; }
    LDS_WAIT();
    const int c = lane & 7;
#pragma unroll
    for (int j = 0; j < 4; ++j) { const int n = (lane >> 3) + 8 * j; const LAS float* sp = scr + (8 * c) * 33 + n;
        u32x4 o; o.x = cvt_pk_bf16(sp[0 * 33], sp[1 * 33]); o.y = cvt_pk_bf16(sp[2 * 33], sp[3 * 33]); o.z = cvt_pk_bf16(sp[4 * 33], sp[5 * 33]); o.w = cvt_pk_bf16(sp[6 * 33], sp[7 * 33]);
        *(u32x4*)(WT + (size_t)(dst_row0 + n) * K + k0 + 8 * c) = o; }
    LDS_WAIT();
}
__device__ __forceinline__ void p0_mat_item(const float* W, int ldw, int K, int nb, int csrc, bf16_t* WT, int drow_base, int mode, int it, LAS float* scr, int lane) {
    const int kb = it / nb, nbi = it % nb, n0 = 32 * nbi;
    int drow = drow_base + n0;
    if (mode == 1) drow = (n0 >> 7) * 256 + (n0 & 127) + drow_base;
    p0_transpose_item(W, ldw, K, WT, drow, csrc + n0, 64 * kb, scr, lane);
}
__device__ __forceinline__ void p0_transposes(const Args& a, LAS unsigned char* lds, int part, int gw, int NGW, int lane, int wave) {
    unsigned char* ws = a.ws;
    LAS float* scr = (LAS float*)(lds + wave * 8448);
    constexpr int I_GU = (D / 64) * (FF / 32), I_DN = (FF / 64) * (D / 32), I_ZZ = (D / 64) * 32, I_XB = (D / 64) * 64, I_OUT = (2048 / 64) * 32, I_PL = 4 * 8;
    if (part == 0) {
        for (int it = gw; it < 2 * I_GU + I_DN; it += NGW) {
            int r = it;
            if (r < I_GU) { p0_mat_item(a.in[I_G1], FF, D, FF / 32, 0, (bf16_t*)(ws + WS_WGU1), 0, 1, r, scr, lane); continue; } r -= I_GU;
            if (r < I_GU) { p0_mat_item(a.in[I_U1], FF, D, FF / 32, 0, (bf16_t*)(ws + WS_WGU1), 128, 1, r, scr, lane); continue; } r -= I_GU;
            p0_mat_item(a.in[I_D1], D, FF, D / 32, 0, (bf16_t*)(ws + WS_WD1), 0, 0, r, scr, lane);
        }
    } else {
        constexpr int NITEMS = 2 * I_GU + I_DN + 2 * I_ZZ + I_XB + I_OUT + 4 * I_PL;
        for (int it = gw; it < NITEMS; it += NGW) {
            int r = it;
            if (r < I_ZZ) { p0_mat_item(a.in[I_WIN], DINP, D, 32, 0, (bf16_t*)(ws + WS_WIN), 0, 0, r, scr, lane); continue; } r -= I_ZZ;
            if (r < I_XB) { p0_mat_item(a.in[I_WIN], DINP, D, 64, 1024, (bf16_t*)(ws + WS_WIN), 1024, 0, r, scr, lane); continue; } r -= I_XB;
            if (r < I_ZZ) { p0_mat_item(a.in[I_WIN], DINP, D, 32, 3088, (bf16_t*)(ws + WS_WIN), 3072, 0, r, scr, lane); continue; } r -= I_ZZ;
            if (r < I_OUT) { p0_mat_item(a.in[I_WOUT], D, 2048, 32, 0, (bf16_t*)(ws + WS_WOUT), 0, 0, r, scr, lane); continue; } r -= I_OUT;
            if (r < 4 * I_PL) { const int gq = r / I_PL; p0_mat_item(a.in[I_POOLW] + (size_t)gq * 65536, 256, 256, 8, 0, (bf16_t*)(ws + WS_WPOOL), gq * 256, 0, r % I_PL, scr, lane); continue; } r -= 4 * I_PL;
            if (r < I_GU) { p0_mat_item(a.in[I_G2], FF, D, FF / 32, 0, (bf16_t*)(ws + WS_WGU2), 0, 1, r, scr, lane); continue; } r -= I_GU;
            if (r < I_GU) { p0_mat_item(a.in[I_U2], FF, D, FF / 32, 0, (bf16_t*)(ws + WS_WGU2), 128, 1, r, scr, lane); continue; } r -= I_GU;
            p0_mat_item(a.in[I_D2], D, FF, D / 32, 0, (bf16_t*)(ws + WS_WD2), 0, 0, r, scr, lane);
        }
    }
}
__device__ __forceinline__ void p0_phase(const Args& a, LAS unsigned char* lds, int tid, int lane, int wave, int G) {
    unsigned char* ws = a.ws;
    {
        LAS float* cact = (LAS float*)(lds + 69632);
        LAS float* red = (LAS float*)(lds + 69632 + 16384);
        if ((int)blockIdx.x < NMOD / 64) {
            for (int i = tid; i < 4 * D; i += NTHREADS) { const float cv = a.in[I_C][i]; cact[i] = cv / (1.f + __expf(-cv)); }
            __syncthreads();
        }
        for (int it = blockIdx.x; it < NMOD / 64; it += G) {
            const int j = it * 64 + lane, kb = wave * 128;
            float s0 = 0.f, s1 = 0.f, s2 = 0.f, s3 = 0.f;
            const float* wp = a.in[I_WADA] + (size_t)kb * NMOD + j;
#pragma unroll 8
            for (int k = 0; k < 128; ++k) { const float wv = wp[(size_t)k * NMOD];
                s0 += cact[kb + k] * wv; s1 += cact[D + kb + k] * wv; s2 += cact[2 * D + kb + k] * wv; s3 += cact[3 * D + kb + k] * wv; }
            red[(wave * 4 + 0) * 64 + lane] = s0; red[(wave * 4 + 1) * 64 + lane] = s1; red[(wave * 4 + 2) * 64 + lane] = s2; red[(wave * 4 + 3) * 64 + lane] = s3;
            __syncthreads();
            if (wave < 4) { float t = a.in[I_BADA][j];
#pragma unroll
                for (int w = 0; w < 8; ++w) t += red[(w * 4 + wave) * 64 + lane];
                ((float*)(ws + WS_MOD))[wave * NMOD + j] = t; }
            __syncthreads();
        }
    }
    for (int idx = blockIdx.x * NTHREADS + tid; idx < 16 * D; idx += G * NTHREADS) { const int k = idx >> 4, j = idx & 15; ((float*)(ws + WS_WDT))[j * D + k] = a.in[I_WIN][(size_t)k * DINP + 3072 + j]; }
    p0_transposes(a, lds, 0, blockIdx.x * NWAVES + wave, G * NWAVES, lane, wave);
}

template <bool DTP>
__device__ __forceinline__ void norm_phase(LAS unsigned char* lds, const float* src, const float* nw, const float* mod, int sh_off, int sc_off, bf16_t* dst,
                                           const float* wdt, const float* dt_bias, float* DT, int tid, int lane, int wave, int G) {
    LAS f32x4* wl = (LAS f32x4*)lds;
    if (DTP) { for (int i = tid; i < 16 * D / 4; i += NTHREADS) wl[i] = ((const f32x4*)wdt)[i]; __syncthreads(); }
    const int gw = blockIdx.x * NWAVES + wave, NGW = G * NWAVES;
    for (int rg = gw; rg < M / 8; rg += NGW) {
        const int row0 = rg * 8, b = row0 >> 12;
        f32x4 Am[4], Bm[4];
#pragma unroll
        for (int j = 0; j < 4; ++j) { const int col = 4 * lane + 256 * j;
            const f32x4 w = *(const f32x4*)(nw + col), sc = *(const f32x4*)(mod + (size_t)b * NMOD + sc_off + col);
            Am[j] = w * (sc + 1.f); Bm[j] = *(const f32x4*)(mod + (size_t)b * NMOD + sh_off + col); }
#pragma unroll 1
        for (int half = 0; half < 2; ++half) {
            f32x4 o[4][4];
#pragma unroll
            for (int r = 0; r < 4; ++r) {
                const int row = row0 + half * 4 + r;
                float ss = 0.f;
#pragma unroll
                for (int j = 0; j < 4; ++j) { o[r][j] = *(const f32x4*)(src + (size_t)row * D + 4 * lane + 256 * j); ss += (o[r][j].x * o[r][j].x + o[r][j].y * o[r][j].y) + (o[r][j].z * o[r][j].z + o[r][j].w * o[r][j].w); }
                const float rstd = rsqrtf(wave_sum(ss) * (1.f / D) + EPS);
#pragma unroll
                for (int j = 0; j < 4; ++j) { o[r][j] = o[r][j] * rstd * Am[j] + Bm[j];
                    u32x2 w; w.x = cvt_pk_bf16(o[r][j].x, o[r][j].y); w.y = cvt_pk_bf16(o[r][j].z, o[r][j].w);
                    *(u32x2*)(dst + (size_t)row * D + 4 * lane + 256 * j) = w; }
            }
            if (DTP) {
                float mine = 0.f;
                __builtin_amdgcn_sched_barrier(0);
#pragma unroll 1
                for (int jj = 0; jj < 16; ++jj) {
                    f32x4 wv[4];
#pragma unroll
                    for (int j = 0; j < 4; ++j) wv[j] = wl[jj * 256 + 64 * j + lane];
#pragma unroll
                    for (int r = 0; r < 4; ++r) { float p = 0.f;
#pragma unroll
                        for (int j = 0; j < 4; ++j) p += (o[r][j].x * wv[j].x + o[r][j].y * wv[j].y) + (o[r][j].z * wv[j].z + o[r][j].w * wv[j].w);
                        const float t = wave_sum(p); if (lane == r * 16 + jj) mine = t; }
                }
                const float xv = mine + dt_bias[lane & 15];
                DT[(size_t)(row0 + half * 4 + (lane >> 4)) * 16 + (lane & 15)] = xv > 20.f ? xv : log1pf(__expf(xv));
            }
        }
    }
}
__device__ __forceinline__ void final_norm_phase(float* xio, const float* nw, int lane, int wave, int G) {
    const int gw = blockIdx.x * NWAVES + wave, NGW = G * NWAVES;
    f32x4 wv[4];
#pragma unroll
    for (int j = 0; j < 4; ++j) wv[j] = *(const f32x4*)(nw + 4 * lane + 256 * j);
    for (int rg = gw; rg < M / 4; rg += NGW) {
        f32x4 v[4][4]; float ss[4];
#pragma unroll
        for (int r = 0; r < 4; ++r)
#pragma unroll
            for (int j = 0; j < 4; ++j) v[r][j] = *(const f32x4*)(xio + (size_t)(rg * 4 + r) * D + 4 * lane + 256 * j);
#pragma unroll
        for (int r = 0; r < 4; ++r) { ss[r] = 0.f;
#pragma unroll
            for (int j = 0; j < 4; ++j) ss[r] += (v[r][j].x * v[r][j].x + v[r][j].y * v[r][j].y) + (v[r][j].z * v[r][j].z + v[r][j].w * v[r][j].w); }
#pragma unroll
        for (int r = 0; r < 4; ++r) { const float rstd = rsqrtf(wave_sum(ss[r]) * (1.f / D) + EPS);
#pragma unroll
            for (int j = 0; j < 4; ++j) *(f32x4*)(xio + (size_t)(rg * 4 + r) * D + 4 * lane + 256 * j) = v[r][j] * rstd * wv[j]; }
    }
}

__device__ __forceinline__ void unpack8(const u32x4 v, float (&f)[8]) { f[0] = bf_lo(v.x); f[1] = bf_hi(v.x); f[2] = bf_lo(v.y); f[3] = bf_hi(v.y); f[4] = bf_lo(v.z); f[5] = bf_hi(v.z); f[6] = bf_lo(v.w); f[7] = bf_hi(v.w); }
__device__ __forceinline__ void diff_item(const bf16_t* U, bf16_t* DIFF, int item, int tid) {
    const int oct = tid & 127, sub = tid >> 7, t0 = item * 32 + sub * 8, pos0 = t0 & (SEQ - 1), w = 2 << (oct >> 5);
    const bf16_t* up = U + (size_t)t0 * 1024 + oct * 8;
    float S[8], f[8];
#pragma unroll
    for (int e = 0; e < 8; ++e) S[e] = 0.f;
    for (int j = 1; j <= w; ++j) if (pos0 - j >= 0) { unpack8(*(const u32x4*)(up - (size_t)j * 1024), f);
#pragma unroll
        for (int e = 0; e < 8; ++e) S[e] += f[e]; }
#pragma unroll
    for (int i = 0; i < 8; ++i) {
        const int pos = pos0 + i;
        unpack8(*(const u32x4*)(up + (size_t)i * 1024), f);
#pragma unroll
        for (int e = 0; e < 8; ++e) S[e] += f[e];
        if (pos >= w) { float q[8]; unpack8(*(const u32x4*)(up + (size_t)(i - w) * 1024), q);
#pragma unroll
            for (int e = 0; e < 8; ++e) S[e] -= q[e]; }
        const float inv = 1.f / (float)(pos + 1 < w ? pos + 1 : w);
        u32x4 o; o.x = cvt_pk_bf16(S[0] * inv - f[0], S[1] * inv - f[1]); o.y = cvt_pk_bf16(S[2] * inv - f[2], S[3] * inv - f[3]);
        o.z = cvt_pk_bf16(S[4] * inv - f[4], S[5] * inv - f[5]); o.w = cvt_pk_bf16(S[6] * inv - f[6], S[7] * inv - f[7]);
        *(u32x4*)(DIFF + (size_t)(t0 + i) * 1024 + oct * 8) = o;
    }
}

constexpr int LP = 272;
constexpr int L_C = 0, L_B = 128 * LP, L_XT = 2 * 128 * LP, L_ACS = L_XT + 4 * 64 * LP, L_DTV = L_ACS + 2048, L_SSD_END = L_DTV + 2048;
static_assert(L_SSD_END <= LDS_BYTES, "ssd lds");

__device__ __forceinline__ void ssd_cumsum(LAS unsigned char* lds, const float* DT, const float* a_log, int T0, int g, int lane, int wave) {
    if (wave < 4) {
        const int h = 4 * g + wave; const float av = -__expf(a_log[h]);
        const int t = 2 * lane;
        const float d0 = DT[(size_t)(T0 + t) * 16 + h], d1 = DT[(size_t)(T0 + t + 1) * 16 + h];
        const float v0 = d0 * av, v1 = d1 * av, s = v0 + v1;
        float inc = s;
#pragma unroll
        for (int o = 1; o < 64; o <<= 1) { const float n = __shfl_up(inc, o); if (lane >= o) inc += n; }
        const float exc = inc - s;
        LAS float* acs = (LAS float*)(lds + L_ACS) + wave * 128; LAS float* dtv = (LAS float*)(lds + L_DTV) + wave * 128;
        acs[t] = exc + v0; acs[t + 1] = exc + s; dtv[t] = d0; dtv[t + 1] = d1;
    }
}
template <int MODE>
__device__ __forceinline__ void ssd_stage(LAS unsigned char* lds, const bf16_t* XBC, const float* conv_w, const float* conv_b, int T0, int c, int g, int tid) {
    const LAS float* acs = (const LAS float*)(lds + L_ACS); const LAS float* dtv = (const LAS float*)(lds + L_DTV);
    constexpr int O_LO = (MODE == 0) ? 16 : 0, NO = 64 - O_LO;
#pragma unroll 1
    for (int task = tid; task < NO * 16; task += NTHREADS) {
        const int o = O_LO + task % NO, sg = task / NO;
        const int ch = (o < 16) ? (1536 + g * 128 + o * 8) : (o < 32) ? (1024 + g * 128 + (o - 16) * 8) : (g * 256 + (o - 32) * 8);
        float w[4][8], bs[8];
#pragma unroll
        for (int k = 0; k < 4; ++k) { const f32x4 w0 = *(const f32x4*)(conv_w + k * DXBC + ch), w1 = *(const f32x4*)(conv_w + k * DXBC + ch + 4);
            w[k][0] = w0.x; w[k][1] = w0.y; w[k][2] = w0.z; w[k][3] = w0.w; w[k][4] = w1.x; w[k][5] = w1.y; w[k][6] = w1.z; w[k][7] = w1.w; }
        { const f32x4 b0 = *(const f32x4*)(conv_b + ch), b1 = *(const f32x4*)(conv_b + ch + 4);
          bs[0] = b0.x; bs[1] = b0.y; bs[2] = b0.z; bs[3] = b0.w; bs[4] = b1.x; bs[5] = b1.y; bs[6] = b1.z; bs[7] = b1.w; }
        const bf16_t* src = XBC + ((size_t)(T0 + sg * 8) - 3) * DXBC + ch;
        float out[8][8];
#pragma unroll
        for (int i = 0; i < 8; ++i)
#pragma unroll
            for (int e = 0; e < 8; ++e) out[i][e] = bs[e];
#pragma unroll
        for (int rr = 0; rr < 11; ++rr) {
            const bool valid = (c * 128 + sg * 8 - 3 + rr) >= 0;
            u32x4 rv = (u32x4){0u, 0u, 0u, 0u};
            if (valid) rv = *(const u32x4*)(src + (size_t)rr * DXBC);
            float f[8]; unpack8(rv, f);
#pragma unroll
            for (int k = 0; k < 4; ++k) { const int i = rr - k;
                if (i >= 0 && i < 8) {
#pragma unroll
                    for (int e = 0; e < 8; ++e) out[i][e] += w[k][e] * f[e]; } }
        }
#pragma unroll
        for (int i = 0; i < 8; ++i)
#pragma unroll
            for (int e = 0; e < 8; ++e) out[i][e] = siluf(out[i][e]);
        if (o >= 32) {
            const int r = (o - 32) >> 3, p0 = ((o - 32) & 7) * 8;
            float sc[8];
#pragma unroll
            for (int i = 0; i < 8; ++i) { const int s = sg * 8 + i; sc[i] = dtv[r * 128 + s]; if (MODE == 0) sc[i] *= __expf(acs[r * 128 + 127] - acs[r * 128 + s]); }
#pragma unroll
            for (int e = 0; e < 8; ++e) { u32x4 v; v.x = cvt_pk_bf16(out[0][e] * sc[0], out[1][e] * sc[1]); v.y = cvt_pk_bf16(out[2][e] * sc[2], out[3][e] * sc[3]);
                v.z = cvt_pk_bf16(out[4][e] * sc[4], out[5][e] * sc[5]); v.w = cvt_pk_bf16(out[6][e] * sc[6], out[7][e] * sc[7]);
                *(LAS u32x4*)(lds + L_XT + (r * 64 + p0 + e) * LP + sg * 16) = v; }
        } else if (MODE == 0) {
            const int n0 = (o - 16) * 8;
#pragma unroll
            for (int e = 0; e < 8; ++e) { u32x4 v; v.x = cvt_pk_bf16(out[0][e], out[1][e]); v.y = cvt_pk_bf16(out[2][e], out[3][e]); v.z = cvt_pk_bf16(out[4][e], out[5][e]); v.w = cvt_pk_bf16(out[6][e], out[7][e]);
                *(LAS u32x4*)(lds + L_C + (n0 + e) * LP + sg * 16) = v; }
        } else {
            const int base = (o < 16) ? L_C : L_B, n0 = (o & 15) * 8;
#pragma unroll
            for (int i = 0; i < 8; ++i) { u32x4 v; v.x = cvt_pk_bf16(out[i][0], out[i][1]); v.y = cvt_pk_bf16(out[i][2], out[i][3]); v.z = cvt_pk_bf16(out[i][4], out[i][5]); v.w = cvt_pk_bf16(out[i][6], out[i][7]);
                *(LAS u32x4*)(lds + base + (sg * 8 + i) * LP + n0 * 2) = v; }
        }
    }
}
#define MFMA16(a, b, c) __builtin_amdgcn_mfma_f32_16x16x32_bf16((a), (b), (c), 0, 0, 0)
#define LFRAG(base, row, kk) (*(const LAS bf16x8*)(lds + (base) + (row) * LP + (kk) * 2))

__device__ __forceinline__ void ssd_states_item(const Args& a, LAS unsigned char* lds, int item, int tid, int lane, int wave) {
    const int g = item & 3, c = (item >> 2) & 31, b = item >> 7, T0 = b * SEQ + c * 128, fr = lane & 15, fq = lane >> 4;
    const float* DT = (const float*)(a.ws + WS_DT);
    __syncthreads();
    ssd_cumsum(lds, DT, a.in[I_ALOG], T0, g, lane, wave);
    __syncthreads();
    if (tid < 4) ((float*)(a.ws + WS_CDEC))[(b * 32 + c) * 16 + 4 * g + tid] = __expf(((const LAS float*)(lds + L_ACS))[tid * 128 + 127]);
    ssd_stage<0>(lds, (const bf16_t*)(a.ws + WS_XBC), a.in[I_CONVW], a.in[I_CONVB], T0, c, g, tid);
    __syncthreads();
    const int r = wave >> 1, p0 = (wave & 1) * 32;
    f32x4 st[2][8];
#pragma unroll
    for (int pf = 0; pf < 2; ++pf)
#pragma unroll
        for (int nf = 0; nf < 8; ++nf) st[pf][nf] = (f32x4){0.f, 0.f, 0.f, 0.f};
#pragma unroll
    for (int ks = 0; ks < 4; ++ks) {
        bf16x8 xf[2];
#pragma unroll
        for (int pf = 0; pf < 2; ++pf) xf[pf] = LFRAG(L_XT, r * 64 + p0 + pf * 16 + fr, ks * 32 + fq * 8);
#pragma unroll
        for (int nf = 0; nf < 8; ++nf) { const bf16x8 bf = LFRAG(L_C, nf * 16 + fr, ks * 32 + fq * 8);
#pragma unroll
            for (int pf = 0; pf < 2; ++pf) st[pf][nf] = MFMA16(bf, xf[pf], st[pf][nf]); }
    }
    bf16_t* SP = (bf16_t*)((unsigned char*)a.out + DO_STATES) + ((size_t)((b * 32 + c) * 16 + 4 * g + r) * 64) * 128;
#ifndef DBG_ST
#define DBG_ST 0
#endif
#if DBG_ST == 1
#pragma unroll
    for (int pf = 0; pf < 2; ++pf)
#pragma unroll
        for (int nf = 0; nf < 8; ++nf) st[pf][nf] = (f32x4){1.f, 2.f, 3.f, 4.f};
#elif DBG_ST == 2
#pragma unroll
    for (int pf = 0; pf < 2; ++pf)
#pragma unroll
        for (int nf = 0; nf < 8; ++nf) { const bf16x8 q = LFRAG(L_XT, r * 64 + p0 + pf * 16 + fr, (nf & 3) * 32 + fq * 8); st[pf][nf] = (f32x4){(float)q[0], (float)q[1], (float)q[6], (float)q[7]}; }
#elif DBG_ST == 3
#pragma unroll
    for (int pf = 0; pf < 2; ++pf)
#pragma unroll
        for (int nf = 0; nf < 8; ++nf) { const bf16x8 q = LFRAG(L_C, nf * 16 + fr, (pf * 2) * 32 + fq * 8); st[pf][nf] = (f32x4){(float)q[0], (float)q[1], (float)q[6], (float)q[7]}; }
#endif
#pragma unroll
    for (int pf = 0; pf < 2; ++pf)
#pragma unroll
        for (int nf = 0; nf < 8; ++nf) { const f32x4 v = st[pf][nf]; u32x2 w; w.x = cvt_pk_bf16(v[0], v[1]); w.y = cvt_pk_bf16(v[2], v[3]);
            *(u32x2*)(SP + (size_t)(p0 + pf * 16 + fr) * 128 + nf * 16 + fq * 4) = w; }
}

__device__ __forceinline__ void scan_phase(const Args& a, LAS unsigned char* lds, int tid, int G) {
    bf16_t* SP = (bf16_t*)((unsigned char*)a.out + DO_STATES);
    const float* CD = (const float*)(a.ws + WS_CDEC);
    LAS float* dl = (LAS float*)lds;
    for (int tb = blockIdx.x; tb < BATCH * NHEAD * 64 * 32 / NTHREADS; tb += G) {
        const int task = tb * NTHREADS + tid;
        const int n4 = task & 31, p = (task >> 5) & 63, h = (task >> 11) & 15, b = task >> 15;
        __syncthreads();
        if (tid < 32) dl[tid] = CD[(b * 32 + tid) * 16 + h];
        u32x2* base = (u32x2*)(SP + ((size_t)((b * 32) * 16 + h) * 64 + p) * 128 + n4 * 4);
        constexpr size_t cstride = (size_t)16 * 64 * 128 / 4;
        u32x2 sv[32];
#pragma unroll
        for (int c = 0; c < 32; ++c) sv[c] = base[c * cstride];
        __syncthreads();
        asm volatile("" ::: "memory");
        float r0 = 0.f, r1 = 0.f, r2 = 0.f, r3 = 0.f;
#pragma unroll
        for (int c = 0; c < 32; ++c) {
            const float dec = dl[c];
            u32x2 o; o.x = cvt_pk_bf16(r0, r1); o.y = cvt_pk_bf16(r2, r3);
            r0 = r0 * dec + bf_lo(sv[c].x); r1 = r1 * dec + bf_hi(sv[c].x); r2 = r2 * dec + bf_lo(sv[c].y); r3 = r3 * dec + bf_hi(sv[c].y);
            base[c * cstride] = o;
        }
    }
}

__device__ __forceinline__ void ssd_out_item(const Args& a, LAS unsigned char* lds, int item, int tid, int lane, int wave) {
    const int g = item & 3, c = (item >> 2) & 31, b = item >> 7, T0 = b * SEQ + c * 128, fr = lane & 15, fq = lane >> 4;
    const float* DT = (const float*)(a.ws + WS_DT);
    const LAS float* acs = (const LAS float*)(lds + L_ACS); const LAS float* dtv = (const LAS float*)(lds + L_DTV);
    __syncthreads();
    ssd_cumsum(lds, DT, a.in[I_ALOG], T0, g, lane, wave);
    __syncthreads();
    ssd_stage<1>(lds, (const bf16_t*)(a.ws + WS_XBC), a.in[I_CONVW], a.in[I_CONVB], T0, c, g, tid);
    __syncthreads();
    const int l0 = wave * 16, l = l0 + fr;
    f32x4 sacc[8];
#pragma unroll
    for (int sf = 0; sf < 8; ++sf) sacc[sf] = (f32x4){0.f, 0.f, 0.f, 0.f};
#pragma unroll
    for (int ks = 0; ks < 4; ++ks) { const bf16x8 cf = LFRAG(L_C, l, ks * 32 + fq * 8);
#pragma unroll
        for (int sf = 0; sf < 8; ++sf) { const bf16x8 bf = LFRAG(L_B, sf * 16 + fr, ks * 32 + fq * 8); sacc[sf] = MFMA16(bf, cf, sacc[sf]); } }
    __syncthreads();
    const int L_M = L_B + wave * 16 * LP;
    const bf16_t* PV = (const bf16_t*)((const unsigned char*)a.out + DO_STATES) + ((size_t)((b * 32 + c) * 16 + 4 * g) * 64) * 128;
    f32x4 y[4][4];
#pragma unroll
    for (int r = 0; r < 4; ++r) {
        const float al = acs[r * 128 + l];
#pragma unroll
        for (int pf = 0; pf < 4; ++pf) y[r][pf] = (f32x4){0.f, 0.f, 0.f, 0.f};
#pragma unroll
        for (int ks = 0; ks < 4; ++ks) {
            const bf16x8 cf = LFRAG(L_C, l, ks * 32 + fq * 8);
#pragma unroll
            for (int pf = 0; pf < 4; ++pf) {
                const bf16x8 pv = *(const bf16x8*)(PV + (size_t)(r * 64 + pf * 16 + fr) * 128 + ks * 32 + fq * 8);
                y[r][pf] = MFMA16(pv, cf, y[r][pf]);
            }
        }
        const float sd = __expf(al);
#pragma unroll
        for (int pf = 0; pf < 4; ++pf) y[r][pf] = y[r][pf] * sd;
#pragma unroll
        for (int sf = 0; sf < 8; ++sf) { const f32x4 as = *(const LAS f32x4*)(acs + r * 128 + sf * 16 + fq * 4); float mv[4];
#pragma unroll
            for (int jj = 0; jj < 4; ++jj) { const int s = sf * 16 + fq * 4 + jj; mv[jj] = (s <= l) ? sacc[sf][jj] * __expf(fminf(al - as[jj], 0.f)) : 0.f; }
            u32x2 w; w.x = cvt_pk_bf16(mv[0], mv[1]); w.y = cvt_pk_bf16(mv[2], mv[3]);
            *(LAS u32x2*)(lds + L_M + fr * LP + (sf * 16 + fq * 4) * 2) = w; }
        __syncthreads();
#pragma unroll
        for (int ks = 0; ks < 4; ++ks) {
            const bf16x8 mf = LFRAG(L_M, fr, ks * 32 + fq * 8);
#pragma unroll
            for (int pf = 0; pf < 4; ++pf) {
                const bf16x8 xf = LFRAG(L_XT, r * 64 + pf * 16 + fr, ks * 32 + fq * 8);
                y[r][pf] = MFMA16(xf, mf, y[r][pf]);
            }
        }
        __syncthreads();
    }
    const size_t tok = (size_t)(T0 + l);
    const bf16_t* Zp = (const bf16_t*)(a.ws + WS_Z) + tok * 1024 + g * 256;
    float ssq = 0.f;
#pragma unroll
    for (int r = 0; r < 4; ++r) {
        const float dsk = a.in[I_DSKIP][4 * g + r] / dtv[r * 128 + l];
#pragma unroll
        for (int pf = 0; pf < 4; ++pf) {
            const int p = pf * 16 + fq * 4;
            const u32x2 zz = *(const u32x2*)(Zp + r * 64 + p);
            const float zf[4] = {bf_lo(zz.x), bf_hi(zz.x), bf_lo(zz.y), bf_hi(zz.y)};
#pragma unroll
            for (int jj = 0; jj < 4; ++jj) {
                const float xdt = __uint_as_float((unsigned)(*(const LAS bf16_t*)(lds + L_XT + (r * 64 + p + jj) * LP + l * 2)) << 16);
                const float v = (y[r][pf][jj] + dsk * xdt) * siluf(zf[jj]);
                y[r][pf][jj] = v; ssq += v * v;
            }
        }
    }
    ssq += __shfl_xor(ssq, 16); ssq += __shfl_xor(ssq, 32);
    const float rstd = rsqrtf(ssq * (1.f / 256.f) + EPS);
    bf16_t* Yp = (bf16_t*)((unsigned char*)a.out + DO_H) + tok * 1024 + g * 256;
#pragma unroll
    for (int r = 0; r < 4; ++r)
#pragma unroll
        for (int pf = 0; pf < 4; ++pf) { const int p = pf * 16 + fq * 4; const f32x4 nwv = *(const f32x4*)(a.in[I_SSDNW] + g * 256 + r * 64 + p);
            u32x2 w; w.x = cvt_pk_bf16(y[r][pf][0] * rstd * nwv.x, y[r][pf][1] * rstd * nwv.y); w.y = cvt_pk_bf16(y[r][pf][2] * rstd * nwv.z, y[r][pf][3] * rstd * nwv.w);
            *(u32x2*)(Yp + r * 64 + p) = w; }
}


#define XB_TMO      128
#define XB_XCNT(j)  (256  + 64 * (j))
#define XB_XSUB(j)  (1280 + 64 * (j))
#define XB_XGEN(j)  (2304 + 64 * (j))
#define XB_TOP      3328
#define XB_TOPGEN   3392
#define XCD_BAR_WORDS 3456
#define XB_SPIN_CAP (1u << 18)
__device__ __forceinline__ unsigned xb_ld(unsigned* p)              { return __hip_atomic_load(p, __ATOMIC_RELAXED, __HIP_MEMORY_SCOPE_AGENT); }
__device__ __forceinline__ unsigned xb_add(unsigned* p, unsigned v) { return __hip_atomic_fetch_add(p, v, __ATOMIC_RELAXED, __HIP_MEMORY_SCOPE_AGENT); }
__device__ __forceinline__ unsigned xb_xcc_id() { return (unsigned)__builtin_amdgcn_s_getreg((3 << 11) | 20) & 0xFu; }
#define XB_SPIN(cond, bar) do { unsigned _sp = 0; while (cond) { __builtin_amdgcn_s_sleep(1); \
    if ((++_sp & 255u) == 0u) { if (xb_ld(&(bar)[XB_TMO])) break; if (_sp > XB_SPIN_CAP) { atomicAdd(&(bar)[XB_TMO], 1u); break; } } } } while (0)
struct XcdBarrier { unsigned* bar; unsigned x; volatile LAS unsigned* st; };
__device__ __forceinline__ XcdBarrier xcd_barrier_post(unsigned* bar, volatile LAS unsigned* st) {
    XcdBarrier b; b.bar = bar; b.x = xb_xcc_id(); b.st = st;
    if (threadIdx.x == 0) (void)xb_add(&bar[XB_XCNT(b.x)], 1u);
    return b;
}
__device__ __forceinline__ void xcd_barrier_complete(unsigned* bar, unsigned x, unsigned& nloc, unsigned& nx) {
    const unsigned G = gridDim.x * gridDim.y * gridDim.z;
    unsigned sum, cnt, mine, sp = 0u;
    for (;;) {
        sum = 0u; cnt = 0u; mine = 0u;
#pragma unroll
        for (unsigned j = 0; j < 16; ++j) { const unsigned c = xb_ld(&bar[XB_XCNT(j)]); sum += c; cnt += (c > 0u) ? 1u : 0u; mine = (j == x) ? c : mine; }
        if (sum == G) break;
        __builtin_amdgcn_s_sleep(1);
        if ((++sp & 255u) == 0u) { if (xb_ld(&bar[XB_TMO])) break; if (sp > XB_SPIN_CAP) { atomicAdd(&bar[XB_TMO], 1u); break; } }
    }
    nloc = mine > 0u ? mine : 1u; nx = cnt > 0u ? cnt : 1u;
}
__device__ __forceinline__ void xcd_barrier(const XcdBarrier& b) {
    asm volatile("s_waitcnt vmcnt(0)" ::: "memory");
    __syncthreads();
    if (threadIdx.x == 0) {
        unsigned* bar = b.bar;
        __builtin_amdgcn_s_waitcnt(0);
        unsigned nloc = b.st[0], nx = b.st[1];
        if (nloc == 0u) { xcd_barrier_complete(bar, b.x, nloc, nx); b.st[0] = nloc; b.st[1] = nx; }
        const unsigned old = xb_add(&bar[XB_XSUB(b.x)], 1u);
        const unsigned gen = old / nloc;
        if (old + 1u == (gen + 1u) * nloc) {
            __builtin_amdgcn_fence(__ATOMIC_RELEASE, "agent");
            asm volatile("s_waitcnt vmcnt(0)" ::: "memory");
            const unsigned og = xb_add(&bar[XB_TOP], 1u);
            const unsigned tg = og / nx;
            if (og + 1u == (tg + 1u) * nx) xb_add(&bar[XB_TOPGEN], 1u);
            else XB_SPIN(xb_ld(&bar[XB_TOPGEN]) == tg, bar);
            __builtin_amdgcn_fence(__ATOMIC_ACQUIRE, "agent");
            xb_add(&bar[XB_XGEN(b.x)], 1u);
            asm volatile("s_waitcnt vmcnt(0)" ::: "memory");
        } else {
            XB_SPIN(xb_ld(&bar[XB_XGEN(b.x)]) == gen, bar);
            __builtin_amdgcn_fence(__ATOMIC_ACQUIRE, "agent");
            asm volatile("s_waitcnt vmcnt(0)" ::: "memory");
        }
    }
    __syncthreads();
}

__global__ void __launch_bounds__(NTHREADS, 2) fwd_megakernel(Args a) {
    extern __shared__ __attribute__((aligned(16))) unsigned char lds_raw[];
    LAS unsigned char* lds = (LAS unsigned char*)lds_raw;
    cg::grid_group grid = cg::this_grid();
    const int G = gridDim.x;
#define PH_IDS() int tid = threadIdx.x; asm volatile("" : "+v"(tid)); const int lane = tid & 63, wave = __builtin_amdgcn_readfirstlane(tid >> 6); (void)lane; (void)wave
    unsigned char* ws = a.ws;
    const float* mod = (const float*)(ws + WS_MOD);
    bf16_t* H = (bf16_t*)((unsigned char*)a.out + DO_H);
    float* XR = (float*)(ws + WS_XR);
    const int lo = a.ph_lo, hi = a.ph_hi;
#ifndef ONLYPH
#define ONLYPH -1
#endif
#define IN(k) ((ONLYPH < 0 || ONLYPH == (k)) && lo <= (k) && (k) < hi)
    volatile LAS unsigned* bst = (volatile LAS unsigned*)(lds + LDS_BYTES - 64);
    if (threadIdx.x < 16) bst[threadIdx.x] = 0u;
    __syncthreads();
    XcdBarrier xbar = xcd_barrier_post((unsigned*)(ws + WS_BAR), bst);
    if (a.ph_hi > 1000) grid.sync();
#define SEAM(k) do { if (IN(k) && IN((k) + 1)) xcd_barrier(xbar); } while (0)
#ifndef DUP_MASK
#define DUP_MASK 0
#endif
#define REP(k) for (int rep_ = 0; rep_ < (((DUP_MASK >> (k)) & 1) ? 2 : 1); ++rep_, (rep_ < (((DUP_MASK >> (k)) & 1) ? 2 : 1) ? xcd_barrier(xbar) : (void)0))

    if (IN(0)) REP(0) { PH_IDS(); p0_phase(a, lds, tid, lane, wave, G); }
    SEAM(0);
    if (IN(1)) REP(1) { PH_IDS(); norm_phase<false>(lds, a.in[I_X], a.in[I_N1], mod, 0 * D, 1 * D, H, nullptr, nullptr, nullptr, tid, lane, wave, G); }
    SEAM(1);
    if (IN(2)) REP(2) { pg8::Gemm g{H, H, (const bf16_t*)(ws + WS_WGU1), M, 2 * FF, D, D, D, 1 << 30, 0}; pg8::StaticOrder S; S.init(M, 2 * FF, G, blockIdx.x);
        pg8::EpiSwiGLU E{(bf16_t*)(ws + WS_ACT)}; pg8::gemm_phase(lds, g, S, E);
        { const int nidle = G - (S.nwg % G); PH_IDS();
          if ((S.nwg % G) != 0 && (int)blockIdx.x >= G - nidle) p0_transposes(a, lds, 1, ((int)blockIdx.x - (G - nidle)) * NWAVES + wave, nidle * NWAVES, lane, wave);
          else if ((S.nwg % G) == 0) p0_transposes(a, lds, 1, blockIdx.x * NWAVES + wave, G * NWAVES, lane, wave); } }
    SEAM(2);
    if (IN(3)) REP(3) { pg8::Gemm g{(const bf16_t*)(ws + WS_ACT), (const bf16_t*)(ws + WS_ACT), (const bf16_t*)(ws + WS_WD1), M, D, FF, FF, FF, 1 << 30, 0}; pg8::StaticOrder S; S.init(M, D, G, blockIdx.x);
        pg8::EpiResid E{a.in[I_X], XR, mod + 2 * D, 0.5f}; pg8::gemm_phase(lds, g, S, E); }
    SEAM(3);
    if (IN(4)) REP(4) { PH_IDS(); norm_phase<true>(lds, XR, a.in[I_NMIX], mod, 3 * D, 4 * D, H, (const float*)(ws + WS_WDT), a.in[I_DTB], (float*)(ws + WS_DT), tid, lane, wave, G); }
    SEAM(4);
    if (IN(5)) REP(5) { pg8::Gemm g{H, H, (const bf16_t*)(ws + WS_WIN), M, NPROJ, D, D, D, 1 << 30, 0}; pg8::StaticOrder S; S.init(M, NPROJ, G, blockIdx.x);
        pg8::EpiSplit E{(bf16_t*)(ws + WS_Z), (bf16_t*)(ws + WS_XBC), (bf16_t*)(ws + WS_U)}; pg8::gemm_phase(lds, g, S, E); }
    SEAM(5);
    if (IN(6)) REP(6) { PH_IDS();
        for (int it = blockIdx.x; it < BATCH * NCHUNK * 4; it += G) ssd_states_item(a, lds, it, tid, lane, wave);
        for (int it = blockIdx.x; it < M / 32; it += G) diff_item((const bf16_t*)(ws + WS_U), H, it, tid);
    }
    SEAM(6);
    if (IN(7)) REP(7) { PH_IDS();
        scan_phase(a, lds, tid, G);
        __syncthreads();
        REP(14) {
        pg8::Gemm g{H, H, (const bf16_t*)(ws + WS_WPOOL), M, 1024, 256, 1024, 256, 1 << 30, 256}; pg8::StaticOrder S; S.init(M, 1024, G, blockIdx.x);
        pg8::EpiPool E{(bf16_t*)(ws + WS_YPOOL), a.in[I_POOLB], a.in[I_POOLS]}; pg8::gemm_phase(lds, g, S, E);
        }
    }
    SEAM(7);
    if (IN(8)) REP(8) { PH_IDS(); for (int it = blockIdx.x; it < BATCH * NCHUNK * 4; it += G) ssd_out_item(a, lds, it, tid, lane, wave); }
    SEAM(8);
    if (IN(9)) REP(9) { __syncthreads();
        pg8::Gemm g{H, (const bf16_t*)(ws + WS_YPOOL), (const bf16_t*)(ws + WS_WOUT), M, D, 2048, 1024, 2048, 16, 0}; pg8::StaticOrder S; S.init(M, D, G, blockIdx.x);
        pg8::EpiResid E{XR, XR, mod + 5 * D, 1.0f}; pg8::gemm_phase(lds, g, S, E); }
    SEAM(9);
    if (IN(10)) REP(10) { PH_IDS(); norm_phase<false>(lds, XR, a.in[I_N2], mod, 6 * D, 7 * D, H, nullptr, nullptr, nullptr, tid, lane, wave, G); }
    SEAM(10);
    if (IN(11)) REP(11) { pg8::Gemm g{H, H, (const bf16_t*)(ws + WS_WGU2), M, 2 * FF, D, D, D, 1 << 30, 0}; pg8::StaticOrder S; S.init(M, 2 * FF, G, blockIdx.x);
        pg8::EpiSwiGLU E{(bf16_t*)(ws + WS_ACT)}; pg8::gemm_phase(lds, g, S, E); }
    SEAM(11);
    if (IN(12)) REP(12) { pg8::Gemm g{(const bf16_t*)(ws + WS_ACT), (const bf16_t*)(ws + WS_ACT), (const bf16_t*)(ws + WS_WD2), M, D, FF, FF, FF, 1 << 30, 0}; pg8::StaticOrder S; S.init(M, D, G, blockIdx.x);
        pg8::EpiResid E{XR, a.out, mod + 8 * D, 0.5f}; pg8::gemm_phase(lds, g, S, E); }
    SEAM(12);
    if (IN(13)) REP(13) { PH_IDS(); final_norm_phase(a.out, a.in[I_NF], lane, wave, G); }
#undef IN
#undef SEAM
}


#ifndef DBG_K
#define DBG_K -1
#endif
__global__ void dbg_dump(float* out, const void* src, int mode, int nch) {
    for (size_t i = (size_t)blockIdx.x * blockDim.x + threadIdx.x; i < (size_t)M * 1024; i += (size_t)gridDim.x * blockDim.x) {
        float v = 0.f;
        if (mode == 0) v = ((const float*)src)[i];
        else if (mode == 2) v = __uint_as_float((unsigned)((const bf16_t*)src)[i + (size_t)M * 1024] << 16);
        else for (int j = 0; j < nch; ++j) v += __uint_as_float((unsigned)((const bf16_t*)src)[i + (size_t)j * M * 1024] << 16);
        out[i] = v;
    }
}
extern "C" void kernel_launch(void* const* d_in, const int* in_sizes, int n_in, void* d_out, int out_size, void* d_ws, size_t ws_size, hipStream_t stream) {
    static int grid_blocks = 0;
    if (grid_blocks == 0) {
        int dev = 0, cus = 0, per_cu = 0;
        (void)hipGetDevice(&dev);
        (void)hipDeviceGetAttribute(&cus, hipDeviceAttributeMultiprocessorCount, dev);
        if (hipFuncSetAttribute((const void*)fwd_megakernel, hipFuncAttributeMaxDynamicSharedMemorySize, LDS_BYTES) != hipSuccess) { fprintf(stderr, "hipFuncSetAttribute failed\n"); grid_blocks = -1; return; }
        if (hipOccupancyMaxActiveBlocksPerMultiprocessor(&per_cu, (const void*)fwd_megakernel, NTHREADS, LDS_BYTES) != hipSuccess || per_cu < 1) { fprintf(stderr, "occupancy query: %d blocks/CU\n", per_cu); grid_blocks = -1; return; }
        grid_blocks = cus;
        if (n_in != 25 || ws_size < WS_END) { fprintf(stderr, "unexpected problem: n_in %d ws %zu\n", n_in, ws_size); grid_blocks = -1; return; }
    }
    if (grid_blocks < 0) return;
    Args a{};
    for (int i = 0; i < 25; ++i) a.in[i] = (const float*)d_in[i];
    a.out = (float*)d_out; a.ws = (unsigned char*)d_ws;
    (void)hipMemsetAsync((unsigned char*)d_ws + WS_BAR, 0, BAR_BYTES, stream);
#ifndef MK_PER_PHASE
#define MK_PER_PHASE 0
#endif
#if MK_PER_PHASE
    const int kmax = (DBG_K >= 0) ? DBG_K : 13;
    for (int k = 0; k <= kmax; ++k) { a.ph_lo = k; a.ph_hi = k + 1; hipLaunchKernelGGL(fwd_megakernel, dim3(grid_blocks), dim3(NTHREADS), LDS_BYTES, stream, a); }
    if (DBG_K >= 0) {
        const unsigned char* ws = (const unsigned char*)d_ws; const void* src = ws + WS_XR; int mode = 0, nch = 1;
        if (DBG_K == 5) { src = ws + WS_Z; mode = 1; nch = 4; }
        if (DBG_K == 2) { src = ws + WS_ACT; mode = 1; nch = 2; }
        if (DBG_K == 6) { src = (const unsigned char*)d_out; mode = 2; nch = 1; }
        if (DBG_K == 7) { src = ws + WS_YPOOL; mode = 1; nch = 1; }
        if (DBG_K == 8) { src = d_out; mode = 1; nch = 1; }
        if (DBG_K == 1) { src = d_out; mode = 1; nch = 1; }
        if (DBG_K == 4) { src = ws + WS_DT; mode = 0; nch = 1; }
        if (src == (const void*)d_out) { (void)hipMemcpyAsync((unsigned char*)d_ws + WS_XR, d_out, 64 * MiB, hipMemcpyDeviceToDevice, stream); src = ws + WS_XR; }
        hipLaunchKernelGGL(dbg_dump, dim3(2048), dim3(256), 0, stream, (float*)d_out, src, mode, nch);
    }
#else
    a.ph_lo = 0; a.ph_hi = 14;
    void* args[] = {&a};
    hipError_t e = hipLaunchCooperativeKernel((const void*)fwd_megakernel, dim3(grid_blocks), dim3(NTHREADS), args, LDS_BYTES, stream);
    if (e != hipSuccess) fprintf(stderr, "cooperative launch failed: %s (grid %d)\n", hipGetErrorString(e), grid_blocks);
#endif
}
```

```cpp
#include <hip/hip_runtime.h>
#include <hip/hip_cooperative_groups.h>
#include <cstdio>
namespace cg = cooperative_groups;

#define LAS __attribute__((address_space(3)))
typedef unsigned short bf16_t;
typedef short bf16x8 __attribute__((ext_vector_type(8)));
typedef float f32x4 __attribute__((ext_vector_type(4)));
typedef float f32x2 __attribute__((ext_vector_type(2)));
typedef unsigned u32x4 __attribute__((ext_vector_type(4)));
typedef unsigned u32x2 __attribute__((ext_vector_type(2)));

constexpr int BATCH = 4, SEQ = 4096, D = 1024, M = BATCH * SEQ, FF = 2816, NPROJ = 4096, DINP = 4112, DXBC = 2048, NMOD = 9 * D;
constexpr int NCHUNK = 32, NHEAD = 16;
constexpr float EPS = 1e-6f;
constexpr int NWAVES = 8, NTHREADS = 512;
constexpr int LDS_BYTES = 147456;

constexpr size_t KiB = 1024, MiB = 1u << 20;
constexpr size_t WS_MOD = 0, WS_CDEC = 256 * KiB, WS_WDT = 512 * KiB, WS_BAR = 768 * KiB, BAR_BYTES = 128 * KiB, WS_CNT = WS_BAR + 16 * KiB, WS_SSQ = 1 * MiB, WS_DT = 2 * MiB;
constexpr size_t WS_WPOOL = 4 * MiB, WS_WOUT = WS_WPOOL + MiB / 2, WS_WGU2 = WS_WOUT + 4 * MiB, WS_WD2 = WS_WGU2 + 11 * MiB, WS_WGU1 = WS_WD2 + 11 * MiB / 2,
                 WS_WD1 = WS_WGU1 + 11 * MiB, WS_WIN = WS_WD1 + 11 * MiB / 2, WS_XR = WS_WIN + 8 * MiB, WS_R2 = WS_XR + 64 * MiB;
constexpr size_t WS_ACT = WS_R2, WS_Z = WS_R2, WS_XBC = WS_R2 + 32 * MiB, WS_U = WS_R2 + 96 * MiB, WS_YPOOL = WS_U, WS_END = WS_U + 32 * MiB;
static_assert(WS_END <= 256 * MiB, "ws map");
static_assert(WS_ACT + (size_t)M * FF * 2 <= 256 * MiB, "ws map act");
constexpr size_t DO_H = 0, DO_STATES = 32 * MiB;

__device__ __forceinline__ float wave_sum(float v) {
#pragma unroll
    for (int o = 1; o < 64; o <<= 1) v += __shfl_xor(v, o);
    return v;
}
typedef __bf16 bf16x2_t __attribute__((ext_vector_type(2)));
__device__ __forceinline__ unsigned cvt_pk_bf16(float lo, float hi) { f32x2 v = {lo, hi}; bf16x2_t r = __builtin_convertvector(v, bf16x2_t); return __builtin_bit_cast(unsigned, r); }
__device__ __forceinline__ float bf_lo(unsigned u) { return __uint_as_float(u << 16); }
__device__ __forceinline__ float bf_hi(unsigned u) { return __uint_as_float(u & 0xffff0000u); }
__device__ __forceinline__ float siluf(float x) { return x * __builtin_amdgcn_rcpf(1.f + __builtin_amdgcn_exp2f(-1.44269504f * x)); }
#define LDS_WAIT() asm volatile("s_waitcnt lgkmcnt(0)" ::: "memory")

namespace pg8 {
constexpr int BM = 256, BK = 64, HALF = 128, HTB = HALF * BK * 2, STAGE_BYTES = 8 * HTB, NXCD = 8, WGM = 8;
__device__ __forceinline__ int lds_byte(int r, int c) { const int st = (r >> 4) * 2 + (c >> 5), rr = r & 15, cc = c & 31, ob = rr * 64 + cc * 2; return st * 1024 + (ob ^ (((ob >> 9) & 1) << 5)); }
__device__ __forceinline__ void stage_rc(int b, int& R, int& C) { const int st = b / 1024, sb = b % 1024, swz = sb ^ (((sb >> 9) & 1) << 5); R = (st >> 1) * 16 + swz / 64; C = (st & 1) * 32 + (swz % 64) / 2; }
struct Unit { int pm, pn; };
struct Gemm { const bf16_t* A; const bf16_t* A2; const bf16_t* Bt; int M, N, K, lda, ldb, ksplit, a_pn_off; };
struct StaticOrder {
    int nM, nN, nwg, G, c;
    __device__ void init(int M_, int N_, int G_, int c_) { nM = M_ / BM; nN = N_ / BM; nwg = nM * nN; G = G_; c = c_; }
    __device__ bool next(int i, Unit& u) const {
        const long L = (long)i * G + c; if (L >= nwg) return false;
        int wgid = (int)L; { const int q = nwg / NXCD, r = nwg % NXCD, xcd = wgid % NXCD, off = wgid / NXCD; wgid = (xcd < r ? xcd * (q + 1) : r * (q + 1) + (xcd - r) * q) + off; }
        const int nig = WGM * nN, gid = wgid / nig, fm = gid * WGM, gsz = (nM - fm) < WGM ? (nM - fm) : WGM;
        u.pm = fm + ((wgid % nig) % gsz); u.pn = (wgid % nig) / gsz; return true;
    }
};
template <class Epi>
__device__ __forceinline__ void gemm_phase(LAS unsigned char* lds, const Gemm g, const StaticOrder& S, const Epi& E) {
    int tid = threadIdx.x; asm volatile("" : "+v"(tid));
    const int wid = __builtin_amdgcn_readfirstlane(tid >> 6), lane = tid & 63, wr = wid >> 2, wc = wid & 3, fr = lane & 15, fq = lane >> 4;
    int nt = g.K / BK, ksplit = g.ksplit;
    asm volatile("" : "+s"(nt), "+s"(ksplit));
    unsigned voffA[2], voffB[2];
#pragma unroll
    for (int i = 0; i < 2; ++i) { int R, C; stage_rc(tid * 16 + i * 8192, R, C); voffA[i] = (unsigned)(R * g.lda + C) * 2u; voffB[i] = (unsigned)(R * g.ldb + C) * 2u; }
    const size_t kstep = (size_t)(BK * 2);
    const size_t hstepA = (size_t)HALF * g.lda * 2, hstepB = (size_t)HALF * g.ldb * 2;
    const size_t tstepA = 2 * hstepA, tstepB = 2 * hstepB;
    const unsigned ldsw = (unsigned)wid * 1024u;
    const int aoff = lds_byte(wr * 64 + fr, fq * 8), boff = lds_byte(wc * 32 + fr, fq * 8);
#define PG8_SA(b, h) (((b) * 2 + (h)) * HTB)
#define PG8_SB(b, h) ((4 + (b) * 2 + (h)) * HTB)
#define PG8_STAGE(bufoff, gbase, voff) do { _Pragma("unroll") for (int _i = 0; _i < 2; ++_i) \
        __builtin_amdgcn_global_load_lds((const unsigned*)((const char*)(gbase) + (voff)[_i]), (LAS unsigned*)(lds + (bufoff) + ldsw + _i * 8192), 16, 0, 0); } while (0)
#define PG8_LDA(dst, b, h) do { _Pragma("unroll") for (int m = 0; m < 4; ++m) _Pragma("unroll") for (int k = 0; k < 2; ++k) dst[m][k] = *(const LAS bf16x8*)(lds + PG8_SA(b, h) + aoff + m * 2048 + k * 1024); } while (0)
#define PG8_LDB(dst, b, h) do { _Pragma("unroll") for (int n = 0; n < 2; ++n) _Pragma("unroll") for (int k = 0; k < 2; ++k) dst[n][k] = *(const LAS bf16x8*)(lds + PG8_SB(b, h) + boff + n * 2048 + k * 1024); } while (0)
#define PG8_MMA(ai, bj, At, Bt) do { __builtin_amdgcn_s_setprio(1); _Pragma("unroll") for (int m = 0; m < 4; ++m) _Pragma("unroll") for (int n = 0; n < 2; ++n) _Pragma("unroll") for (int k = 0; k < 2; ++k) \
        acc[ai][bj][m][n] = __builtin_amdgcn_mfma_f32_16x16x32_bf16(Bt[n][k], At[m][k], acc[ai][bj][m][n], 0, 0, 0); __builtin_amdgcn_s_setprio(0); } while (0)
#define PG8_WAIT_V(n) asm volatile("s_waitcnt vmcnt(" #n ")" ::: "memory")
#define PG8_WAIT_L(n) asm volatile("s_waitcnt lgkmcnt(" #n ")" ::: "memory")
#define PG8_BAR __builtin_amdgcn_s_barrier()
#define PG8_SCHED __builtin_amdgcn_sched_barrier(0)
#define PG8_TILEA(c1, c2, t) ((t) < ksplit ? (c1) + (size_t)(t) * kstep : (c2) + (size_t)((t) - ksplit) * kstep)
    Unit cur, nxt; int ui = 0;
    if (!S.next(0, cur)) return;
    f32x4 acc[2][2][4][2];
#pragma unroll
    for (int a = 0; a < 2; ++a)
#pragma unroll
        for (int b = 0; b < 2; ++b)
#pragma unroll
            for (int m = 0; m < 4; ++m)
#pragma unroll
                for (int n = 0; n < 2; ++n) acc[a][b][m][n] = (f32x4){0.f, 0.f, 0.f, 0.f};
    bf16x8 At[4][2], B0[2][2], B1[2][2];
    const char* cA = (const char*)g.A + (size_t)cur.pm * tstepA + (size_t)cur.pn * g.a_pn_off * 2;
    const char* cA2 = (const char*)g.A2 + (size_t)cur.pm * tstepA + (size_t)cur.pn * g.a_pn_off * 2;
    const char* cB = (const char*)g.Bt + (size_t)cur.pn * tstepB;
    PG8_STAGE(PG8_SB(0, 0), cB, voffB); PG8_STAGE(PG8_SA(0, 0), cA, voffA); PG8_STAGE(PG8_SB(0, 1), cB + hstepB, voffB); PG8_STAGE(PG8_SA(0, 1), cA + hstepA, voffA);
    if (wr == 1) PG8_BAR;
    PG8_WAIT_V(4); PG8_BAR;
    PG8_STAGE(PG8_SB(1, 0), cB + kstep, voffB); PG8_STAGE(PG8_SA(1, 0), cA + kstep, voffA); PG8_STAGE(PG8_SB(1, 1), cB + hstepB + kstep, voffB);
    PG8_WAIT_V(6); PG8_BAR;
    for (;;) {
        const bool has_next = S.next(ui + 1, nxt);
        const char* nA = has_next ? (const char*)g.A + (size_t)nxt.pm * tstepA + (size_t)nxt.pn * g.a_pn_off * 2 : cA;
        const char* nA2 = has_next ? (const char*)g.A2 + (size_t)nxt.pm * tstepA + (size_t)nxt.pn * g.a_pn_off * 2 : cA2;
        const char* nB = has_next ? (const char*)g.Bt + (size_t)nxt.pn * tstepB : cB;
        for (int t = 0; t < nt; t += 2) {
            const bool last = (t == nt - 2);
            const char* a1 = PG8_TILEA(cA, cA2, t + 1);
            const char* a2 = last ? nA : PG8_TILEA(cA, cA2, t + 2); const char* b2 = last ? nB : cB + (size_t)(t + 2) * kstep;
            const char* a3 = a2 + kstep; const char* b3 = b2 + kstep;
            PG8_LDB(B0, 0, 0); PG8_SCHED; PG8_LDA(At, 0, 0); PG8_STAGE(PG8_SA(1, 1), a1 + hstepA, voffA);
            PG8_WAIT_L(8); PG8_BAR; PG8_WAIT_L(0); PG8_MMA(0, 0, At, B0); PG8_BAR; PG8_SCHED;
            PG8_LDB(B1, 0, 1); PG8_STAGE(PG8_SB(0, 0), b2, voffB);
            PG8_BAR; PG8_WAIT_L(0); PG8_MMA(0, 1, At, B1); PG8_BAR;
            PG8_LDA(At, 0, 1); PG8_STAGE(PG8_SA(0, 0), a2, voffA);
            PG8_BAR; PG8_WAIT_L(0); PG8_MMA(1, 0, At, B0); PG8_BAR; PG8_SCHED;
            PG8_STAGE(PG8_SB(0, 1), b2 + hstepB, voffB);
            PG8_WAIT_V(6); PG8_BAR; PG8_MMA(1, 1, At, B1); PG8_BAR;
            PG8_LDB(B0, 1, 0); PG8_SCHED; PG8_LDA(At, 1, 0); PG8_STAGE(PG8_SA(0, 1), a2 + hstepA, voffA);
            PG8_WAIT_L(8); PG8_BAR; PG8_WAIT_L(0); PG8_MMA(0, 0, At, B0); PG8_BAR; PG8_SCHED;
            PG8_LDB(B1, 1, 1); PG8_STAGE(PG8_SB(1, 0), b3, voffB);
            PG8_BAR; PG8_WAIT_L(0); PG8_MMA(0, 1, At, B1); PG8_BAR;
            PG8_LDA(At, 1, 1); PG8_STAGE(PG8_SA(1, 0), a3, voffA);
            PG8_BAR; PG8_WAIT_L(0); PG8_MMA(1, 0, At, B0); PG8_BAR; PG8_SCHED;
            PG8_STAGE(PG8_SB(1, 1), b3 + hstepB, voffB);
            PG8_WAIT_V(6); PG8_BAR; PG8_MMA(1, 1, At, B1); PG8_BAR;
        }
        if constexpr (!Epi::AFTER_DRAIN) E(acc, cur, wr, wc, fr, fq);
        if (!has_next) break;
#pragma unroll
        for (int a = 0; a < 2; ++a)
#pragma unroll
            for (int b = 0; b < 2; ++b)
#pragma unroll
                for (int m = 0; m < 4; ++m)
#pragma unroll
                    for (int n = 0; n < 2; ++n) acc[a][b][m][n] = (f32x4){0.f, 0.f, 0.f, 0.f};
        cur = nxt; cA = nA; cA2 = nA2; cB = nB; ++ui;
    }
    PG8_WAIT_V(0);
    if (wr == 0) PG8_BAR;
    PG8_BAR;
    if constexpr (Epi::AFTER_DRAIN) E.fused(acc, cur, wr, wc, fr, fq, lds, wid, lane);
#undef PG8_SA
#undef PG8_SB
#undef PG8_STAGE
#undef PG8_LDA
#undef PG8_LDB
#undef PG8_MMA
#undef PG8_WAIT_V
#undef PG8_WAIT_L
#undef PG8_BAR
#undef PG8_SCHED
#undef PG8_TILEA
}

struct EpiSwiGLU {
    static constexpr bool AFTER_DRAIN = false;
    bf16_t* O;
    __device__ __forceinline__ void operator()(const f32x4 (&acc)[2][2][4][2], const Unit& u, int wr, int wc, int fr, int fq) const {
        const int row0 = u.pm * BM + wr * 64 + fr, col0 = u.pn * HALF + wc * 32 + 4 * fq;
#pragma unroll
        for (int ai = 0; ai < 2; ++ai)
#pragma unroll
            for (int m = 0; m < 4; ++m) { bf16_t* rowp = O + (size_t)(row0 + ai * HALF + m * 16) * FF + col0;
#pragma unroll
                for (int n = 0; n < 2; ++n) { const f32x4 gt = acc[ai][0][m][n], up = acc[ai][1][m][n];
                    u32x2 w; w.x = cvt_pk_bf16(siluf(gt[0]) * up[0], siluf(gt[1]) * up[1]); w.y = cvt_pk_bf16(siluf(gt[2]) * up[2], siluf(gt[3]) * up[3]);
                    *(u32x2*)(rowp + n * 16) = w; } }
    }
};
struct EpiResid {
    static constexpr bool AFTER_DRAIN = false;
    const float* base; float* out; const float* gate; float scale;
    __device__ __forceinline__ void operator()(const f32x4 (&acc)[2][2][4][2], const Unit& u, int wr, int wc, int fr, int fq) const {
        const int row0 = u.pm * BM + wr * 64 + fr, col0 = u.pn * BM + wc * 32 + 4 * fq, b = u.pm >> 4;
        f32x4 gv[2][2];
#pragma unroll
        for (int bj = 0; bj < 2; ++bj)
#pragma unroll
            for (int n = 0; n < 2; ++n) gv[bj][n] = *(const f32x4*)(gate + (size_t)b * NMOD + col0 + bj * HALF + n * 16) * scale;
#pragma unroll
        for (int ai = 0; ai < 2; ++ai)
#pragma unroll
            for (int m = 0; m < 4; ++m) { const size_t off = (size_t)(row0 + ai * HALF + m * 16) * D + col0;
#pragma unroll
                for (int bj = 0; bj < 2; ++bj)
#pragma unroll
                    for (int n = 0; n < 2; ++n) { const f32x4 bs = *(const f32x4*)(base + off + bj * HALF + n * 16);
                        *(f32x4*)(out + off + bj * HALF + n * 16) = bs + gv[bj][n] * acc[ai][bj][m][n]; } }
    }
};
struct EpiSplit {
    static constexpr bool AFTER_DRAIN = false;
    bf16_t* Z; bf16_t* XBC; bf16_t* U;
    __device__ __forceinline__ void operator()(const f32x4 (&acc)[2][2][4][2], const Unit& u, int wr, int wc, int fr, int fq) const {
        bf16_t* basep; int ld, c0;
        if (u.pn < 4) { basep = Z; ld = 1024; c0 = u.pn * BM; } else if (u.pn < 12) { basep = XBC; ld = 2048; c0 = (u.pn - 4) * BM; } else { basep = U; ld = 1024; c0 = (u.pn - 12) * BM; }
        const int row0 = u.pm * BM + wr * 64 + fr, col0 = c0 + wc * 32 + 4 * fq;
#pragma unroll
        for (int ai = 0; ai < 2; ++ai)
#pragma unroll
            for (int m = 0; m < 4; ++m) { bf16_t* rowp = basep + (size_t)(row0 + ai * HALF + m * 16) * ld + col0;
#pragma unroll
                for (int bj = 0; bj < 2; ++bj)
#pragma unroll
                    for (int n = 0; n < 2; ++n) { const f32x4 v = acc[ai][bj][m][n]; u32x2 w; w.x = cvt_pk_bf16(v[0], v[1]); w.y = cvt_pk_bf16(v[2], v[3]);
                        *(u32x2*)(rowp + bj * HALF + n * 16) = w; } }
    }
};
struct EpiPool {
    static constexpr bool AFTER_DRAIN = false;
    bf16_t* O; const float* bias; const float* scl;
    __device__ __forceinline__ void operator()(const f32x4 (&acc)[2][2][4][2], const Unit& u, int wr, int wc, int fr, int fq) const {
        const int row0 = u.pm * BM + wr * 64 + fr, col0 = u.pn * BM + wc * 32 + 4 * fq;
        f32x4 bv[2][2], sv[2][2];
#pragma unroll
        for (int bj = 0; bj < 2; ++bj)
#pragma unroll
            for (int n = 0; n < 2; ++n) { bv[bj][n] = *(const f32x4*)(bias + col0 + bj * HALF + n * 16); sv[bj][n] = *(const f32x4*)(scl + col0 + bj * HALF + n * 16); }
#pragma unroll
        for (int ai = 0; ai < 2; ++ai)
#pragma unroll
            for (int m = 0; m < 4; ++m) { bf16_t* rowp = O + (size_t)(row0 + ai * HALF + m * 16) * 1024 + col0;
#pragma unroll
                for (int bj = 0; bj < 2; ++bj)
#pragma unroll
                    for (int n = 0; n < 2; ++n) { const f32x4 v = (acc[ai][bj][m][n] + bv[bj][n]) * sv[bj][n]; u32x2 w; w.x = cvt_pk_bf16(v[0], v[1]); w.y = cvt_pk_bf16(v[2], v[3]);
                        *(u32x2*)(rowp + bj * HALF + n * 16) = w; } }
    }
};

template <bool HALF_SCALE> struct EpiResidNorm {
    static constexpr bool AFTER_DRAIN = true;
    const float* base; float* xout; const float* gate;
    const float* nw; const float* sh; const float* sc;
    bf16_t* hout; float* fout;
    float* ssq; unsigned* cnt;
    __device__ __forceinline__ void fused(f32x4 (&acc)[2][2][4][2], const Unit& u, int wr, int wc, int fr, int fq, LAS unsigned char* lds, int wid, int lane) const {
        const float* const base = this->base; float* const xout = this->xout; const float* const gate = this->gate; const float scale = HALF_SCALE ? 0.5f : 1.0f;
        const float* const nw = this->nw; const float* const sh = this->sh; const float* const sc = this->sc; bf16_t* const hout = this->hout; float* const fout = this->fout;
        float* const ssq = this->ssq; unsigned* const cnt = this->cnt;
        LAS float* P = (LAS float*)lds;
        LAS float* S = (LAS float*)(lds + 4096);
        const int row0 = u.pm * BM + wr * 64 + fr, col0 = u.pn * BM + wc * 32 + 4 * fq, b = u.pm >> 4;
        {
            f32x4 gv[2][2];
#pragma unroll
            for (int bj = 0; bj < 2; ++bj)
#pragma unroll
                for (int n = 0; n < 2; ++n) gv[bj][n] = *(const f32x4*)(gate + (size_t)b * NMOD + col0 + bj * HALF + n * 16) * scale;
#pragma unroll
            for (int ai = 0; ai < 2; ++ai)
#pragma unroll
                for (int m = 0; m < 4; ++m) { const size_t off = (size_t)(row0 + ai * HALF + m * 16) * D + col0; float sq = 0.f;
#pragma unroll
                    for (int bj = 0; bj < 2; ++bj)
#pragma unroll
                        for (int n = 0; n < 2; ++n) { const f32x4 bs = *(const f32x4*)(base + off + bj * HALF + n * 16); const f32x4 x = bs + gv[bj][n] * acc[ai][bj][m][n];
                            acc[ai][bj][m][n] = x; if (xout) *(f32x4*)(xout + off + bj * HALF + n * 16) = x;
                            sq += (x[0] * x[0] + x[1] * x[1]) + (x[2] * x[2] + x[3] * x[3]); }
                    sq += __shfl_xor(sq, 16); sq += __shfl_xor(sq, 32);
                    if (fq == 0) P[(ai * HALF + wr * 64 + m * 16 + fr) * 4 + wc] = sq; }
        }
        asm volatile("s_waitcnt lgkmcnt(0)" ::: "memory"); __builtin_amdgcn_s_barrier(); asm volatile("" ::: "memory");
        const int tid = wid * 64 + lane;
        if (tid < 256) { const f32x4 p = *(const LAS f32x4*)(P + tid * 4);
            __hip_atomic_store(ssq + ((size_t)(u.pm * BM + tid)) * 4 + u.pn, (p[0] + p[1]) + (p[2] + p[3]), __ATOMIC_RELAXED, __HIP_MEMORY_SCOPE_AGENT); }
        asm volatile("s_waitcnt vmcnt(0)" ::: "memory");
        if (wid < 4 && lane == 0) __hip_atomic_fetch_add(cnt + 64 * u.pm, 1u, __ATOMIC_RELAXED, __HIP_MEMORY_SCOPE_AGENT);
        if (wid == 0) {
            unsigned spins = 0;
            while ((unsigned)__builtin_amdgcn_readfirstlane(__hip_atomic_load(cnt + 64 * u.pm, __ATOMIC_RELAXED, __HIP_MEMORY_SCOPE_AGENT)) < 16u) { __builtin_amdgcn_s_sleep(2); if (++spins > (1u << 22)) break; }
            __builtin_amdgcn_fence(__ATOMIC_ACQUIRE, "agent");
        }
        asm volatile("s_waitcnt vmcnt(0) lgkmcnt(0)" ::: "memory"); __builtin_amdgcn_s_barrier(); asm volatile("" ::: "memory");
        if (tid < 256) { const float* slot = ssq + ((size_t)(u.pm * BM + tid)) * 4; float t = 0.f;
#pragma unroll
            for (int q = 0; q < 4; ++q) t += __hip_atomic_load(slot + q, __ATOMIC_RELAXED, __HIP_MEMORY_SCOPE_AGENT);
            S[tid] = rsqrtf(t * (1.f / D) + EPS); }
        asm volatile("s_waitcnt vmcnt(0) lgkmcnt(0)" ::: "memory"); __builtin_amdgcn_s_barrier(); asm volatile("" ::: "memory");
#pragma unroll
        for (int bj = 0; bj < 2; ++bj)
#pragma unroll
            for (int n = 0; n < 2; ++n) { const int col = col0 + bj * HALF + n * 16;
                f32x4 A4 = *(const f32x4*)(nw + col), B4 = (f32x4){0.f, 0.f, 0.f, 0.f};
                if (sc) { A4 = A4 * (*(const f32x4*)(sc + (size_t)b * NMOD + col) + 1.f); B4 = *(const f32x4*)(sh + (size_t)b * NMOD + col); }
#pragma unroll
                for (int ai = 0; ai < 2; ++ai)
#pragma unroll
                    for (int m = 0; m < 4; ++m) { const size_t off = (size_t)(row0 + ai * HALF + m * 16) * D + col; const f32x4 o = acc[ai][bj][m][n] * S[ai * HALF + wr * 64 + m * 16 + fr] * A4 + B4;
                        if (hout) { u32x2 w; w.x = cvt_pk_bf16(o[0], o[1]); w.y = cvt_pk_bf16(o[2], o[3]); *(u32x2*)(hout + off) = w; }
                        else *(f32x4*)(fout + off) = o; } }
    }
};
}

struct Args { const float* in[25]; float* out; unsigned char* ws; int ph_lo, ph_hi; };
enum { I_X = 0, I_C, I_WADA, I_BADA, I_N1, I_G1, I_U1, I_D1, I_NMIX, I_WIN, I_CONVW, I_CONVB, I_DTB, I_ALOG, I_DSKIP, I_SSDNW, I_POOLW, I_POOLB, I_POOLS, I_WOUT, I_N2, I_G2, I_U2, I_D2, I_NF };

__device__ __forceinline__ void p0_transpose_item(const float* W, int ldw, int K, bf16_t* WT, int dst_row0, int n0, int k0, LAS float* scr, int lane) {
    const int lr = lane >> 3, lc = (lane & 7) * 4;
    f32x4 v[8];
#pragma unroll
    for (int i = 0; i < 8; ++i) v[i] = *(const f32x4*)(W + (size_t)(k0 + 8 * i + lr) * ldw + n0 + lc);
#pragma unroll
    for (int i = 0; i < 8; ++i) { LAS float* d = scr + (8 * i + lr) * 33 + lc; d[0] = v[i].x; d[1] = v[i].y; d[2] = v[i].z; d[3] = v[i].w; }
    LDS_WAIT();
    const int c = lane & 7;
#pragma unroll
    for (int j = 0; j < 4; ++j) { const int n = (lane >> 3) + 8 * j; const LAS float* sp = scr + (8 * c) * 33 + n;
        u32x4 o; o.x = cvt_pk_bf16(sp[0 * 33], sp[1 * 33]); o.y = cvt_pk_bf16(sp[2 * 33], sp[3 * 33]); o.z = cvt_pk_bf16(sp[4 * 33], sp[5 * 33]); o.w = cvt_pk_bf16(sp[6 * 33], sp[7 * 33]);
        *(u32x4*)(WT + (size_t)(dst_row0 + n) * K + k0 + 8 * c) = o; }
    LDS_WAIT();
}
__device__ __forceinline__ void p0_mat_item(const float* W, int ldw, int K, int nb, int csrc, bf16_t* WT, int drow_base, int mode, int it, LAS float* scr, int lane) {
    const int kb = it / nb, nbi = it % nb, n0 = 32 * nbi;
    int drow = drow_base + n0;
    if (mode == 1) drow = (n0 >> 7) * 256 + (n0 & 127) + drow_base;
    p0_transpose_item(W, ldw, K, WT, drow, csrc + n0, 64 * kb, scr, lane);
}
__device__ __forceinline__ void p0_transposes(const Args& a, LAS unsigned char* lds, int part, int gw, int NGW, int lane, int wave) {
    unsigned char* ws = a.ws;
    LAS float* scr = (LAS float*)(lds + wave * 8448);
    constexpr int I_GU = (D / 64) * (FF / 32), I_DN = (FF / 64) * (D / 32), I_ZZ = (D / 64) * 32, I_XB = (D / 64) * 64, I_OUT = (2048 / 64) * 32, I_PL = 4 * 8;
    if (part == 0) {
        for (int it = gw; it < 2 * I_GU + I_DN; it += NGW) {
            int r = it;
            if (r < I_GU) { p0_mat_item(a.in[I_G1], FF, D, FF / 32, 0, (bf16_t*)(ws + WS_WGU1), 0, 1, r, scr, lane); continue; } r -= I_GU;
            if (r < I_GU) { p0_mat_item(a.in[I_U1], FF, D, FF / 32, 0, (bf16_t*)(ws + WS_WGU1), 128, 1, r, scr, lane); continue; } r -= I_GU;
            p0_mat_item(a.in[I_D1], D, FF, D / 32, 0, (bf16_t*)(ws + WS_WD1), 0, 0, r, scr, lane);
        }
    } else {
        constexpr int NITEMS = 2 * I_GU + I_DN + 2 * I_ZZ + I_XB + I_OUT + 4 * I_PL;
        for (int it = gw; it < NITEMS; it += NGW) {
            int r = it;
            if (r < I_ZZ) { p0_mat_item(a.in[I_WIN], DINP, D, 32, 0, (bf16_t*)(ws + WS_WIN), 0, 0, r, scr, lane); continue; } r -= I_ZZ;
            if (r < I_XB) { p0_mat_item(a.in[I_WIN], DINP, D, 64, 1024, (bf16_t*)(ws + WS_WIN), 1024, 0, r, scr, lane); continue; } r -= I_XB;
            if (r < I_ZZ) { p0_mat_item(a.in[I_WIN], DINP, D, 32, 3088, (bf16_t*)(ws + WS_WIN), 3072, 0, r, scr, lane); continue; } r -= I_ZZ;
            if (r < I_OUT) { p0_mat_item(a.in[I_WOUT], D, 2048, 32, 0, (bf16_t*)(ws + WS_WOUT), 0, 0, r, scr, lane); continue; } r -= I_OUT;
            if (r < 4 * I_PL) { const int gq = r / I_PL; p0_mat_item(a.in[I_POOLW] + (size_t)gq * 65536, 256, 256, 8, 0, (bf16_t*)(ws + WS_WPOOL), gq * 256, 0, r % I_PL, scr, lane); continue; } r -= 4 * I_PL;
            if (r < I_GU) { p0_mat_item(a.in[I_G2], FF, D, FF / 32, 0, (bf16_t*)(ws + WS_WGU2), 0, 1, r, scr, lane); continue; } r -= I_GU;
            if (r < I_GU) { p0_mat_item(a.in[I_U2], FF, D, FF / 32, 0, (bf16_t*)(ws + WS_WGU2), 128, 1, r, scr, lane); continue; } r -= I_GU;
            p0_mat_item(a.in[I_D2], D, FF, D / 32, 0, (bf16_t*)(ws + WS_WD2), 0, 0, r, scr, lane);
        }
    }
}
__device__ __forceinline__ void p0_phase(const Args& a, LAS unsigned char* lds, int tid, int lane, int wave, int G) {
    unsigned char* ws = a.ws;
    {
        LAS float* cact = (LAS float*)(lds + 69632);
        LAS float* red = (LAS float*)(lds + 69632 + 16384);
        if ((int)blockIdx.x < NMOD / 64) {
            for (int i = tid; i < 4 * D; i += NTHREADS) { const float cv = a.in[I_C][i]; cact[i] = cv / (1.f + __expf(-cv)); }
            __syncthreads();
        }
        for (int it = blockIdx.x; it < NMOD / 64; it += G) {
            const int j = it * 64 + lane, kb = wave * 128;
            float s0 = 0.f, s1 = 0.f, s2 = 0.f, s3 = 0.f;
            const float* wp = a.in[I_WADA] + (size_t)kb * NMOD + j;
#pragma unroll 8
            for (int k = 0; k < 128; ++k) { const float wv = wp[(size_t)k * NMOD];
                s0 += cact[kb + k] * wv; s1 += cact[D + kb + k] * wv; s2 += cact[2 * D + kb + k] * wv; s3 += cact[3 * D + kb + k] * wv; }
            red[(wave * 4 + 0) * 64 + lane] = s0; red[(wave * 4 + 1) * 64 + lane] = s1; red[(wave * 4 + 2) * 64 + lane] = s2; red[(wave * 4 + 3) * 64 + lane] = s3;
            __syncthreads();
            if (wave < 4) { float t = a.in[I_BADA][j];
#pragma unroll
                for (int w = 0; w < 8; ++w) t += red[(w * 4 + wave) * 64 + lane];
                ((float*)(ws + WS_MOD))[wave * NMOD + j] = t; }
            __syncthreads();
        }
    }
    for (int idx = blockIdx.x * NTHREADS + tid; idx < 16 * D; idx += G * NTHREADS) { const int k = idx >> 4, j = idx & 15; ((float*)(ws + WS_WDT))[j * D + k] = a.in[I_WIN][(size_t)k * DINP + 3072 + j]; }
    p0_transposes(a, lds, 0, blockIdx.x * NWAVES + wave, G * NWAVES, lane, wave);
}

template <bool DTP>
__device__ __forceinline__ void norm_phase(LAS unsigned char* lds, const float* src, const float* nw, const float* mod, int sh_off, int sc_off, bf16_t* dst,
                                           const float* wdt, const float* dt_bias, float* DT, int tid, int lane, int wave, int G) {
    LAS f32x4* wl = (LAS f32x4*)lds;
    if (DTP) { for (int i = tid; i < 16 * D / 4; i += NTHREADS) wl[i] = ((const f32x4*)wdt)[i]; __syncthreads(); }
    const int gw = blockIdx.x * NWAVES + wave, NGW = G * NWAVES;
    for (int rg = gw; rg < M / 8; rg += NGW) {
        const int row0 = rg * 8, b = row0 >> 12;
        f32x4 Am[4], Bm[4];
#pragma unroll
        for (int j = 0; j < 4; ++j) { const int col = 4 * lane + 256 * j;
            const f32x4 w = *(const f32x4*)(nw + col), sc = *(const f32x4*)(mod + (size_t)b * NMOD + sc_off + col);
            Am[j] = w * (sc + 1.f); Bm[j] = *(const f32x4*)(mod + (size_t)b * NMOD + sh_off + col); }
#pragma unroll 1
        for (int half = 0; half < 2; ++half) {
            f32x4 o[4][4];
#pragma unroll
            for (int r = 0; r < 4; ++r) {
                const int row = row0 + half * 4 + r;
                float ss = 0.f;
#pragma unroll
                for (int j = 0; j < 4; ++j) { o[r][j] = *(const f32x4*)(src + (size_t)row * D + 4 * lane + 256 * j); ss += (o[r][j].x * o[r][j].x + o[r][j].y * o[r][j].y) + (o[r][j].z * o[r][j].z + o[r][j].w * o[r][j].w); }
                const float rstd = rsqrtf(wave_sum(ss) * (1.f / D) + EPS);
#pragma unroll
                for (int j = 0; j < 4; ++j) { o[r][j] = o[r][j] * rstd * Am[j] + Bm[j];
                    u32x2 w; w.x = cvt_pk_bf16(o[r][j].x, o[r][j].y); w.y = cvt_pk_bf16(o[r][j].z, o[r][j].w);
                    *(u32x2*)(dst + (size_t)row * D + 4 * lane + 256 * j) = w; }
            }
            if (DTP) {
                float mine = 0.f;
                __builtin_amdgcn_sched_barrier(0);
#pragma unroll 1
                for (int jj = 0; jj < 16; ++jj) {
                    f32x4 wv[4];
#pragma unroll
                    for (int j = 0; j < 4; ++j) wv[j] = wl[jj * 256 + 64 * j + lane];
#pragma unroll
                    for (int r = 0; r < 4; ++r) { float p = 0.f;
#pragma unroll
                        for (int j = 0; j < 4; ++j) p += (o[r][j].x * wv[j].x + o[r][j].y * wv[j].y) + (o[r][j].z * wv[j].z + o[r][j].w * wv[j].w);
                        const float t = wave_sum(p); if (lane == r * 16 + jj) mine = t; }
                }
                const float xv = mine + dt_bias[lane & 15];
                DT[(size_t)(row0 + half * 4 + (lane >> 4)) * 16 + (lane & 15)] = xv > 20.f ? xv : log1pf(__expf(xv));
            }
        }
    }
}
__device__ __forceinline__ void final_norm_phase(float* xio, const float* nw, int lane, int wave, int G) {
    const int gw = blockIdx.x * NWAVES + wave, NGW = G * NWAVES;
    f32x4 wv[4];
#pragma unroll
    for (int j = 0; j < 4; ++j) wv[j] = *(const f32x4*)(nw + 4 * lane + 256 * j);
    for (int rg = gw; rg < M / 4; rg += NGW) {
        f32x4 v[4][4]; float ss[4];
#pragma unroll
        for (int r = 0; r < 4; ++r)
#pragma unroll
            for (int j = 0; j < 4; ++j) v[r][j] = *(const f32x4*)(xio + (size_t)(rg * 4 + r) * D + 4 * lane + 256 * j);
#pragma unroll
        for (int r = 0; r < 4; ++r) { ss[r] = 0.f;
#pragma unroll
            for (int j = 0; j < 4; ++j) ss[r] += (v[r][j].x * v[r][j].x + v[r][j].y * v[r][j].y) + (v[r][j].z * v[r][j].z + v[r][j].w * v[r][j].w); }
#pragma unroll
        for (int r = 0; r < 4; ++r) { const float rstd = rsqrtf(wave_sum(ss[r]) * (1.f / D) + EPS);
#pragma unroll
            for (int j = 0; j < 4; ++j) *(f32x4*)(xio + (size_t)(rg * 4 + r) * D + 4 * lane + 256 * j) = v[r][j] * rstd * wv[j]; }
    }
}

__device__ __forceinline__ void unpack8(const u32x4 v, float (&f)[8]) { f[0] = bf_lo(v.x); f[1] = bf_hi(v.x); f[2] = bf_lo(v.y); f[3] = bf_hi(v.y); f[4] = bf_lo(v.z); f[5] = bf_hi(v.z); f[6] = bf_lo(v.w); f[7] = bf_hi(v.w); }
__device__ __forceinline__ void diff_item(const bf16_t* U, bf16_t* DIFF, int item, int tid) {
    const int oct = tid & 127, sub = tid >> 7, t0 = item * 32 + sub * 8, pos0 = t0 & (SEQ - 1), w = 2 << (oct >> 5);
    const bf16_t* up = U + (size_t)t0 * 1024 + oct * 8;
    float S[8], f[8];
#pragma unroll
    for (int e = 0; e < 8; ++e) S[e] = 0.f;
    for (int j = 1; j <= w; ++j) if (pos0 - j >= 0) { unpack8(*(const u32x4*)(up - (size_t)j * 1024), f);
#pragma unroll
        for (int e = 0; e < 8; ++e) S[e] += f[e]; }
#pragma unroll
    for (int i = 0; i < 8; ++i) {
        const int pos = pos0 + i;
        unpack8(*(const u32x4*)(up + (size_t)i * 1024), f);
#pragma unroll
        for (int e = 0; e < 8; ++e) S[e] += f[e];
        if (pos >= w) { float q[8]; unpack8(*(const u32x4*)(up + (size_t)(i - w) * 1024), q);
#pragma unroll
            for (int e = 0; e < 8; ++e) S[e] -= q[e]; }
        const float inv = 1.f / (float)(pos + 1 < w ? pos + 1 : w);
        u32x4 o; o.x = cvt_pk_bf16(S[0] * inv - f[0], S[1] * inv - f[1]); o.y = cvt_pk_bf16(S[2] * inv - f[2], S[3] * inv - f[3]);
        o.z = cvt_pk_bf16(S[4] * inv - f[4], S[5] * inv - f[5]); o.w = cvt_pk_bf16(S[6] * inv - f[6], S[7] * inv - f[7]);
        *(u32x4*)(DIFF + (size_t)(t0 + i) * 1024 + oct * 8) = o;
    }
}

constexpr int LP = 272;
constexpr int L_C = 0, L_B = 128 * LP, L_XT = 2 * 128 * LP, L_ACS = L_XT + 4 * 64 * LP, L_DTV = L_ACS + 2048, L_SSD_END = L_DTV + 2048;
static_assert(L_SSD_END <= LDS_BYTES, "ssd lds");

__device__ __forceinline__ void ssd_cumsum(LAS unsigned char* lds, const float* DT, const float* a_log, int T0, int g, int lane, int wave) {
    if (wave < 4) {
        const int h = 4 * g + wave; const float av = -__expf(a_log[h]);
        const int t = 2 * lane;
        const float d0 = DT[(size_t)(T0 + t) * 16 + h], d1 = DT[(size_t)(T0 + t + 1) * 16 + h];
        const float v0 = d0 * av, v1 = d1 * av, s = v0 + v1;
        float inc = s;
#pragma unroll
        for (int o = 1; o < 64; o <<= 1) { const float n = __shfl_up(inc, o); if (lane >= o) inc += n; }
        const float exc = inc - s;
        LAS float* acs = (LAS float*)(lds + L_ACS) + wave * 128; LAS float* dtv = (LAS float*)(lds + L_DTV) + wave * 128;
        acs[t] = exc + v0; acs[t + 1] = exc + s; dtv[t] = d0; dtv[t + 1] = d1;
    }
}
template <int MODE>
__device__ __forceinline__ void ssd_stage(LAS unsigned char* lds, const bf16_t* XBC, const float* conv_w, const float* conv_b, int T0, int c, int g, int tid) {
    const LAS float* acs = (const LAS float*)(lds + L_ACS); const LAS float* dtv = (const LAS float*)(lds + L_DTV);
    constexpr int O_LO = (MODE == 0) ? 16 : 0, NO = 64 - O_LO;
#pragma unroll 1
    for (int task = tid; task < NO * 16; task += NTHREADS) {
        const int o = O_LO + task % NO, sg = task / NO;
        const int ch = (o < 16) ? (1536 + g * 128 + o * 8) : (o < 32) ? (1024 + g * 128 + (o - 16) * 8) : (g * 256 + (o - 32) * 8);
        float w[4][8], bs[8];
#pragma unroll
        for (int k = 0; k < 4; ++k) { const f32x4 w0 = *(const f32x4*)(conv_w + k * DXBC + ch), w1 = *(const f32x4*)(conv_w + k * DXBC + ch + 4);
            w[k][0] = w0.x; w[k][1] = w0.y; w[k][2] = w0.z; w[k][3] = w0.w; w[k][4] = w1.x; w[k][5] = w1.y; w[k][6] = w1.z; w[k][7] = w1.w; }
        { const f32x4 b0 = *(const f32x4*)(conv_b + ch), b1 = *(const f32x4*)(conv_b + ch + 4);
          bs[0] = b0.x; bs[1] = b0.y; bs[2] = b0.z; bs[3] = b0.w; bs[4] = b1.x; bs[5] = b1.y; bs[6] = b1.z; bs[7] = b1.w; }
        const bf16_t* src = XBC + ((size_t)(T0 + sg * 8) - 3) * DXBC + ch;
        float out[8][8];
#pragma unroll
        for (int i = 0; i < 8; ++i)
#pragma unroll
            for (int e = 0; e < 8; ++e) out[i][e] = bs[e];
#pragma unroll
        for (int rr = 0; rr < 11; ++rr) {
            const bool valid = (c * 128 + sg * 8 - 3 + rr) >= 0;
            u32x4 rv = (u32x4){0u, 0u, 0u, 0u};
            if (valid) rv = *(const u32x4*)(src + (size_t)rr * DXBC);
            float f[8]; unpack8(rv, f);
#pragma unroll
            for (int k = 0; k < 4; ++k) { const int i = rr - k;
                if (i >= 0 && i < 8) {
#pragma unroll
                    for (int e = 0; e < 8; ++e) out[i][e] += w[k][e] * f[e]; } }
        }
#pragma unroll
        for (int i = 0; i < 8; ++i)
#pragma unroll
            for (int e = 0; e < 8; ++e) out[i][e] = siluf(out[i][e]);
        if (o >= 32) {
            const int r = (o - 32) >> 3, p0 = ((o - 32) & 7) * 8;
            float sc[8];
#pragma unroll
            for (int i = 0; i < 8; ++i) { const int s = sg * 8 + i; sc[i] = dtv[r * 128 + s]; if (MODE == 0) sc[i] *= __expf(acs[r * 128 + 127] - acs[r * 128 + s]); }
#pragma unroll
            for (int e = 0; e < 8; ++e) { u32x4 v; v.x = cvt_pk_bf16(out[0][e] * sc[0], out[1][e] * sc[1]); v.y = cvt_pk_bf16(out[2][e] * sc[2], out[3][e] * sc[3]);
                v.z = cvt_pk_bf16(out[4][e] * sc[4], out[5][e] * sc[5]); v.w = cvt_pk_bf16(out[6][e] * sc[6], out[7][e] * sc[7]);
                *(LAS u32x4*)(lds + L_XT + (r * 64 + p0 + e) * LP + sg * 16) = v; }
        } else if (MODE == 0) {
            const int n0 = (o - 16) * 8;
#pragma unroll
            for (int e = 0; e < 8; ++e) { u32x4 v; v.x = cvt_pk_bf16(out[0][e], out[1][e]); v.y = cvt_pk_bf16(out[2][e], out[3][e]); v.z = cvt_pk_bf16(out[4][e], out[5][e]); v.w = cvt_pk_bf16(out[6][e], out[7][e]);
                *(LAS u32x4*)(lds + L_C + (n0 + e) * LP + sg * 16) = v; }
        } else {
            const int base = (o < 16) ? L_C : L_B, n0 = (o & 15) * 8;
#pragma unroll
            for (int i = 0; i < 8; ++i) { u32x4 v; v.x = cvt_pk_bf16(out[i][0], out[i][1]); v.y = cvt_pk_bf16(out[i][2], out[i][3]); v.z = cvt_pk_bf16(out[i][4], out[i][5]); v.w = cvt_pk_bf16(out[i][6], out[i][7]);
                *(LAS u32x4*)(lds + base + (sg * 8 + i) * LP + n0 * 2) = v; }
        }
    }
}
#define MFMA16(a, b, c) __builtin_amdgcn_mfma_f32_16x16x32_bf16((a), (b), (c), 0, 0, 0)
#define LFRAG(base, row, kk) (*(const LAS bf16x8*)(lds + (base) + (row) * LP + (kk) * 2))

__device__ __forceinline__ void ssd_states_item(const Args& a, LAS unsigned char* lds, int item, int tid, int lane, int wave) {
    const int g = item & 3, c = (item >> 2) & 31, b = item >> 7, T0 = b * SEQ + c * 128, fr = lane & 15, fq = lane >> 4;
    const float* DT = (const float*)(a.ws + WS_DT);
    __syncthreads();
    ssd_cumsum(lds, DT, a.in[I_ALOG], T0, g, lane, wave);
    __syncthreads();
    if (tid < 4) ((float*)(a.ws + WS_CDEC))[(b * 32 + c) * 16 + 4 * g + tid] = __expf(((const LAS float*)(lds + L_ACS))[tid * 128 + 127]);
    ssd_stage<0>(lds, (const bf16_t*)(a.ws + WS_XBC), a.in[I_CONVW], a.in[I_CONVB], T0, c, g, tid);
    __syncthreads();
    const int r = wave >> 1, p0 = (wave & 1) * 32;
    f32x4 st[2][8];
#pragma unroll
    for (int pf = 0; pf < 2; ++pf)
#pragma unroll
        for (int nf = 0; nf < 8; ++nf) st[pf][nf] = (f32x4){0.f, 0.f, 0.f, 0.f};
#pragma unroll
    for (int ks = 0; ks < 4; ++ks) {
        bf16x8 xf[2];
#pragma unroll
        for (int pf = 0; pf < 2; ++pf) xf[pf] = LFRAG(L_XT, r * 64 + p0 + pf * 16 + fr, ks * 32 + fq * 8);
#pragma unroll
        for (int nf = 0; nf < 8; ++nf) { const bf16x8 bf = LFRAG(L_C, nf * 16 + fr, ks * 32 + fq * 8);
#pragma unroll
            for (int pf = 0; pf < 2; ++pf) st[pf][nf] = MFMA16(bf, xf[pf], st[pf][nf]); }
    }
    bf16_t* SP = (bf16_t*)((unsigned char*)a.out + DO_STATES) + ((size_t)((b * 32 + c) * 16 + 4 * g + r) * 64) * 128;
#ifndef DBG_ST
#define DBG_ST 0
#endif
#if DBG_ST == 1
#pragma unroll
    for (int pf = 0; pf < 2; ++pf)
#pragma unroll
        for (int nf = 0; nf < 8; ++nf) st[pf][nf] = (f32x4){1.f, 2.f, 3.f, 4.f};
#elif DBG_ST == 2
#pragma unroll
    for (int pf = 0; pf < 2; ++pf)
#pragma unroll
        for (int nf = 0; nf < 8; ++nf) { const bf16x8 q = LFRAG(L_XT, r * 64 + p0 + pf * 16 + fr, (nf & 3) * 32 + fq * 8); st[pf][nf] = (f32x4){(float)q[0], (float)q[1], (float)q[6], (float)q[7]}; }
#elif DBG_ST == 3
#pragma unroll
    for (int pf = 0; pf < 2; ++pf)
#pragma unroll
        for (int nf = 0; nf < 8; ++nf) { const bf16x8 q = LFRAG(L_C, nf * 16 + fr, (pf * 2) * 32 + fq * 8); st[pf][nf] = (f32x4){(float)q[0], (float)q[1], (float)q[6], (float)q[7]}; }
#endif
#pragma unroll
    for (int pf = 0; pf < 2; ++pf)
#pragma unroll
        for (int nf = 0; nf < 8; ++nf) { const f32x4 v = st[pf][nf]; u32x2 w; w.x = cvt_pk_bf16(v[0], v[1]); w.y = cvt_pk_bf16(v[2], v[3]);
            *(u32x2*)(SP + (size_t)(p0 + pf * 16 + fr) * 128 + nf * 16 + fq * 4) = w; }
}

__device__ __forceinline__ void scan_phase(const Args& a, LAS unsigned char* lds, int tid, int G) {
    bf16_t* SP = (bf16_t*)((unsigned char*)a.out + DO_STATES);
    const float* CD = (const float*)(a.ws + WS_CDEC);
    LAS float* dl = (LAS float*)lds;
    for (int tb = blockIdx.x; tb < BATCH * NHEAD * 64 * 32 / NTHREADS; tb += G) {
        const int task = tb * NTHREADS + tid;
        const int n4 = task & 31, p = (task >> 5) & 63, h = (task >> 11) & 15, b = task >> 15;
        __syncthreads();
        if (tid < 32) dl[tid] = CD[(b * 32 + tid) * 16 + h];
        u32x2* base = (u32x2*)(SP + ((size_t)((b * 32) * 16 + h) * 64 + p) * 128 + n4 * 4);
        constexpr size_t cstride = (size_t)16 * 64 * 128 / 4;
        u32x2 sv[32];
#pragma unroll
        for (int c = 0; c < 32; ++c) sv[c] = base[c * cstride];
        __syncthreads();
        asm volatile("" ::: "memory");
        float r0 = 0.f, r1 = 0.f, r2 = 0.f, r3 = 0.f;
#pragma unroll
        for (int c = 0; c < 32; ++c) {
            const float dec = dl[c];
            u32x2 o; o.x = cvt_pk_bf16(r0, r1); o.y = cvt_pk_bf16(r2, r3);
            r0 = r0 * dec + bf_lo(sv[c].x); r1 = r1 * dec + bf_hi(sv[c].x); r2 = r2 * dec + bf_lo(sv[c].y); r3 = r3 * dec + bf_hi(sv[c].y);
            base[c * cstride] = o;
        }
    }
}

__device__ __forceinline__ void ssd_out_item(const Args& a, LAS unsigned char* lds, int item, int tid, int lane, int wave) {
    const int g = item & 3, c = (item >> 2) & 31, b = item >> 7, T0 = b * SEQ + c * 128, fr = lane & 15, fq = lane >> 4;
    const float* DT = (const float*)(a.ws + WS_DT);
    const LAS float* acs = (const LAS float*)(lds + L_ACS); const LAS float* dtv = (const LAS float*)(lds + L_DTV);
    __syncthreads();
    ssd_cumsum(lds, DT, a.in[I_ALOG], T0, g, lane, wave);
    __syncthreads();
    ssd_stage<1>(lds, (const bf16_t*)(a.ws + WS_XBC), a.in[I_CONVW], a.in[I_CONVB], T0, c, g, tid);
    __syncthreads();
    const int l0 = wave * 16, l = l0 + fr;
    f32x4 sacc[8];
#pragma unroll
    for (int sf = 0; sf < 8; ++sf) sacc[sf] = (f32x4){0.f, 0.f, 0.f, 0.f};
#pragma unroll
    for (int ks = 0; ks < 4; ++ks) { const bf16x8 cf = LFRAG(L_C, l, ks * 32 + fq * 8);
#pragma unroll
        for (int sf = 0; sf < 8; ++sf) { const bf16x8 bf = LFRAG(L_B, sf * 16 + fr, ks * 32 + fq * 8); sacc[sf] = MFMA16(bf, cf, sacc[sf]); } }
    __syncthreads();
    const int L_M = L_B + wave * 16 * LP;
    const bf16_t* PV = (const bf16_t*)((const unsigned char*)a.out + DO_STATES) + ((size_t)((b * 32 + c) * 16 + 4 * g) * 64) * 128;
    f32x4 y[4][4];
#pragma unroll
    for (int r = 0; r < 4; ++r) {
        const float al = acs[r * 128 + l];
#pragma unroll
        for (int pf = 0; pf < 4; ++pf) y[r][pf] = (f32x4){0.f, 0.f, 0.f, 0.f};
#pragma unroll
        for (int ks = 0; ks < 4; ++ks) {
            const bf16x8 cf = LFRAG(L_C, l, ks * 32 + fq * 8);
#pragma unroll
            for (int pf = 0; pf < 4; ++pf) {
                const bf16x8 pv = *(const bf16x8*)(PV + (size_t)(r * 64 + pf * 16 + fr) * 128 + ks * 32 + fq * 8);
                y[r][pf] = MFMA16(pv, cf, y[r][pf]);
            }
        }
        const float sd = __expf(al);
#pragma unroll
        for (int pf = 0; pf < 4; ++pf) y[r][pf] = y[r][pf] * sd;
#pragma unroll
        for (int sf = 0; sf < 8; ++sf) { const f32x4 as = *(const LAS f32x4*)(acs + r * 128 + sf * 16 + fq * 4); float mv[4];
#pragma unroll
            for (int jj = 0; jj < 4; ++jj) { const int s = sf * 16 + fq * 4 + jj; mv[jj] = (s <= l) ? sacc[sf][jj] * __expf(fminf(al - as[jj], 0.f)) : 0.f; }
            u32x2 w; w.x = cvt_pk_bf16(mv[0], mv[1]); w.y = cvt_pk_bf16(mv[2], mv[3]);
            *(LAS u32x2*)(lds + L_M + fr * LP + (sf * 16 + fq * 4) * 2) = w; }
        __syncthreads();
#pragma unroll
        for (int ks = 0; ks < 4; ++ks) {
            const bf16x8 mf = LFRAG(L_M, fr, ks * 32 + fq * 8);
#pragma unroll
            for (int pf = 0; pf < 4; ++pf) {
                const bf16x8 xf = LFRAG(L_XT, r * 64 + pf * 16 + fr, ks * 32 + fq * 8);
                y[r][pf] = MFMA16(xf, mf, y[r][pf]);
            }
        }
        __syncthreads();
    }
    const size_t tok = (size_t)(T0 + l);
    const bf16_t* Zp = (const bf16_t*)(a.ws + WS_Z) + tok * 1024 + g * 256;
    float ssq = 0.f;
#pragma unroll
    for (int r = 0; r < 4; ++r) {
        const float dsk = a.in[I_DSKIP][4 * g + r] / dtv[r * 128 + l];
#pragma unroll
        for (int pf = 0; pf < 4; ++pf) {
            const int p = pf * 16 + fq * 4;
            const u32x2 zz = *(const u32x2*)(Zp + r * 64 + p);
            const float zf[4] = {bf_lo(zz.x), bf_hi(zz.x), bf_lo(zz.y), bf_hi(zz.y)};
#pragma unroll
            for (int jj = 0; jj < 4; ++jj) {
                const float xdt = __uint_as_float((unsigned)(*(const LAS bf16_t*)(lds + L_XT + (r * 64 + p + jj) * LP + l * 2)) << 16);
                const float v = (y[r][pf][jj] + dsk * xdt) * siluf(zf[jj]);
                y[r][pf][jj] = v; ssq += v * v;
            }
        }
    }
    ssq += __shfl_xor(ssq, 16); ssq += __shfl_xor(ssq, 32);
    const float rstd = rsqrtf(ssq * (1.f / 256.f) + EPS);
    bf16_t* Yp = (bf16_t*)((unsigned char*)a.out + DO_H) + tok * 1024 + g * 256;
#pragma unroll
    for (int r = 0; r < 4; ++r)
#pragma unroll
        for (int pf = 0; pf < 4; ++pf) { const int p = pf * 16 + fq * 4; const f32x4 nwv = *(const f32x4*)(a.in[I_SSDNW] + g * 256 + r * 64 + p);
            u32x2 w; w.x = cvt_pk_bf16(y[r][pf][0] * rstd * nwv.x, y[r][pf][1] * rstd * nwv.y); w.y = cvt_pk_bf16(y[r][pf][2] * rstd * nwv.z, y[r][pf][3] * rstd * nwv.w);
            *(u32x2*)(Yp + r * 64 + p) = w; }
}


#define XB_TMO      128
#define XB_XCNT(j)  (256  + 64 * (j))
#define XB_XSUB(j)  (1280 + 64 * (j))
#define XB_XGEN(j)  (2304 + 64 * (j))
#define XB_TOP      3328
#define XB_TOPGEN   3392
#define XCD_BAR_WORDS 3456
#define XB_SPIN_CAP (1u << 18)
__device__ __forceinline__ unsigned xb_ld(unsigned* p)              { return __hip_atomic_load(p, __ATOMIC_RELAXED, __HIP_MEMORY_SCOPE_AGENT); }
__device__ __forceinline__ unsigned xb_add(unsigned* p, unsigned v) { return __hip_atomic_fetch_add(p, v, __ATOMIC_RELAXED, __HIP_MEMORY_SCOPE_AGENT); }
__device__ __forceinline__ unsigned xb_xcc_id() { return (unsigned)__builtin_amdgcn_s_getreg((3 << 11) | 20) & 0xFu; }
#define XB_SPIN(cond, bar) do { unsigned _sp = 0; while (cond) { __builtin_amdgcn_s_sleep(1); \
    if ((++_sp & 255u) == 0u) { if (xb_ld(&(bar)[XB_TMO])) break; if (_sp > XB_SPIN_CAP) { atomicAdd(&(bar)[XB_TMO], 1u); break; } } } } while (0)
struct XcdBarrier { unsigned* bar; unsigned x; volatile LAS unsigned* st; };
__device__ __forceinline__ XcdBarrier xcd_barrier_post(unsigned* bar, volatile LAS unsigned* st) {
    XcdBarrier b; b.bar = bar; b.x = xb_xcc_id(); b.st = st;
    if (threadIdx.x == 0) (void)xb_add(&bar[XB_XCNT(b.x)], 1u);
    return b;
}
__device__ __forceinline__ void xcd_barrier_complete(unsigned* bar, unsigned x, unsigned& nloc, unsigned& nx) {
    const unsigned G = gridDim.x * gridDim.y * gridDim.z;
    unsigned sum, cnt, mine, sp = 0u;
    for (;;) {
        sum = 0u; cnt = 0u; mine = 0u;
#pragma unroll
        for (unsigned j = 0; j < 16; ++j) { const unsigned c = xb_ld(&bar[XB_XCNT(j)]); sum += c; cnt += (c > 0u) ? 1u : 0u; mine = (j == x) ? c : mine; }
        if (sum == G) break;
        __builtin_amdgcn_s_sleep(1);
        if ((++sp & 255u) == 0u) { if (xb_ld(&bar[XB_TMO])) break; if (sp > XB_SPIN_CAP) { atomicAdd(&bar[XB_TMO], 1u); break; } }
    }
    nloc = mine > 0u ? mine : 1u; nx = cnt > 0u ? cnt : 1u;
}
__device__ __forceinline__ void xcd_barrier(const XcdBarrier& b) {
    asm volatile("s_waitcnt vmcnt(0)" ::: "memory");
    __syncthreads();
    if (threadIdx.x == 0) {
        unsigned* bar = b.bar;
        __builtin_amdgcn_s_waitcnt(0);
        unsigned nloc = b.st[0], nx = b.st[1];
        if (nloc == 0u) { xcd_barrier_complete(bar, b.x, nloc, nx); b.st[0] = nloc; b.st[1] = nx; }
        const unsigned old = xb_add(&bar[XB_XSUB(b.x)], 1u);
        const unsigned gen = old / nloc;
        if (old + 1u == (gen + 1u) * nloc) {
            __builtin_amdgcn_fence(__ATOMIC_RELEASE, "agent");
            asm volatile("s_waitcnt vmcnt(0)" ::: "memory");
            const unsigned og = xb_add(&bar[XB_TOP], 1u);
            const unsigned tg = og / nx;
            if (og + 1u == (tg + 1u) * nx) xb_add(&bar[XB_TOPGEN], 1u);
            else XB_SPIN(xb_ld(&bar[XB_TOPGEN]) == tg, bar);
            __builtin_amdgcn_fence(__ATOMIC_ACQUIRE, "agent");
            xb_add(&bar[XB_XGEN(b.x)], 1u);
            asm volatile("s_waitcnt vmcnt(0)" ::: "memory");
        } else {
            XB_SPIN(xb_ld(&bar[XB_XGEN(b.x)]) == gen, bar);
            __builtin_amdgcn_fence(__ATOMIC_ACQUIRE, "agent");
            asm volatile("s_waitcnt vmcnt(0)" ::: "memory");
        }
    }
    __syncthreads();
}

__global__ void __launch_bounds__(NTHREADS, 2) fwd_megakernel(Args a) {
    extern __shared__ __attribute__((aligned(16))) unsigned char lds_raw[];
    LAS unsigned char* lds = (LAS unsigned char*)lds_raw;
    cg::grid_group grid = cg::this_grid();
    const int G = gridDim.x;
#define PH_IDS() int tid = threadIdx.x; asm volatile("" : "+v"(tid)); const int lane = tid & 63, wave = __builtin_amdgcn_readfirstlane(tid >> 6); (void)lane; (void)wave
    unsigned char* ws = a.ws;
    const float* mod = (const float*)(ws + WS_MOD);
    bf16_t* H = (bf16_t*)((unsigned char*)a.out + DO_H);
    float* XR = (float*)(ws + WS_XR);
    const int lo = a.ph_lo, hi = a.ph_hi;
#ifndef ONLYPH
#define ONLYPH -1
#endif
#define IN(k) ((ONLYPH < 0 || ONLYPH == (k)) && lo <= (k) && (k) < hi)
    volatile LAS unsigned* bst = (volatile LAS unsigned*)(lds + LDS_BYTES - 64);
    if (threadIdx.x < 16) bst[threadIdx.x] = 0u;
    __syncthreads();
    XcdBarrier xbar = xcd_barrier_post((unsigned*)(ws + WS_BAR), bst);
    if (a.ph_hi > 1000) grid.sync();
#define SEAM(k) do { if (IN(k) && IN((k) + 1)) xcd_barrier(xbar); } while (0)
#ifndef DUP_MASK
#define DUP_MASK 0
#endif
#define REP(k) for (int rep_ = 0; rep_ < (((DUP_MASK >> (k)) & 1) ? 2 : 1); ++rep_, (rep_ < (((DUP_MASK >> (k)) & 1) ? 2 : 1) ? xcd_barrier(xbar) : (void)0))

    if (IN(0)) REP(0) { PH_IDS(); p0_phase(a, lds, tid, lane, wave, G); }
    SEAM(0);
    if (IN(1)) REP(1) { PH_IDS(); norm_phase<false>(lds, a.in[I_X], a.in[I_N1], mod, 0 * D, 1 * D, H, nullptr, nullptr, nullptr, tid, lane, wave, G); }
    SEAM(1);
    if (IN(2)) REP(2) { pg8::Gemm g{H, H, (const bf16_t*)(ws + WS_WGU1), M, 2 * FF, D, D, D, 1 << 30, 0}; pg8::StaticOrder S; S.init(M, 2 * FF, G, blockIdx.x);
        pg8::EpiSwiGLU E{(bf16_t*)(ws + WS_ACT)}; pg8::gemm_phase(lds, g, S, E);
        { const int nidle = G - (S.nwg % G); PH_IDS();
          if ((S.nwg % G) != 0 && (int)blockIdx.x >= G - nidle) p0_transposes(a, lds, 1, ((int)blockIdx.x - (G - nidle)) * NWAVES + wave, nidle * NWAVES, lane, wave);
          else if ((S.nwg % G) == 0) p0_transposes(a, lds, 1, blockIdx.x * NWAVES + wave, G * NWAVES, lane, wave); } }
    SEAM(2);
    if (IN(3)) REP(3) { pg8::Gemm g{(const bf16_t*)(ws + WS_ACT), (const bf16_t*)(ws + WS_ACT), (const bf16_t*)(ws + WS_WD1), M, D, FF, FF, FF, 1 << 30, 0}; pg8::StaticOrder S; S.init(M, D, G, blockIdx.x);
        pg8::EpiResid E{a.in[I_X], XR, mod + 2 * D, 0.5f}; pg8::gemm_phase(lds, g, S, E); }
    SEAM(3);
    if (IN(4)) REP(4) { PH_IDS(); norm_phase<true>(lds, XR, a.in[I_NMIX], mod, 3 * D, 4 * D, H, (const float*)(ws + WS_WDT), a.in[I_DTB], (float*)(ws + WS_DT), tid, lane, wave, G); }
    SEAM(4);
    if (IN(5)) REP(5) { pg8::Gemm g{H, H, (const bf16_t*)(ws + WS_WIN), M, NPROJ, D, D, D, 1 << 30, 0}; pg8::StaticOrder S; S.init(M, NPROJ, G, blockIdx.x);
        pg8::EpiSplit E{(bf16_t*)(ws + WS_Z), (bf16_t*)(ws + WS_XBC), (bf16_t*)(ws + WS_U)}; pg8::gemm_phase(lds, g, S, E); }
    SEAM(5);
    if (IN(6)) REP(6) { PH_IDS();
        for (int it = blockIdx.x; it < BATCH * NCHUNK * 4; it += G) ssd_states_item(a, lds, it, tid, lane, wave);
        for (int it = blockIdx.x; it < M / 32; it += G) diff_item((const bf16_t*)(ws + WS_U), H, it, tid);
    }
    SEAM(6);
    if (IN(7)) REP(7) { PH_IDS();
        scan_phase(a, lds, tid, G);
        __syncthreads();
        REP(14) {
        pg8::Gemm g{H, H, (const bf16_t*)(ws + WS_WPOOL), M, 1024, 256, 1024, 256, 1 << 30, 256}; pg8::StaticOrder S; S.init(M, 1024, G, blockIdx.x);
        pg8::EpiPool E{(bf16_t*)(ws + WS_YPOOL), a.in[I_POOLB], a.in[I_POOLS]}; pg8::gemm_phase(lds, g, S, E);
        }
    }
    SEAM(7);
    if (IN(8)) REP(8) { PH_IDS(); for (int it = blockIdx.x; it < BATCH * NCHUNK * 4; it += G) ssd_out_item(a, lds, it, tid, lane, wave); }
    SEAM(8);
    if (IN(9)) REP(9) { __syncthreads();
        pg8::Gemm g{H, (const bf16_t*)(ws + WS_YPOOL), (const bf16_t*)(ws + WS_WOUT), M, D, 2048, 1024, 2048, 16, 0}; pg8::StaticOrder S; S.init(M, D, G, blockIdx.x);
        pg8::EpiResidNorm<false> E{XR, XR, mod + 5 * D, a.in[I_N2], mod + 6 * D, mod + 7 * D, H, nullptr, (float*)(ws + WS_SSQ) + 1 * M * 4, (unsigned*)(ws + WS_CNT) + 1 * 64 * 64}; pg8::gemm_phase(lds, g, S, E); }
    SEAM(9);
    if (IN(11)) REP(11) { pg8::Gemm g{H, H, (const bf16_t*)(ws + WS_WGU2), M, 2 * FF, D, D, D, 1 << 30, 0}; pg8::StaticOrder S; S.init(M, 2 * FF, G, blockIdx.x);
        pg8::EpiSwiGLU E{(bf16_t*)(ws + WS_ACT)}; pg8::gemm_phase(lds, g, S, E); }
    SEAM(11);
    if (IN(12)) REP(12) { pg8::Gemm g{(const bf16_t*)(ws + WS_ACT), (const bf16_t*)(ws + WS_ACT), (const bf16_t*)(ws + WS_WD2), M, D, FF, FF, FF, 1 << 30, 0}; pg8::StaticOrder S; S.init(M, D, G, blockIdx.x);
        pg8::EpiResidNorm<true> E{XR, nullptr, mod + 8 * D, a.in[I_NF], nullptr, nullptr, nullptr, a.out, (float*)(ws + WS_SSQ) + 2 * M * 4, (unsigned*)(ws + WS_CNT) + 2 * 64 * 64}; pg8::gemm_phase(lds, g, S, E); }
#undef IN
#undef SEAM
}


#ifndef DBG_K
#define DBG_K -1
#endif
__global__ void dbg_dump(float* out, const void* src, int mode, int nch) {
    for (size_t i = (size_t)blockIdx.x * blockDim.x + threadIdx.x; i < (size_t)M * 1024; i += (size_t)gridDim.x * blockDim.x) {
        float v = 0.f;
        if (mode == 0) v = ((const float*)src)[i];
        else if (mode == 2) v = __uint_as_float((unsigned)((const bf16_t*)src)[i + (size_t)M * 1024] << 16);
        else for (int j = 0; j < nch; ++j) v += __uint_as_float((unsigned)((const bf16_t*)src)[i + (size_t)j * M * 1024] << 16);
        out[i] = v;
    }
}
extern "C" void kernel_launch(void* const* d_in, const int* in_sizes, int n_in, void* d_out, int out_size, void* d_ws, size_t ws_size, hipStream_t stream) {
    static int grid_blocks = 0;
    if (grid_blocks == 0) {
        int dev = 0, cus = 0, per_cu = 0;
        (void)hipGetDevice(&dev);
        (void)hipDeviceGetAttribute(&cus, hipDeviceAttributeMultiprocessorCount, dev);
        if (hipFuncSetAttribute((const void*)fwd_megakernel, hipFuncAttributeMaxDynamicSharedMemorySize, LDS_BYTES) != hipSuccess) { fprintf(stderr, "hipFuncSetAttribute failed\n"); grid_blocks = -1; return; }
        if (hipOccupancyMaxActiveBlocksPerMultiprocessor(&per_cu, (const void*)fwd_megakernel, NTHREADS, LDS_BYTES) != hipSuccess || per_cu < 1) { fprintf(stderr, "occupancy query: %d blocks/CU\n", per_cu); grid_blocks = -1; return; }
        grid_blocks = cus;
        if (n_in != 25 || ws_size < WS_END) { fprintf(stderr, "unexpected problem: n_in %d ws %zu\n", n_in, ws_size); grid_blocks = -1; return; }
    }
    if (grid_blocks < 0) return;
    Args a{};
    for (int i = 0; i < 25; ++i) a.in[i] = (const float*)d_in[i];
    a.out = (float*)d_out; a.ws = (unsigned char*)d_ws;
    (void)hipMemsetAsync((unsigned char*)d_ws + WS_BAR, 0, BAR_BYTES, stream);
#ifndef MK_PER_PHASE
#define MK_PER_PHASE 0
#endif
#if MK_PER_PHASE
    const int kmax = (DBG_K >= 0) ? DBG_K : 13;
    for (int k = 0; k <= kmax; ++k) { a.ph_lo = k; a.ph_hi = k + 1; hipLaunchKernelGGL(fwd_megakernel, dim3(grid_blocks), dim3(NTHREADS), LDS_BYTES, stream, a); }
    if (DBG_K >= 0) {
        const unsigned char* ws = (const unsigned char*)d_ws; const void* src = ws + WS_XR; int mode = 0, nch = 1;
        if (DBG_K == 5) { src = ws + WS_Z; mode = 1; nch = 4; }
        if (DBG_K == 2) { src = ws + WS_ACT; mode = 1; nch = 2; }
        if (DBG_K == 6) { src = (const unsigned char*)d_out; mode = 2; nch = 1; }
        if (DBG_K == 7) { src = ws + WS_YPOOL; mode = 1; nch = 1; }
        if (DBG_K == 8) { src = d_out; mode = 1; nch = 1; }
        if (DBG_K == 1) { src = d_out; mode = 1; nch = 1; }
        if (DBG_K == 4) { src = ws + WS_DT; mode = 0; nch = 1; }
        if (src == (const void*)d_out) { (void)hipMemcpyAsync((unsigned char*)d_ws + WS_XR, d_out, 64 * MiB, hipMemcpyDeviceToDevice, stream); src = ws + WS_XR; }
        hipLaunchKernelGGL(dbg_dump, dim3(2048), dim3(256), 0, stream, (float*)d_out, src, mode, nch);
    }
#else
    a.ph_lo = 0; a.ph_hi = 14;
    void* args[] = {&a};
    hipError_t e = hipLaunchCooperativeKernel((const void*)fwd_megakernel, dim3(grid_blocks), dim3(NTHREADS), args, LDS_BYTES, stream);
    if (e != hipSuccess) fprintf(stderr, "cooperative launch failed: %s (grid %d)\n", hipGetErrorString(e), grid_blocks);
#endif
}
```

```cpp
#include <hip/hip_runtime.h>
#include <hip/hip_cooperative_groups.h>
#include <cstdio>
namespace cg = cooperative_groups;

#define LAS __attribute__((address_space(3)))
typedef unsigned short bf16_t;
typedef short bf16x8 __attribute__((ext_vector_type(8)));
typedef float f32x4 __attribute__((ext_vector_type(4)));
typedef float f32x2 __attribute__((ext_vector_type(2)));
typedef unsigned u32x4 __attribute__((ext_vector_type(4)));
typedef unsigned u32x2 __attribute__((ext_vector_type(2)));

constexpr int BATCH = 4, SEQ = 4096, D = 1024, M = BATCH * SEQ, FF = 2816, NPROJ = 4096, DINP = 4112, DXBC = 2048, NMOD = 9 * D;
constexpr int NCHUNK = 32, NHEAD = 16;
constexpr float EPS = 1e-6f;
constexpr int NWAVES = 8, NTHREADS = 512;
constexpr int LDS_BYTES = 147456;

constexpr size_t KiB = 1024, MiB = 1u << 20;
constexpr size_t WS_MOD = 0, WS_CDEC = 256 * KiB, WS_WDT = 512 * KiB, WS_BAR = 768 * KiB, BAR_BYTES = 128 * KiB, WS_CNT = WS_BAR + 16 * KiB, WS_SSQ = 1 * MiB, WS_DT = 2 * MiB;
constexpr size_t WS_WPOOL = 4 * MiB, WS_WOUT = WS_WPOOL + MiB / 2, WS_WGU2 = WS_WOUT + 4 * MiB, WS_WD2 = WS_WGU2 + 11 * MiB, WS_WGU1 = WS_WD2 + 11 * MiB / 2,
                 WS_WD1 = WS_WGU1 + 11 * MiB, WS_WIN = WS_WD1 + 11 * MiB / 2, WS_XR = WS_WIN + 8 * MiB, WS_R2 = WS_XR + 64 * MiB;
constexpr size_t WS_ACT = WS_R2, WS_Z = WS_R2, WS_XBC = WS_R2 + 32 * MiB, WS_U = WS_R2 + 96 * MiB, WS_YPOOL = WS_U, WS_END = WS_U + 32 * MiB;
static_assert(WS_END <= 256 * MiB, "ws map");
static_assert(WS_ACT + (size_t)M * FF * 2 <= 256 * MiB, "ws map act");
constexpr size_t DO_H = 0, DO_STATES = 32 * MiB;

__device__ __forceinline__ float wave_sum(float v) {
#pragma unroll
    for (int o = 1; o < 64; o <<= 1) v += __shfl_xor(v, o);
    return v;
}
typedef __bf16 bf16x2_t __attribute__((ext_vector_type(2)));
__device__ __forceinline__ unsigned cvt_pk_bf16(float lo, float hi) { f32x2 v = {lo, hi}; bf16x2_t r = __builtin_convertvector(v, bf16x2_t); return __builtin_bit_cast(unsigned, r); }
__device__ __forceinline__ float bf_lo(unsigned u) { return __uint_as_float(u << 16); }
__device__ __forceinline__ float bf_hi(unsigned u) { return __uint_as_float(u & 0xffff0000u); }
__device__ __forceinline__ float siluf(float x) { return x * __builtin_amdgcn_rcpf(1.f + __builtin_amdgcn_exp2f(-1.44269504f * x)); }
#define LDS_WAIT() asm volatile("s_waitcnt lgkmcnt(0)" ::: "memory")

namespace pg8 {
constexpr int BM = 256, BK = 64, HALF = 128, HTB = HALF * BK * 2, STAGE_BYTES = 8 * HTB, NXCD = 8, WGM = 8;
__device__ __forceinline__ int lds_byte(int r, int c) { const int st = (r >> 4) * 2 + (c >> 5), rr = r & 15, cc = c & 31, ob = rr * 64 + cc * 2; return st * 1024 + (ob ^ (((ob >> 9) & 1) << 5)); }
__device__ __forceinline__ void stage_rc(int b, int& R, int& C) { const int st = b / 1024, sb = b % 1024, swz = sb ^ (((sb >> 9) & 1) << 5); R = (st >> 1) * 16 + swz / 64; C = (st & 1) * 32 + (swz % 64) / 2; }
struct Unit { int pm, pn; };
struct Gemm { const bf16_t* A; const bf16_t* A2; const bf16_t* Bt; int M, N, K, lda, ldb, ksplit, a_pn_off; };
struct StaticOrder {
    int nM, nN, nwg, G, c;
    __device__ void init(int M_, int N_, int G_, int c_) { nM = M_ / BM; nN = N_ / BM; nwg = nM * nN; G = G_; c = c_; }
    __device__ bool next(int i, Unit& u) const {
        const long L = (long)i * G + c; if (L >= nwg) return false;
        int wgid = (int)L; { const int q = nwg / NXCD, r = nwg % NXCD, xcd = wgid % NXCD, off = wgid / NXCD; wgid = (xcd < r ? xcd * (q + 1) : r * (q + 1) + (xcd - r) * q) + off; }
        const int nig = WGM * nN, gid = wgid / nig, fm = gid * WGM, gsz = (nM - fm) < WGM ? (nM - fm) : WGM;
        u.pm = fm + ((wgid % nig) % gsz); u.pn = (wgid % nig) / gsz; return true;
    }
};
template <class Epi>
__device__ __forceinline__ void gemm_phase(LAS unsigned char* lds, const Gemm g, const StaticOrder& S, const Epi& E) {
    int tid = threadIdx.x; asm volatile("" : "+v"(tid));
    const int wid = __builtin_amdgcn_readfirstlane(tid >> 6), lane = tid & 63, wr = wid >> 2, wc = wid & 3, fr = lane & 15, fq = lane >> 4;
    int nt = g.K / BK, ksplit = g.ksplit;
    asm volatile("" : "+s"(nt), "+s"(ksplit));
    unsigned voffA[2], voffB[2];
#pragma unroll
    for (int i = 0; i < 2; ++i) { int R, C; stage_rc(tid * 16 + i * 8192, R, C); voffA[i] = (unsigned)(R * g.lda + C) * 2u; voffB[i] = (unsigned)(R * g.ldb + C) * 2u; }
    const size_t kstep = (size_t)(BK * 2);
    const size_t hstepA = (size_t)HALF * g.lda * 2, hstepB = (size_t)HALF * g.ldb * 2;
    const size_t tstepA = 2 * hstepA, tstepB = 2 * hstepB;
    const unsigned ldsw = (unsigned)wid * 1024u;
    const int aoff = lds_byte(wr * 64 + fr, fq * 8), boff = lds_byte(wc * 32 + fr, fq * 8);
#define PG8_SA(b, h) (((b) * 2 + (h)) * HTB)
#define PG8_SB(b, h) ((4 + (b) * 2 + (h)) * HTB)
#define PG8_STAGE(bufoff, gbase, voff) do { _Pragma("unroll") for (int _i = 0; _i < 2; ++_i) \
        __builtin_amdgcn_global_load_lds((const unsigned*)((const char*)(gbase) + (voff)[_i]), (LAS unsigned*)(lds + (bufoff) + ldsw + _i * 8192), 16, 0, 0); } while (0)
#define PG8_LDA(dst, b, h) do { _Pragma("unroll") for (int m = 0; m < 4; ++m) _Pragma("unroll") for (int k = 0; k < 2; ++k) dst[m][k] = *(const LAS bf16x8*)(lds + PG8_SA(b, h) + aoff + m * 2048 + k * 1024); } while (0)
#define PG8_LDB(dst, b, h) do { _Pragma("unroll") for (int n = 0; n < 2; ++n) _Pragma("unroll") for (int k = 0; k < 2; ++k) dst[n][k] = *(const LAS bf16x8*)(lds + PG8_SB(b, h) + boff + n * 2048 + k * 1024); } while (0)
#define PG8_MMA(ai, bj, At, Bt) do { __builtin_amdgcn_s_setprio(1); _Pragma("unroll") for (int m = 0; m < 4; ++m) _Pragma("unroll") for (int n = 0; n < 2; ++n) _Pragma("unroll") for (int k = 0; k < 2; ++k) \
        acc[ai][bj][m][n] = __builtin_amdgcn_mfma_f32_16x16x32_bf16(Bt[n][k], At[m][k], acc[ai][bj][m][n], 0, 0, 0); __builtin_amdgcn_s_setprio(0); } while (0)
#define PG8_WAIT_V(n) asm volatile("s_waitcnt vmcnt(" #n ")" ::: "memory")
#define PG8_WAIT_L(n) asm volatile("s_waitcnt lgkmcnt(" #n ")" ::: "memory")
#define PG8_BAR __builtin_amdgcn_s_barrier()
#define PG8_SCHED __builtin_amdgcn_sched_barrier(0)
#define PG8_TILEA(c1, c2, t) ((t) < ksplit ? (c1) + (size_t)(t) * kstep : (c2) + (size_t)((t) - ksplit) * kstep)
    Unit cur, nxt; int ui = 0;
    if (!S.next(0, cur)) return;
    f32x4 acc[2][2][4][2];
#pragma unroll
    for (int a = 0; a < 2; ++a)
#pragma unroll
        for (int b = 0; b < 2; ++b)
#pragma unroll
            for (int m = 0; m < 4; ++m)
#pragma unroll
                for (int n = 0; n < 2; ++n) acc[a][b][m][n] = (f32x4){0.f, 0.f, 0.f, 0.f};
    bf16x8 At[4][2], B0[2][2], B1[2][2];
    const char* cA = (const char*)g.A + (size_t)cur.pm * tstepA + (size_t)cur.pn * g.a_pn_off * 2;
    const char* cA2 = (const char*)g.A2 + (size_t)cur.pm * tstepA + (size_t)cur.pn * g.a_pn_off * 2;
    const char* cB = (const char*)g.Bt + (size_t)cur.pn * tstepB;
    PG8_STAGE(PG8_SB(0, 0), cB, voffB); PG8_STAGE(PG8_SA(0, 0), cA, voffA); PG8_STAGE(PG8_SB(0, 1), cB + hstepB, voffB); PG8_STAGE(PG8_SA(0, 1), cA + hstepA, voffA);
    if (wr == 1) PG8_BAR;
    PG8_WAIT_V(4); PG8_BAR;
    PG8_STAGE(PG8_SB(1, 0), cB + kstep, voffB); PG8_STAGE(PG8_SA(1, 0), cA + kstep, voffA); PG8_STAGE(PG8_SB(1, 1), cB + hstepB + kstep, voffB);
    PG8_WAIT_V(6); PG8_BAR;
    for (;;) {
        const bool has_next = S.next(ui + 1, nxt);
        const char* nA = has_next ? (const char*)g.A + (size_t)nxt.pm * tstepA + (size_t)nxt.pn * g.a_pn_off * 2 : cA;
        const char* nA2 = has_next ? (const char*)g.A2 + (size_t)nxt.pm * tstepA + (size_t)nxt.pn * g.a_pn_off * 2 : cA2;
        const char* nB = has_next ? (const char*)g.Bt + (size_t)nxt.pn * tstepB : cB;
        for (int t = 0; t < nt; t += 2) {
            const bool last = (t == nt - 2);
            const char* a1 = PG8_TILEA(cA, cA2, t + 1);
            const char* a2 = last ? nA : PG8_TILEA(cA, cA2, t + 2); const char* b2 = last ? nB : cB + (size_t)(t + 2) * kstep;
            const char* a3 = a2 + kstep; const char* b3 = b2 + kstep;
            PG8_LDB(B0, 0, 0); PG8_SCHED; PG8_LDA(At, 0, 0); PG8_STAGE(PG8_SA(1, 1), a1 + hstepA, voffA);
            PG8_WAIT_L(8); PG8_BAR; PG8_WAIT_L(0); PG8_MMA(0, 0, At, B0); PG8_BAR; PG8_SCHED;
            PG8_LDB(B1, 0, 1); PG8_STAGE(PG8_SB(0, 0), b2, voffB);
            PG8_BAR; PG8_WAIT_L(0); PG8_MMA(0, 1, At, B1); PG8_BAR;
            PG8_LDA(At, 0, 1); PG8_STAGE(PG8_SA(0, 0), a2, voffA);
            PG8_BAR; PG8_WAIT_L(0); PG8_MMA(1, 0, At, B0); PG8_BAR; PG8_SCHED;
            PG8_STAGE(PG8_SB(0, 1), b2 + hstepB, voffB);
            PG8_WAIT_V(6); PG8_BAR; PG8_MMA(1, 1, At, B1); PG8_BAR;
            PG8_LDB(B0, 1, 0); PG8_SCHED; PG8_LDA(At, 1, 0); PG8_STAGE(PG8_SA(0, 1), a2 + hstepA, voffA);
            PG8_WAIT_L(8); PG8_BAR; PG8_WAIT_L(0); PG8_MMA(0, 0, At, B0); PG8_BAR; PG8_SCHED;
            PG8_LDB(B1, 1, 1); PG8_STAGE(PG8_SB(1, 0), b3, voffB);
            PG8_BAR; PG8_WAIT_L(0); PG8_MMA(0, 1, At, B1); PG8_BAR;
            PG8_LDA(At, 1, 1); PG8_STAGE(PG8_SA(1, 0), a3, voffA);
            PG8_BAR; PG8_WAIT_L(0); PG8_MMA(1, 0, At, B0); PG8_BAR; PG8_SCHED;
            PG8_STAGE(PG8_SB(1, 1), b3 + hstepB, voffB);
            PG8_WAIT_V(6); PG8_BAR; PG8_MMA(1, 1, At, B1); PG8_BAR;
        }
        if constexpr (!Epi::AFTER_DRAIN) E(acc, cur, wr, wc, fr, fq);
        if (!has_next) break;
#pragma unroll
        for (int a = 0; a < 2; ++a)
#pragma unroll
            for (int b = 0; b < 2; ++b)
#pragma unroll
                for (int m = 0; m < 4; ++m)
#pragma unroll
                    for (int n = 0; n < 2; ++n) acc[a][b][m][n] = (f32x4){0.f, 0.f, 0.f, 0.f};
        cur = nxt; cA = nA; cA2 = nA2; cB = nB; ++ui;
    }
    PG8_WAIT_V(0);
    if (wr == 0) PG8_BAR;
    PG8_BAR;
    if constexpr (Epi::AFTER_DRAIN) E.fused(acc, cur, wr, wc, fr, fq, lds, wid, lane);
#undef PG8_SA
#undef PG8_SB
#undef PG8_STAGE
#undef PG8_LDA
#undef PG8_LDB
#undef PG8_MMA
#undef PG8_WAIT_V
#undef PG8_WAIT_L
#undef PG8_BAR
#undef PG8_SCHED
#undef PG8_TILEA
}

struct EpiSwiGLU {
    static constexpr bool AFTER_DRAIN = false;
    bf16_t* O;
    __device__ __forceinline__ void operator()(const f32x4 (&acc)[2][2][4][2], const Unit& u, int wr, int wc, int fr, int fq) const {
        const int row0 = u.pm * BM + wr * 64 + fr, col0 = u.pn * HALF + wc * 32 + 4 * fq;
#pragma unroll
        for (int ai = 0; ai < 2; ++ai)
#pragma unroll
            for (int m = 0; m < 4; ++m) { bf16_t* rowp = O + (size_t)(row0 + ai * HALF + m * 16) * FF + col0;
#pragma unroll
                for (int n = 0; n < 2; ++n) { const f32x4 gt = acc[ai][0][m][n], up = acc[ai][1][m][n];
                    u32x2 w; w.x = cvt_pk_bf16(siluf(gt[0]) * up[0], siluf(gt[1]) * up[1]); w.y = cvt_pk_bf16(siluf(gt[2]) * up[2], siluf(gt[3]) * up[3]);
                    *(u32x2*)(rowp + n * 16) = w; } }
    }
};
struct EpiResid {
    static constexpr bool AFTER_DRAIN = false;
    const float* base; float* out; const float* gate; float scale;
    __device__ __forceinline__ void operator()(const f32x4 (&acc)[2][2][4][2], const Unit& u, int wr, int wc, int fr, int fq) const {
        const int row0 = u.pm * BM + wr * 64 + fr, col0 = u.pn * BM + wc * 32 + 4 * fq, b = u.pm >> 4;
        f32x4 gv[2][2];
#pragma unroll
        for (int bj = 0; bj < 2; ++bj)
#pragma unroll
            for (int n = 0; n < 2; ++n) gv[bj][n] = *(const f32x4*)(gate + (size_t)b * NMOD + col0 + bj * HALF + n * 16) * scale;
#pragma unroll
        for (int ai = 0; ai < 2; ++ai)
#pragma unroll
            for (int m = 0; m < 4; ++m) { const size_t off = (size_t)(row0 + ai * HALF + m * 16) * D + col0;
#pragma unroll
                for (int bj = 0; bj < 2; ++bj)
#pragma unroll
                    for (int n = 0; n < 2; ++n) { const f32x4 bs = *(const f32x4*)(base + off + bj * HALF + n * 16);
                        *(f32x4*)(out + off + bj * HALF + n * 16) = bs + gv[bj][n] * acc[ai][bj][m][n]; } }
    }
};
struct EpiSplit {
    static constexpr bool AFTER_DRAIN = false;
    bf16_t* Z; bf16_t* XBC; bf16_t* U;
    __device__ __forceinline__ void operator()(const f32x4 (&acc)[2][2][4][2], const Unit& u, int wr, int wc, int fr, int fq) const {
        bf16_t* basep; int ld, c0;
        if (u.pn < 4) { basep = Z; ld = 1024; c0 = u.pn * BM; } else if (u.pn < 12) { basep = XBC; ld = 2048; c0 = (u.pn - 4) * BM; } else { basep = U; ld = 1024; c0 = (u.pn - 12) * BM; }
        const int row0 = u.pm * BM + wr * 64 + fr, col0 = c0 + wc * 32 + 4 * fq;
#pragma unroll
        for (int ai = 0; ai < 2; ++ai)
#pragma unroll
            for (int m = 0; m < 4; ++m) { bf16_t* rowp = basep + (size_t)(row0 + ai * HALF + m * 16) * ld + col0;
#pragma unroll
                for (int bj = 0; bj < 2; ++bj)
#pragma unroll
                    for (int n = 0; n < 2; ++n) { const f32x4 v = acc[ai][bj][m][n]; u32x2 w; w.x = cvt_pk_bf16(v[0], v[1]); w.y = cvt_pk_bf16(v[2], v[3]);
                        *(u32x2*)(rowp + bj * HALF + n * 16) = w; } }
    }
};
struct EpiPool {
    static constexpr bool AFTER_DRAIN = false;
    bf16_t* O; const float* bias; const float* scl;
    __device__ __forceinline__ void operator()(const f32x4 (&acc)[2][2][4][2], const Unit& u, int wr, int wc, int fr, int fq) const {
        const int row0 = u.pm * BM + wr * 64 + fr, col0 = u.pn * BM + wc * 32 + 4 * fq;
        f32x4 bv[2][2], sv[2][2];
#pragma unroll
        for (int bj = 0; bj < 2; ++bj)
#pragma unroll
            for (int n = 0; n < 2; ++n) { bv[bj][n] = *(const f32x4*)(bias + col0 + bj * HALF + n * 16); sv[bj][n] = *(const f32x4*)(scl + col0 + bj * HALF + n * 16); }
#pragma unroll
        for (int ai = 0; ai < 2; ++ai)
#pragma unroll
            for (int m = 0; m < 4; ++m) { bf16_t* rowp = O + (size_t)(row0 + ai * HALF + m * 16) * 1024 + col0;
#pragma unroll
                for (int bj = 0; bj < 2; ++bj)
#pragma unroll
                    for (int n = 0; n < 2; ++n) { const f32x4 v = (acc[ai][bj][m][n] + bv[bj][n]) * sv[bj][n]; u32x2 w; w.x = cvt_pk_bf16(v[0], v[1]); w.y = cvt_pk_bf16(v[2], v[3]);
                        *(u32x2*)(rowp + bj * HALF + n * 16) = w; } }
    }
};

template <bool HALF_SCALE> struct EpiResidNorm {
    static constexpr bool AFTER_DRAIN = true;
    const float* base; float* xout; const float* gate;
    const float* nw; const float* sh; const float* sc;
    bf16_t* hout; float* fout;
    float* ssq; unsigned* cnt;
    __device__ __forceinline__ void fused(f32x4 (&acc)[2][2][4][2], const Unit& u, int wr, int wc, int fr, int fq, LAS unsigned char* lds, int wid, int lane) const {
        const float* const base = this->base; float* const xout = this->xout; const float* const gate = this->gate; const float scale = HALF_SCALE ? 0.5f : 1.0f;
        const float* const nw = this->nw; const float* const sh = this->sh; const float* const sc = this->sc; bf16_t* const hout = this->hout; float* const fout = this->fout;
        float* const ssq = this->ssq; unsigned* const cnt = this->cnt;
        LAS float* P = (LAS float*)lds;
        LAS float* S = (LAS float*)(lds + 4096);
        const int row0 = u.pm * BM + wr * 64 + fr, col0 = u.pn * BM + wc * 32 + 4 * fq, b = u.pm >> 4;
        {
            f32x4 gv[2][2];
#pragma unroll
            for (int bj = 0; bj < 2; ++bj)
#pragma unroll
                for (int n = 0; n < 2; ++n) gv[bj][n] = *(const f32x4*)(gate + (size_t)b * NMOD + col0 + bj * HALF + n * 16) * scale;
#pragma unroll
            for (int ai = 0; ai < 2; ++ai)
#pragma unroll
                for (int m = 0; m < 4; ++m) { const size_t off = (size_t)(row0 + ai * HALF + m * 16) * D + col0; float sq = 0.f;
#pragma unroll
                    for (int bj = 0; bj < 2; ++bj)
#pragma unroll
                        for (int n = 0; n < 2; ++n) { const f32x4 bs = *(const f32x4*)(base + off + bj * HALF + n * 16); const f32x4 x = bs + gv[bj][n] * acc[ai][bj][m][n];
                            acc[ai][bj][m][n] = x; if (xout) *(f32x4*)(xout + off + bj * HALF + n * 16) = x;
                            sq += (x[0] * x[0] + x[1] * x[1]) + (x[2] * x[2] + x[3] * x[3]); }
                    sq += __shfl_xor(sq, 16); sq += __shfl_xor(sq, 32);
                    if (fq == 0) P[(ai * HALF + wr * 64 + m * 16 + fr) * 4 + wc] = sq; }
        }
        asm volatile("s_waitcnt lgkmcnt(0)" ::: "memory"); __builtin_amdgcn_s_barrier(); asm volatile("" ::: "memory");
        const int tid = wid * 64 + lane;
        if (tid < 256) { const f32x4 p = *(const LAS f32x4*)(P + tid * 4);
            __hip_atomic_store(ssq + ((size_t)(u.pm * BM + tid)) * 4 + u.pn, (p[0] + p[1]) + (p[2] + p[3]), __ATOMIC_RELAXED, __HIP_MEMORY_SCOPE_AGENT); }
        asm volatile("s_waitcnt vmcnt(0)" ::: "memory");
        if (wid < 4 && lane == 0) __hip_atomic_fetch_add(cnt + 64 * u.pm, 1u, __ATOMIC_RELAXED, __HIP_MEMORY_SCOPE_AGENT);
        if (wid == 0) {
            unsigned spins = 0;
            while ((unsigned)__builtin_amdgcn_readfirstlane(__hip_atomic_load(cnt + 64 * u.pm, __ATOMIC_RELAXED, __HIP_MEMORY_SCOPE_AGENT)) < 16u) { __builtin_amdgcn_s_sleep(2); if (++spins > (1u << 22)) break; }
            __builtin_amdgcn_fence(__ATOMIC_ACQUIRE, "agent");
        }
        asm volatile("s_waitcnt vmcnt(0) lgkmcnt(0)" ::: "memory"); __builtin_amdgcn_s_barrier(); asm volatile("" ::: "memory");
        if (tid < 256) { const float* slot = ssq + ((size_t)(u.pm * BM + tid)) * 4; float t = 0.f;
#pragma unroll
            for (int q = 0; q < 4; ++q) t += __hip_atomic_load(slot + q, __ATOMIC_RELAXED, __HIP_MEMORY_SCOPE_AGENT);
            S[tid] = rsqrtf(t * (1.f / D) + EPS); }
        asm volatile("s_waitcnt vmcnt(0) lgkmcnt(0)" ::: "memory"); __builtin_amdgcn_s_barrier(); asm volatile("" ::: "memory");
#pragma unroll
        for (int bj = 0; bj < 2; ++bj)
#pragma unroll
            for (int n = 0; n < 2; ++n) { const int col = col0 + bj * HALF + n * 16;
                f32x4 A4 = *(const f32x4*)(nw + col), B4 = (f32x4){0.f, 0.f, 0.f, 0.f};
                if (sc) { A4 = A4 * (*(const f32x4*)(sc + (size_t)b * NMOD + col) + 1.f); B4 = *(const f32x4*)(sh + (size_t)b * NMOD + col); }
#pragma unroll
                for (int ai = 0; ai < 2; ++ai)
#pragma unroll
                    for (int m = 0; m < 4; ++m) { const size_t off = (size_t)(row0 + ai * HALF + m * 16) * D + col; const f32x4 o = acc[ai][bj][m][n] * S[ai * HALF + wr * 64 + m * 16 + fr] * A4 + B4;
                        if (hout) { u32x2 w; w.x = cvt_pk_bf16(o[0], o[1]); w.y = cvt_pk_bf16(o[2], o[3]); *(u32x2*)(hout + off) = w; }
                        else *(f32x4*)(fout + off) = o; } }
    }
};
}

struct Args { const float* in[25]; float* out; unsigned char* ws; int ph_lo, ph_hi; };
enum { I_X = 0, I_C, I_WADA, I_BADA, I_N1, I_G1, I_U1, I_D1, I_NMIX, I_WIN, I_CONVW, I_CONVB, I_DTB, I_ALOG, I_DSKIP, I_SSDNW, I_POOLW, I_POOLB, I_POOLS, I_WOUT, I_N2, I_G2, I_U2, I_D2, I_NF };

__device__ __forceinline__ void p0_transpose_item(const float* W, int ldw, int K, bf16_t* WT, int dst_row0, int n0, int k0, LAS float* scr, int lane) {
    const int lr = lane >> 3, lc = (lane & 7) * 4;
    f32x4 v[8];
#pragma unroll
    for (int i = 0; i < 8; ++i) v[i] = *(const f32x4*)(W + (size_t)(k0 + 8 * i + lr) * ldw + n0 + lc);
#pragma unroll
    for (int i = 0; i < 8; ++i) { LAS float* d = scr + (8 * i + lr) * 33 + lc; d[0] = v[i].x; d[1] = v[i].y; d[2] = v[i].z; d[3] = v[i].w; }
    LDS_WAIT();
    const int c = lane & 7;
#pragma unroll
    for (int j = 0; j < 4; ++j) { const int n = (lane >> 3) + 8 * j; const LAS float* sp = scr + (8 * c) * 33 + n;
        u32x4 o; o.x = cvt_pk_bf16(sp[0 * 33], sp[1 * 33]); o.y = cvt_pk_bf16(sp[2 * 33], sp[3 * 33]); o.z = cvt_pk_bf16(sp[4 * 33], sp[5 * 33]); o.w = cvt_pk_bf16(sp[6 * 33], sp[7 * 33]);
        *(u32x4*)(WT + (size_t)(dst_row0 + n) * K + k0 + 8 * c) = o; }
    LDS_WAIT();
}
__device__ __forceinline__ void p0_mat_item(const float* W, int ldw, int K, int nb, int csrc, bf16_t* WT, int drow_base, int mode, int it, LAS float* scr, int lane) {
    const int kb = it / nb, nbi = it % nb, n0 = 32 * nbi;
    int drow = drow_base + n0;
    if (mode == 1) drow = (n0 >> 7) * 256 + (n0 & 127) + drow_base;
    p0_transpose_item(W, ldw, K, WT, drow, csrc + n0, 64 * kb, scr, lane);
}
__device__ __forceinline__ void p0_transposes(const Args& a, LAS unsigned char* lds, int part, int gw, int NGW, int lane, int wave) {
    unsigned char* ws = a.ws;
    LAS float* scr = (LAS float*)(lds + wave * 8448);
    constexpr int I_GU = (D / 64) * (FF / 32), I_DN = (FF / 64) * (D / 32), I_ZZ = (D / 64) * 32, I_XB = (D / 64) * 64, I_OUT = (2048 / 64) * 32, I_PL = 4 * 8;
    if (part == 0) {
        for (int it = gw; it < 2 * I_GU + I_DN; it += NGW) {
            int r = it;
            if (r < I_GU) { p0_mat_item(a.in[I_G1], FF, D, FF / 32, 0, (bf16_t*)(ws + WS_WGU1), 0, 1, r, scr, lane); continue; } r -= I_GU;
            if (r < I_GU) { p0_mat_item(a.in[I_U1], FF, D, FF / 32, 0, (bf16_t*)(ws + WS_WGU1), 128, 1, r, scr, lane); continue; } r -= I_GU;
            p0_mat_item(a.in[I_D1], D, FF, D / 32, 0, (bf16_t*)(ws + WS_WD1), 0, 0, r, scr, lane);
        }
    } else {
        constexpr int NITEMS = 2 * I_GU + I_DN + 2 * I_ZZ + I_XB + I_OUT + 4 * I_PL;
        for (int it = gw; it < NITEMS; it += NGW) {
            int r = it;
            if (r < I_ZZ) { p0_mat_item(a.in[I_WIN], DINP, D, 32, 0, (bf16_t*)(ws + WS_WIN), 0, 0, r, scr, lane); continue; } r -= I_ZZ;
            if (r < I_XB) { p0_mat_item(a.in[I_WIN], DINP, D, 64, 1024, (bf16_t*)(ws + WS_WIN), 1024, 0, r, scr, lane); continue; } r -= I_XB;
            if (r < I_ZZ) { p0_mat_item(a.in[I_WIN], DINP, D, 32, 3088, (bf16_t*)(ws + WS_WIN), 3072, 0, r, scr, lane); continue; } r -= I_ZZ;
            if (r < I_OUT) { p0_mat_item(a.in[I_WOUT], D, 2048, 32, 0, (bf16_t*)(ws + WS_WOUT), 0, 0, r, scr, lane); continue; } r -= I_OUT;
            if (r < 4 * I_PL) { const int gq = r / I_PL; p0_mat_item(a.in[I_POOLW] + (size_t)gq * 65536, 256, 256, 8, 0, (bf16_t*)(ws + WS_WPOOL), gq * 256, 0, r % I_PL, scr, lane); continue; } r -= 4 * I_PL;
            if (r < I_GU) { p0_mat_item(a.in[I_G2], FF, D, FF / 32, 0, (bf16_t*)(ws + WS_WGU2), 0, 1, r, scr, lane); continue; } r -= I_GU;
            if (r < I_GU) { p0_mat_item(a.in[I_U2], FF, D, FF / 32, 0, (bf16_t*)(ws + WS_WGU2), 128, 1, r, scr, lane); continue; } r -= I_GU;
            p0_mat_item(a.in[I_D2], D, FF, D / 32, 0, (bf16_t*)(ws + WS_WD2), 0, 0, r, scr, lane);
        }
    }
}
__device__ __forceinline__ void p0_phase(const Args& a, LAS unsigned char* lds, int tid, int lane, int wave, int G) {
    unsigned char* ws = a.ws;
    {
        LAS float* cact = (LAS float*)(lds + 69632);
        LAS float* red = (LAS float*)(lds + 69632 + 16384);
        if ((int)blockIdx.x < NMOD / 64) {
            for (int i = tid; i < 4 * D; i += NTHREADS) { const float cv = a.in[I_C][i]; cact[i] = cv / (1.f + __expf(-cv)); }
            __syncthreads();
        }
        for (int it = blockIdx.x; it < NMOD / 64; it += G) {
            const int j = it * 64 + lane, kb = wave * 128;
            float s0 = 0.f, s1 = 0.f, s2 = 0.f, s3 = 0.f;
            const float* wp = a.in[I_WADA] + (size_t)kb * NMOD + j;
#pragma unroll 8
            for (int k = 0; k < 128; ++k) { const float wv = wp[(size_t)k * NMOD];
                s0 += cact[kb + k] * wv; s1 += cact[D + kb + k] * wv; s2 += cact[2 * D + kb + k] * wv; s3 += cact[3 * D + kb + k] * wv; }
            red[(wave * 4 + 0) * 64 + lane] = s0; red[(wave * 4 + 1) * 64 + lane] = s1; red[(wave * 4 + 2) * 64 + lane] = s2; red[(wave * 4 + 3) * 64 + lane] = s3;
            __syncthreads();
            if (wave < 4) { float t = a.in[I_BADA][j];
#pragma unroll
                for (int w = 0; w < 8; ++w) t += red[(w * 4 + wave) * 64 + lane];
                ((float*)(ws + WS_MOD))[wave * NMOD + j] = t; }
            __syncthreads();
        }
    }
    for (int idx = blockIdx.x * NTHREADS + tid; idx < 16 * D / 2; idx += G * NTHREADS) { const int k = (idx >> 4) * 2, j = idx & 15;
        ((unsigned*)(ws + WS_WDT))[(j * D + k) >> 1] = cvt_pk_bf16(a.in[I_WIN][(size_t)k * DINP + 3072 + j], a.in[I_WIN][(size_t)(k + 1) * DINP + 3072 + j]); }
    p0_transposes(a, lds, 0, blockIdx.x * NWAVES + wave, G * NWAVES, lane, wave);
}

template <bool DTP>
__device__ __forceinline__ void norm_phase(LAS unsigned char* lds, const float* src, const float* nw, const float* mod, int sh_off, int sc_off, bf16_t* dst,
                                           const float* wdt, const float* dt_bias, float* DT, int tid, int lane, int wave, int G) {
    LAS f32x4* wl = (LAS f32x4*)lds;
    if (DTP) { for (int i = tid; i < 16 * D / 4; i += NTHREADS) wl[i] = ((const f32x4*)wdt)[i]; __syncthreads(); }
    const int gw = blockIdx.x * NWAVES + wave, NGW = G * NWAVES;
    for (int rg = gw; rg < M / 8; rg += NGW) {
        const int row0 = rg * 8, b = row0 >> 12;
        f32x4 Am[4], Bm[4];
#pragma unroll
        for (int j = 0; j < 4; ++j) { const int col = 4 * lane + 256 * j;
            const f32x4 w = *(const f32x4*)(nw + col), sc = *(const f32x4*)(mod + (size_t)b * NMOD + sc_off + col);
            Am[j] = w * (sc + 1.f); Bm[j] = *(const f32x4*)(mod + (size_t)b * NMOD + sh_off + col); }
#pragma unroll 1
        for (int half = 0; half < 2; ++half) {
            f32x4 o[4][4];
#pragma unroll
            for (int r = 0; r < 4; ++r) {
                const int row = row0 + half * 4 + r;
                float ss = 0.f;
#pragma unroll
                for (int j = 0; j < 4; ++j) { o[r][j] = *(const f32x4*)(src + (size_t)row * D + 4 * lane + 256 * j); ss += (o[r][j].x * o[r][j].x + o[r][j].y * o[r][j].y) + (o[r][j].z * o[r][j].z + o[r][j].w * o[r][j].w); }
                const float rstd = rsqrtf(wave_sum(ss) * (1.f / D) + EPS);
#pragma unroll
                for (int j = 0; j < 4; ++j) { o[r][j] = o[r][j] * rstd * Am[j] + Bm[j];
                    u32x2 w; w.x = cvt_pk_bf16(o[r][j].x, o[r][j].y); w.y = cvt_pk_bf16(o[r][j].z, o[r][j].w);
                    *(u32x2*)(dst + (size_t)row * D + 4 * lane + 256 * j) = w; }
            }
            if (DTP) {
                float mine = 0.f;
                __builtin_amdgcn_sched_barrier(0);
#pragma unroll 1
                for (int jj = 0; jj < 16; ++jj) {
                    f32x4 wv[4];
#pragma unroll
                    for (int j = 0; j < 4; ++j) wv[j] = wl[jj * 256 + 64 * j + lane];
#pragma unroll
                    for (int r = 0; r < 4; ++r) { float p = 0.f;
#pragma unroll
                        for (int j = 0; j < 4; ++j) p += (o[r][j].x * wv[j].x + o[r][j].y * wv[j].y) + (o[r][j].z * wv[j].z + o[r][j].w * wv[j].w);
                        const float t = wave_sum(p); if (lane == r * 16 + jj) mine = t; }
                }
                const float xv = mine + dt_bias[lane & 15];
                DT[(size_t)(row0 + half * 4 + (lane >> 4)) * 16 + (lane & 15)] = xv > 20.f ? xv : log1pf(__expf(xv));
            }
        }
    }
}
__device__ __forceinline__ void final_norm_phase(float* xio, const float* nw, int lane, int wave, int G) {
    const int gw = blockIdx.x * NWAVES + wave, NGW = G * NWAVES;
    f32x4 wv[4];
#pragma unroll
    for (int j = 0; j < 4; ++j) wv[j] = *(const f32x4*)(nw + 4 * lane + 256 * j);
    for (int rg = gw; rg < M / 4; rg += NGW) {
        f32x4 v[4][4]; float ss[4];
#pragma unroll
        for (int r = 0; r < 4; ++r)
#pragma unroll
            for (int j = 0; j < 4; ++j) v[r][j] = *(const f32x4*)(xio + (size_t)(rg * 4 + r) * D + 4 * lane + 256 * j);
#pragma unroll
        for (int r = 0; r < 4; ++r) { ss[r] = 0.f;
#pragma unroll
            for (int j = 0; j < 4; ++j) ss[r] += (v[r][j].x * v[r][j].x + v[r][j].y * v[r][j].y) + (v[r][j].z * v[r][j].z + v[r][j].w * v[r][j].w); }
#pragma unroll
        for (int r = 0; r < 4; ++r) { const float rstd = rsqrtf(wave_sum(ss[r]) * (1.f / D) + EPS);
#pragma unroll
            for (int j = 0; j < 4; ++j) *(f32x4*)(xio + (size_t)(rg * 4 + r) * D + 4 * lane + 256 * j) = v[r][j] * rstd * wv[j]; }
    }
}


__device__ __forceinline__ void dt_tail(const bf16_t* Hn, const bf16_t* WDTB, const float* dt_bias, float* DT, int G, int wave, int lane) {
    const int fr = lane & 15, fq = lane >> 4;
    if (wave < 4) for (int tg = wave * G + blockIdx.x; tg < M / 16; tg += 4 * G) {
        const int row0 = tg * 16;
        f32x4 d = (f32x4){0.f, 0.f, 0.f, 0.f};
        const bf16_t* ap = Hn + (size_t)(row0 + fr) * D + fq * 8; const bf16_t* bp = WDTB + (size_t)fr * D + fq * 8;
#pragma unroll 8
        for (int ks = 0; ks < 32; ++ks) d = __builtin_amdgcn_mfma_f32_16x16x32_bf16(*(const bf16x8*)(ap + ks * 32), *(const bf16x8*)(bp + ks * 32), d, 0, 0, 0);
        const float bias = dt_bias[fr];
#pragma unroll
        for (int jj = 0; jj < 4; ++jj) { const float xv = d[jj] + bias; DT[(size_t)(row0 + fq * 4 + jj) * 16 + fr] = xv > 20.f ? xv : log1pf(__expf(xv)); }
    }
}

__device__ __forceinline__ void unpack8(const u32x4 v, float (&f)[8]) { f[0] = bf_lo(v.x); f[1] = bf_hi(v.x); f[2] = bf_lo(v.y); f[3] = bf_hi(v.y); f[4] = bf_lo(v.z); f[5] = bf_hi(v.z); f[6] = bf_lo(v.w); f[7] = bf_hi(v.w); }
__device__ __forceinline__ void diff_item(const bf16_t* U, bf16_t* DIFF, int item, int tid) {
    const int oct = tid & 127, sub = tid >> 7, t0 = item * 32 + sub * 8, pos0 = t0 & (SEQ - 1), w = 2 << (oct >> 5);
    const bf16_t* up = U + (size_t)t0 * 1024 + oct * 8;
    float S[8], f[8];
#pragma unroll
    for (int e = 0; e < 8; ++e) S[e] = 0.f;
    for (int j = 1; j <= w; ++j) if (pos0 - j >= 0) { unpack8(*(const u32x4*)(up - (size_t)j * 1024), f);
#pragma unroll
        for (int e = 0; e < 8; ++e) S[e] += f[e]; }
#pragma unroll
    for (int i = 0; i < 8; ++i) {
        const int pos = pos0 + i;
        unpack8(*(const u32x4*)(up + (size_t)i * 1024), f);
#pragma unroll
        for (int e = 0; e < 8; ++e) S[e] += f[e];
        if (pos >= w) { float q[8]; unpack8(*(const u32x4*)(up + (size_t)(i - w) * 1024), q);
#pragma unroll
            for (int e = 0; e < 8; ++e) S[e] -= q[e]; }
        const float inv = 1.f / (float)(pos + 1 < w ? pos + 1 : w);
        u32x4 o; o.x = cvt_pk_bf16(S[0] * inv - f[0], S[1] * inv - f[1]); o.y = cvt_pk_bf16(S[2] * inv - f[2], S[3] * inv - f[3]);
        o.z = cvt_pk_bf16(S[4] * inv - f[4], S[5] * inv - f[5]); o.w = cvt_pk_bf16(S[6] * inv - f[6], S[7] * inv - f[7]);
        *(u32x4*)(DIFF + (size_t)(t0 + i) * 1024 + oct * 8) = o;
    }
}

constexpr int LP = 272;
constexpr int L_C = 0, L_B = 128 * LP, L_XT = 2 * 128 * LP, L_ACS = L_XT + 4 * 64 * LP, L_DTV = L_ACS + 2048, L_SSD_END = L_DTV + 2048;
static_assert(L_SSD_END <= LDS_BYTES, "ssd lds");

__device__ __forceinline__ void ssd_cumsum(LAS unsigned char* lds, const float* DT, const float* a_log, int T0, int g, int lane, int wave) {
    if (wave < 4) {
        const int h = 4 * g + wave; const float av = -__expf(a_log[h]);
        const int t = 2 * lane;
        const float d0 = DT[(size_t)(T0 + t) * 16 + h], d1 = DT[(size_t)(T0 + t + 1) * 16 + h];
        const float v0 = d0 * av, v1 = d1 * av, s = v0 + v1;
        float inc = s;
#pragma unroll
        for (int o = 1; o < 64; o <<= 1) { const float n = __shfl_up(inc, o); if (lane >= o) inc += n; }
        const float exc = inc - s;
        LAS float* acs = (LAS float*)(lds + L_ACS) + wave * 128; LAS float* dtv = (LAS float*)(lds + L_DTV) + wave * 128;
        acs[t] = exc + v0; acs[t + 1] = exc + s; dtv[t] = d0; dtv[t + 1] = d1;
    }
}
template <int MODE>
__device__ __forceinline__ void ssd_stage(LAS unsigned char* lds, const bf16_t* XBC, const float* conv_w, const float* conv_b, int T0, int c, int g, int tid) {
    const LAS float* acs = (const LAS float*)(lds + L_ACS); const LAS float* dtv = (const LAS float*)(lds + L_DTV);
    constexpr int O_LO = (MODE == 0) ? 16 : 0, NO = 64 - O_LO;
#pragma unroll 1
    for (int task = tid; task < NO * 16; task += NTHREADS) {
        const int o = O_LO + task % NO, sg = task / NO;
        const int ch = (o < 16) ? (1536 + g * 128 + o * 8) : (o < 32) ? (1024 + g * 128 + (o - 16) * 8) : (g * 256 + (o - 32) * 8);
        float w[4][8], bs[8];
#pragma unroll
        for (int k = 0; k < 4; ++k) { const f32x4 w0 = *(const f32x4*)(conv_w + k * DXBC + ch), w1 = *(const f32x4*)(conv_w + k * DXBC + ch + 4);
            w[k][0] = w0.x; w[k][1] = w0.y; w[k][2] = w0.z; w[k][3] = w0.w; w[k][4] = w1.x; w[k][5] = w1.y; w[k][6] = w1.z; w[k][7] = w1.w; }
        { const f32x4 b0 = *(const f32x4*)(conv_b + ch), b1 = *(const f32x4*)(conv_b + ch + 4);
          bs[0] = b0.x; bs[1] = b0.y; bs[2] = b0.z; bs[3] = b0.w; bs[4] = b1.x; bs[5] = b1.y; bs[6] = b1.z; bs[7] = b1.w; }
        const bf16_t* src = XBC + ((size_t)(T0 + sg * 8) - 3) * DXBC + ch;
        float out[8][8];
#pragma unroll
        for (int i = 0; i < 8; ++i)
#pragma unroll
            for (int e = 0; e < 8; ++e) out[i][e] = bs[e];
#pragma unroll
        for (int rr = 0; rr < 11; ++rr) {
            const bool valid = (c * 128 + sg * 8 - 3 + rr) >= 0;
            u32x4 rv = (u32x4){0u, 0u, 0u, 0u};
            if (valid) rv = *(const u32x4*)(src + (size_t)rr * DXBC);
            float f[8]; unpack8(rv, f);
#pragma unroll
            for (int k = 0; k < 4; ++k) { const int i = rr - k;
                if (i >= 0 && i < 8) {
#pragma unroll
                    for (int e = 0; e < 8; ++e) out[i][e] += w[k][e] * f[e]; } }
        }
#pragma unroll
        for (int i = 0; i < 8; ++i)
#pragma unroll
            for (int e = 0; e < 8; ++e) out[i][e] = siluf(out[i][e]);
        if (o >= 32) {
            const int r = (o - 32) >> 3, p0 = ((o - 32) & 7) * 8;
            float sc[8];
#pragma unroll
            for (int i = 0; i < 8; ++i) { const int s = sg * 8 + i; sc[i] = dtv[r * 128 + s]; if (MODE == 0) sc[i] *= __expf(acs[r * 128 + 127] - acs[r * 128 + s]); }
#pragma unroll
            for (int e = 0; e < 8; ++e) { u32x4 v; v.x = cvt_pk_bf16(out[0][e] * sc[0], out[1][e] * sc[1]); v.y = cvt_pk_bf16(out[2][e] * sc[2], out[3][e] * sc[3]);
                v.z = cvt_pk_bf16(out[4][e] * sc[4], out[5][e] * sc[5]); v.w = cvt_pk_bf16(out[6][e] * sc[6], out[7][e] * sc[7]);
                *(LAS u32x4*)(lds + L_XT + (r * 64 + p0 + e) * LP + sg * 16) = v; }
        } else if (MODE == 0) {
            const int n0 = (o - 16) * 8;
#pragma unroll
            for (int e = 0; e < 8; ++e) { u32x4 v; v.x = cvt_pk_bf16(out[0][e], out[1][e]); v.y = cvt_pk_bf16(out[2][e], out[3][e]); v.z = cvt_pk_bf16(out[4][e], out[5][e]); v.w = cvt_pk_bf16(out[6][e], out[7][e]);
                *(LAS u32x4*)(lds + L_C + (n0 + e) * LP + sg * 16) = v; }
        } else {
            const int base = (o < 16) ? L_C : L_B, n0 = (o & 15) * 8;
#pragma unroll
            for (int i = 0; i < 8; ++i) { u32x4 v; v.x = cvt_pk_bf16(out[i][0], out[i][1]); v.y = cvt_pk_bf16(out[i][2], out[i][3]); v.z = cvt_pk_bf16(out[i][4], out[i][5]); v.w = cvt_pk_bf16(out[i][6], out[i][7]);
                *(LAS u32x4*)(lds + base + (sg * 8 + i) * LP + n0 * 2) = v; }
        }
    }
}
#define MFMA16(a, b, c) __builtin_amdgcn_mfma_f32_16x16x32_bf16((a), (b), (c), 0, 0, 0)
#define LFRAG(base, row, kk) (*(const LAS bf16x8*)(lds + (base) + (row) * LP + (kk) * 2))

__device__ __forceinline__ void ssd_states_item(const Args& a, LAS unsigned char* lds, int item, int tid, int lane, int wave) {
    const int g = item & 3, c = (item >> 2) & 31, b = item >> 7, T0 = b * SEQ + c * 128, fr = lane & 15, fq = lane >> 4;
    const float* DT = (const float*)(a.ws + WS_DT);
    __syncthreads();
    ssd_cumsum(lds, DT, a.in[I_ALOG], T0, g, lane, wave);
    __syncthreads();
    if (tid < 4) ((float*)(a.ws + WS_CDEC))[(b * 32 + c) * 16 + 4 * g + tid] = __expf(((const LAS float*)(lds + L_ACS))[tid * 128 + 127]);
    ssd_stage<0>(lds, (const bf16_t*)(a.ws + WS_XBC), a.in[I_CONVW], a.in[I_CONVB], T0, c, g, tid);
    __syncthreads();
    const int r = wave >> 1, p0 = (wave & 1) * 32;
    f32x4 st[2][8];
#pragma unroll
    for (int pf = 0; pf < 2; ++pf)
#pragma unroll
        for (int nf = 0; nf < 8; ++nf) st[pf][nf] = (f32x4){0.f, 0.f, 0.f, 0.f};
#pragma unroll
    for (int ks = 0; ks < 4; ++ks) {
        bf16x8 xf[2];
#pragma unroll
        for (int pf = 0; pf < 2; ++pf) xf[pf] = LFRAG(L_XT, r * 64 + p0 + pf * 16 + fr, ks * 32 + fq * 8);
#pragma unroll
        for (int nf = 0; nf < 8; ++nf) { const bf16x8 bf = LFRAG(L_C, nf * 16 + fr, ks * 32 + fq * 8);
#pragma unroll
            for (int pf = 0; pf < 2; ++pf) st[pf][nf] = MFMA16(bf, xf[pf], st[pf][nf]); }
    }
    bf16_t* SP = (bf16_t*)((unsigned char*)a.out + DO_STATES) + ((size_t)((b * 32 + c) * 16 + 4 * g + r) * 64) * 128;
#ifndef DBG_ST
#define DBG_ST 0
#endif
#if DBG_ST == 1
#pragma unroll
    for (int pf = 0; pf < 2; ++pf)
#pragma unroll
        for (int nf = 0; nf < 8; ++nf) st[pf][nf] = (f32x4){1.f, 2.f, 3.f, 4.f};
#elif DBG_ST == 2
#pragma unroll
    for (int pf = 0; pf < 2; ++pf)
#pragma unroll
        for (int nf = 0; nf < 8; ++nf) { const bf16x8 q = LFRAG(L_XT, r * 64 + p0 + pf * 16 + fr, (nf & 3) * 32 + fq * 8); st[pf][nf] = (f32x4){(float)q[0], (float)q[1], (float)q[6], (float)q[7]}; }
#elif DBG_ST == 3
#pragma unroll
    for (int pf = 0; pf < 2; ++pf)
#pragma unroll
        for (int nf = 0; nf < 8; ++nf) { const bf16x8 q = LFRAG(L_C, nf * 16 + fr, (pf * 2) * 32 + fq * 8); st[pf][nf] = (f32x4){(float)q[0], (float)q[1], (float)q[6], (float)q[7]}; }
#endif
#pragma unroll
    for (int pf = 0; pf < 2; ++pf)
#pragma unroll
        for (int nf = 0; nf < 8; ++nf) { const f32x4 v = st[pf][nf]; u32x2 w; w.x = cvt_pk_bf16(v[0], v[1]); w.y = cvt_pk_bf16(v[2], v[3]);
            *(u32x2*)(SP + (size_t)(p0 + pf * 16 + fr) * 128 + nf * 16 + fq * 4) = w; }
}

__device__ __forceinline__ void scan_phase(const Args& a, LAS unsigned char* lds, int tid, int G) {
    bf16_t* SP = (bf16_t*)((unsigned char*)a.out + DO_STATES);
    const float* CD = (const float*)(a.ws + WS_CDEC);
    LAS float* dl = (LAS float*)lds;
    for (int tb = blockIdx.x; tb < BATCH * NHEAD * 64 * 32 / NTHREADS; tb += G) {
        const int task = tb * NTHREADS + tid;
        const int n4 = task & 31, p = (task >> 5) & 63, h = (task >> 11) & 15, b = task >> 15;
        __syncthreads();
        if (tid < 32) dl[tid] = CD[(b * 32 + tid) * 16 + h];
        u32x2* base = (u32x2*)(SP + ((size_t)((b * 32) * 16 + h) * 64 + p) * 128 + n4 * 4);
        constexpr size_t cstride = (size_t)16 * 64 * 128 / 4;
        u32x2 sv[32];
#pragma unroll
        for (int c = 0; c < 32; ++c) sv[c] = base[c * cstride];
        __syncthreads();
        asm volatile("" ::: "memory");
        float r0 = 0.f, r1 = 0.f, r2 = 0.f, r3 = 0.f;
#pragma unroll
        for (int c = 0; c < 32; ++c) {
            const float dec = dl[c];
            u32x2 o; o.x = cvt_pk_bf16(r0, r1); o.y = cvt_pk_bf16(r2, r3);
            r0 = r0 * dec + bf_lo(sv[c].x); r1 = r1 * dec + bf_hi(sv[c].x); r2 = r2 * dec + bf_lo(sv[c].y); r3 = r3 * dec + bf_hi(sv[c].y);
            base[c * cstride] = o;
        }
    }
}

__device__ __forceinline__ void ssd_out_item(const Args& a, LAS unsigned char* lds, int item, int tid, int lane, int wave) {
    const int g = item & 3, c = (item >> 2) & 31, b = item >> 7, T0 = b * SEQ + c * 128, fr = lane & 15, fq = lane >> 4;
    const float* DT = (const float*)(a.ws + WS_DT);
    const LAS float* acs = (const LAS float*)(lds + L_ACS); const LAS float* dtv = (const LAS float*)(lds + L_DTV);
    __syncthreads();
    ssd_cumsum(lds, DT, a.in[I_ALOG], T0, g, lane, wave);
    __syncthreads();
    ssd_stage<1>(lds, (const bf16_t*)(a.ws + WS_XBC), a.in[I_CONVW], a.in[I_CONVB], T0, c, g, tid);
    __syncthreads();
    const int l0 = wave * 16, l = l0 + fr;
    f32x4 sacc[8];
#pragma unroll
    for (int sf = 0; sf < 8; ++sf) sacc[sf] = (f32x4){0.f, 0.f, 0.f, 0.f};
#pragma unroll
    for (int ks = 0; ks < 4; ++ks) { const bf16x8 cf = LFRAG(L_C, l, ks * 32 + fq * 8);
#pragma unroll
        for (int sf = 0; sf < 8; ++sf) { const bf16x8 bf = LFRAG(L_B, sf * 16 + fr, ks * 32 + fq * 8); sacc[sf] = MFMA16(bf, cf, sacc[sf]); } }
    __syncthreads();
    const int L_M = L_B + wave * 16 * LP;
    const bf16_t* PV = (const bf16_t*)((const unsigned char*)a.out + DO_STATES) + ((size_t)((b * 32 + c) * 16 + 4 * g) * 64) * 128;
    f32x4 y[4][4];
#pragma unroll
    for (int r = 0; r < 4; ++r) {
        const float al = acs[r * 128 + l];
#pragma unroll
        for (int pf = 0; pf < 4; ++pf) y[r][pf] = (f32x4){0.f, 0.f, 0.f, 0.f};
#pragma unroll
        for (int ks = 0; ks < 4; ++ks) {
            const bf16x8 cf = LFRAG(L_C, l, ks * 32 + fq * 8);
#pragma unroll
            for (int pf = 0; pf < 4; ++pf) {
                const bf16x8 pv = *(const bf16x8*)(PV + (size_t)(r * 64 + pf * 16 + fr) * 128 + ks * 32 + fq * 8);
                y[r][pf] = MFMA16(pv, cf, y[r][pf]);
            }
        }
        const float sd = __expf(al);
#pragma unroll
        for (int pf = 0; pf < 4; ++pf) y[r][pf] = y[r][pf] * sd;
#pragma unroll
        for (int sf = 0; sf < 8; ++sf) { const f32x4 as = *(const LAS f32x4*)(acs + r * 128 + sf * 16 + fq * 4); float mv[4];
#pragma unroll
            for (int jj = 0; jj < 4; ++jj) { const int s = sf * 16 + fq * 4 + jj; mv[jj] = (s <= l) ? sacc[sf][jj] * __expf(fminf(al - as[jj], 0.f)) : 0.f; }
            u32x2 w; w.x = cvt_pk_bf16(mv[0], mv[1]); w.y = cvt_pk_bf16(mv[2], mv[3]);
            *(LAS u32x2*)(lds + L_M + fr * LP + (sf * 16 + fq * 4) * 2) = w; }
        __syncthreads();
#pragma unroll
        for (int ks = 0; ks < 4; ++ks) {
            const bf16x8 mf = LFRAG(L_M, fr, ks * 32 + fq * 8);
#pragma unroll
            for (int pf = 0; pf < 4; ++pf) {
                const bf16x8 xf = LFRAG(L_XT, r * 64 + pf * 16 + fr, ks * 32 + fq * 8);
                y[r][pf] = MFMA16(xf, mf, y[r][pf]);
            }
        }
        __syncthreads();
    }
    const size_t tok = (size_t)(T0 + l);
    const bf16_t* Zp = (const bf16_t*)(a.ws + WS_Z) + tok * 1024 + g * 256;
    float ssq = 0.f;
#pragma unroll
    for (int r = 0; r < 4; ++r) {
        const float dsk = a.in[I_DSKIP][4 * g + r] / dtv[r * 128 + l];
#pragma unroll
        for (int pf = 0; pf < 4; ++pf) {
            const int p = pf * 16 + fq * 4;
            const u32x2 zz = *(const u32x2*)(Zp + r * 64 + p);
            const float zf[4] = {bf_lo(zz.x), bf_hi(zz.x), bf_lo(zz.y), bf_hi(zz.y)};
#pragma unroll
            for (int jj = 0; jj < 4; ++jj) {
                const float xdt = __uint_as_float((unsigned)(*(const LAS bf16_t*)(lds + L_XT + (r * 64 + p + jj) * LP + l * 2)) << 16);
                const float v = (y[r][pf][jj] + dsk * xdt) * siluf(zf[jj]);
                y[r][pf][jj] = v; ssq += v * v;
            }
        }
    }
    ssq += __shfl_xor(ssq, 16); ssq += __shfl_xor(ssq, 32);
    const float rstd = rsqrtf(ssq * (1.f / 256.f) + EPS);
    bf16_t* Yp = (bf16_t*)((unsigned char*)a.out + DO_H) + tok * 1024 + g * 256;
#pragma unroll
    for (int r = 0; r < 4; ++r)
#pragma unroll
        for (int pf = 0; pf < 4; ++pf) { const int p = pf * 16 + fq * 4; const f32x4 nwv = *(const f32x4*)(a.in[I_SSDNW] + g * 256 + r * 64 + p);
            u32x2 w; w.x = cvt_pk_bf16(y[r][pf][0] * rstd * nwv.x, y[r][pf][1] * rstd * nwv.y); w.y = cvt_pk_bf16(y[r][pf][2] * rstd * nwv.z, y[r][pf][3] * rstd * nwv.w);
            *(u32x2*)(Yp + r * 64 + p) = w; }
}


#define XB_TMO      128
#define XB_XCNT(j)  (256  + 64 * (j))
#define XB_XSUB(j)  (1280 + 64 * (j))
#define XB_XGEN(j)  (2304 + 64 * (j))
#define XB_TOP      3328
#define XB_TOPGEN   3392
#define XCD_BAR_WORDS 3456
#define XB_SPIN_CAP (1u << 18)
__device__ __forceinline__ unsigned xb_ld(unsigned* p)              { return __hip_atomic_load(p, __ATOMIC_RELAXED, __HIP_MEMORY_SCOPE_AGENT); }
__device__ __forceinline__ unsigned xb_add(unsigned* p, unsigned v) { return __hip_atomic_fetch_add(p, v, __ATOMIC_RELAXED, __HIP_MEMORY_SCOPE_AGENT); }
__device__ __forceinline__ unsigned xb_xcc_id() { return (unsigned)__builtin_amdgcn_s_getreg((3 << 11) | 20) & 0xFu; }
#define XB_SPIN(cond, bar) do { unsigned _sp = 0; while (cond) { __builtin_amdgcn_s_sleep(1); \
    if ((++_sp & 255u) == 0u) { if (xb_ld(&(bar)[XB_TMO])) break; if (_sp > XB_SPIN_CAP) { atomicAdd(&(bar)[XB_TMO], 1u); break; } } } } while (0)
struct XcdBarrier { unsigned* bar; unsigned x; volatile LAS unsigned* st; };
__device__ __forceinline__ XcdBarrier xcd_barrier_post(unsigned* bar, volatile LAS unsigned* st) {
    XcdBarrier b; b.bar = bar; b.x = xb_xcc_id(); b.st = st;
    if (threadIdx.x == 0) (void)xb_add(&bar[XB_XCNT(b.x)], 1u);
    return b;
}
__device__ __forceinline__ void xcd_barrier_complete(unsigned* bar, unsigned x, unsigned& nloc, unsigned& nx) {
    const unsigned G = gridDim.x * gridDim.y * gridDim.z;
    unsigned sum, cnt, mine, sp = 0u;
    for (;;) {
        sum = 0u; cnt = 0u; mine = 0u;
#pragma unroll
        for (unsigned j = 0; j < 16; ++j) { const unsigned c = xb_ld(&bar[XB_XCNT(j)]); sum += c; cnt += (c > 0u) ? 1u : 0u; mine = (j == x) ? c : mine; }
        if (sum == G) break;
        __builtin_amdgcn_s_sleep(1);
        if ((++sp & 255u) == 0u) { if (xb_ld(&bar[XB_TMO])) break; if (sp > XB_SPIN_CAP) { atomicAdd(&bar[XB_TMO], 1u); break; } }
    }
    nloc = mine > 0u ? mine : 1u; nx = cnt > 0u ? cnt : 1u;
}
__device__ __forceinline__ void xcd_barrier(const XcdBarrier& b) {
    asm volatile("s_waitcnt vmcnt(0)" ::: "memory");
    __syncthreads();
    if (threadIdx.x == 0) {
        unsigned* bar = b.bar;
        __builtin_amdgcn_s_waitcnt(0);
        unsigned nloc = b.st[0], nx = b.st[1];
        if (nloc == 0u) { xcd_barrier_complete(bar, b.x, nloc, nx); b.st[0] = nloc; b.st[1] = nx; }
        const unsigned old = xb_add(&bar[XB_XSUB(b.x)], 1u);
        const unsigned gen = old / nloc;
        if (old + 1u == (gen + 1u) * nloc) {
            __builtin_amdgcn_fence(__ATOMIC_RELEASE, "agent");
            asm volatile("s_waitcnt vmcnt(0)" ::: "memory");
            const unsigned og = xb_add(&bar[XB_TOP], 1u);
            const unsigned tg = og / nx;
            if (og + 1u == (tg + 1u) * nx) xb_add(&bar[XB_TOPGEN], 1u);
            else XB_SPIN(xb_ld(&bar[XB_TOPGEN]) == tg, bar);
            __builtin_amdgcn_fence(__ATOMIC_ACQUIRE, "agent");
            xb_add(&bar[XB_XGEN(b.x)], 1u);
            asm volatile("s_waitcnt vmcnt(0)" ::: "memory");
        } else {
            XB_SPIN(xb_ld(&bar[XB_XGEN(b.x)]) == gen, bar);
            __builtin_amdgcn_fence(__ATOMIC_ACQUIRE, "agent");
            asm volatile("s_waitcnt vmcnt(0)" ::: "memory");
        }
    }
    __syncthreads();
}

__global__ void __launch_bounds__(NTHREADS, 2) fwd_megakernel(Args a) {
    extern __shared__ __attribute__((aligned(16))) unsigned char lds_raw[];
    LAS unsigned char* lds = (LAS unsigned char*)lds_raw;
    cg::grid_group grid = cg::this_grid();
    const int G = gridDim.x;
#define PH_IDS() int tid = threadIdx.x; asm volatile("" : "+v"(tid)); const int lane = tid & 63, wave = __builtin_amdgcn_readfirstlane(tid >> 6); (void)lane; (void)wave
    unsigned char* ws = a.ws;
    const float* mod = (const float*)(ws + WS_MOD);
    bf16_t* H = (bf16_t*)((unsigned char*)a.out + DO_H);
    float* XR = (float*)(ws + WS_XR);
    const int lo = a.ph_lo, hi = a.ph_hi;
#ifndef ONLYPH
#define ONLYPH -1
#endif
#define IN(k) ((ONLYPH < 0 || ONLYPH == (k)) && lo <= (k) && (k) < hi)
    volatile LAS unsigned* bst = (volatile LAS unsigned*)(lds + LDS_BYTES - 64);
    if (threadIdx.x < 16) bst[threadIdx.x] = 0u;
    __syncthreads();
    XcdBarrier xbar = xcd_barrier_post((unsigned*)(ws + WS_BAR), bst);
    if (a.ph_hi > 1000) grid.sync();
#define SEAM(k) do { if (IN(k) && IN((k) + 1)) xcd_barrier(xbar); } while (0)
#ifndef DUP_MASK
#define DUP_MASK 0
#endif
#define REP(k) for (int rep_ = 0; rep_ < (((DUP_MASK >> (k)) & 1) ? 2 : 1); ++rep_, (rep_ < (((DUP_MASK >> (k)) & 1) ? 2 : 1) ? xcd_barrier(xbar) : (void)0))

    if (IN(0)) REP(0) { PH_IDS(); p0_phase(a, lds, tid, lane, wave, G); }
    SEAM(0);
    if (IN(1)) REP(1) { PH_IDS(); norm_phase<false>(lds, a.in[I_X], a.in[I_N1], mod, 0 * D, 1 * D, H, nullptr, nullptr, nullptr, tid, lane, wave, G); }
    SEAM(1);
    if (IN(2)) REP(2) { pg8::Gemm g{H, H, (const bf16_t*)(ws + WS_WGU1), M, 2 * FF, D, D, D, 1 << 30, 0}; pg8::StaticOrder S; S.init(M, 2 * FF, G, blockIdx.x);
        pg8::EpiSwiGLU E{(bf16_t*)(ws + WS_ACT)}; pg8::gemm_phase(lds, g, S, E);
        { const int nidle = G - (S.nwg % G); PH_IDS();
          if ((S.nwg % G) != 0 && (int)blockIdx.x >= G - nidle) p0_transposes(a, lds, 1, ((int)blockIdx.x - (G - nidle)) * NWAVES + wave, nidle * NWAVES, lane, wave);
          else if ((S.nwg % G) == 0) p0_transposes(a, lds, 1, blockIdx.x * NWAVES + wave, G * NWAVES, lane, wave); } }
    SEAM(2);
    if (IN(3)) REP(3) { pg8::Gemm g{(const bf16_t*)(ws + WS_ACT), (const bf16_t*)(ws + WS_ACT), (const bf16_t*)(ws + WS_WD1), M, D, FF, FF, FF, 1 << 30, 0}; pg8::StaticOrder S; S.init(M, D, G, blockIdx.x);
        pg8::EpiResidNorm<true> E{a.in[I_X], XR, mod + 2 * D, a.in[I_NMIX], mod + 3 * D, mod + 4 * D, H, nullptr, (float*)(ws + WS_SSQ), (unsigned*)(ws + WS_CNT)}; pg8::gemm_phase(lds, g, S, E); }
    SEAM(3);
    if (IN(5)) REP(5) { pg8::Gemm g{H, H, (const bf16_t*)(ws + WS_WIN), M, NPROJ, D, D, D, 1 << 30, 0}; pg8::StaticOrder S; S.init(M, NPROJ, G, blockIdx.x);
        pg8::EpiSplit E{(bf16_t*)(ws + WS_Z), (bf16_t*)(ws + WS_XBC), (bf16_t*)(ws + WS_U)}; pg8::gemm_phase(lds, g, S, E);
        { PH_IDS(); dt_tail(H, (const bf16_t*)(ws + WS_WDT), a.in[I_DTB], (float*)(ws + WS_DT), G, wave, lane); } }
    SEAM(5);
    if (IN(6)) REP(6) { PH_IDS();
        for (int it = blockIdx.x; it < BATCH * NCHUNK * 4; it += G) ssd_states_item(a, lds, it, tid, lane, wave);
        for (int it = blockIdx.x; it < M / 32; it += G) diff_item((const bf16_t*)(ws + WS_U), H, it, tid);
    }
    SEAM(6);
    if (IN(7)) REP(7) { PH_IDS();
        scan_phase(a, lds, tid, G);
        __syncthreads();
        REP(14) {
        pg8::Gemm g{H, H, (const bf16_t*)(ws + WS_WPOOL), M, 1024, 256, 1024, 256, 1 << 30, 256}; pg8::StaticOrder S; S.init(M, 1024, G, blockIdx.x);
        pg8::EpiPool E{(bf16_t*)(ws + WS_YPOOL), a.in[I_POOLB], a.in[I_POOLS]}; pg8::gemm_phase(lds, g, S, E);
        }
    }
    SEAM(7);
    if (IN(8)) REP(8) { PH_IDS(); for (int it = blockIdx.x; it < BATCH * NCHUNK * 4; it += G) ssd_out_item(a, lds, it, tid, lane, wave); }
    SEAM(8);
    if (IN(9)) REP(9) { __syncthreads();
        pg8::Gemm g{H, (const bf16_t*)(ws + WS_YPOOL), (const bf16_t*)(ws + WS_WOUT), M, D, 2048, 1024, 2048, 16, 0}; pg8::StaticOrder S; S.init(M, D, G, blockIdx.x);
        pg8::EpiResidNorm<false> E{XR, XR, mod + 5 * D, a.in[I_N2], mod + 6 * D, mod + 7 * D, H, nullptr, (float*)(ws + WS_SSQ) + 1 * M * 4, (unsigned*)(ws + WS_CNT) + 1 * 64 * 64}; pg8::gemm_phase(lds, g, S, E); }
    SEAM(9);
    if (IN(11)) REP(11) { pg8::Gemm g{H, H, (const bf16_t*)(ws + WS_WGU2), M, 2 * FF, D, D, D, 1 << 30, 0}; pg8::StaticOrder S; S.init(M, 2 * FF, G, blockIdx.x);
        pg8::EpiSwiGLU E{(bf16_t*)(ws + WS_ACT)}; pg8::gemm_phase(lds, g, S, E); }
    SEAM(11);
    if (IN(12)) REP(12) { pg8::Gemm g{(const bf16_t*)(ws + WS_ACT), (const bf16_t*)(ws + WS_ACT), (const bf16_t*)(ws + WS_WD2), M, D, FF, FF, FF, 1 << 30, 0}; pg8::StaticOrder S; S.init(M, D, G, blockIdx.x);
        pg8::EpiResidNorm<true> E{XR, nullptr, mod + 8 * D, a.in[I_NF], nullptr, nullptr, nullptr, a.out, (float*)(ws + WS_SSQ) + 2 * M * 4, (unsigned*)(ws + WS_CNT) + 2 * 64 * 64}; pg8::gemm_phase(lds, g, S, E); }
#undef IN
#undef SEAM
}


#ifndef DBG_K
#define DBG_K -1
#endif
__global__ void dbg_dump(float* out, const void* src, int mode, int nch) {
    for (size_t i = (size_t)blockIdx.x * blockDim.x + threadIdx.x; i < (size_t)M * 1024; i += (size_t)gridDim.x * blockDim.x) {
        float v = 0.f;
        if (mode == 0) v = ((const float*)src)[i];
        else if (mode == 2) v = __uint_as_float((unsigned)((const bf16_t*)src)[i + (size_t)M * 1024] << 16);
        else for (int j = 0; j < nch; ++j) v += __uint_as_float((unsigned)((const bf16_t*)src)[i + (size_t)j * M * 1024] << 16);
        out[i] = v;
    }
}
extern "C" void kernel_launch(void* const* d_in, const int* in_sizes, int n_in, void* d_out, int out_size, void* d_ws, size_t ws_size, hipStream_t stream) {
    static int grid_blocks = 0;
    if (grid_blocks == 0) {
        int dev = 0, cus = 0, per_cu = 0;
        (void)hipGetDevice(&dev);
        (void)hipDeviceGetAttribute(&cus, hipDeviceAttributeMultiprocessorCount, dev);
        if (hipFuncSetAttribute((const void*)fwd_megakernel, hipFuncAttributeMaxDynamicSharedMemorySize, LDS_BYTES) != hipSuccess) { fprintf(stderr, "hipFuncSetAttribute failed\n"); grid_blocks = -1; return; }
        if (hipOccupancyMaxActiveBlocksPerMultiprocessor(&per_cu, (const void*)fwd_megakernel, NTHREADS, LDS_BYTES) != hipSuccess || per_cu < 1) { fprintf(stderr, "occupancy query: %d blocks/CU\n", per_cu); grid_blocks = -1; return; }
        grid_blocks = cus;
        if (n_in != 25 || ws_size < WS_END) { fprintf(stderr, "unexpected problem: n_in %d ws %zu\n", n_in, ws_size); grid_blocks = -1; return; }
    }
    if (grid_blocks < 0) return;
    Args a{};
    for (int i = 0; i < 25; ++i) a.in[i] = (const float*)d_in[i];
    a.out = (float*)d_out; a.ws = (unsigned char*)d_ws;
    (void)hipMemsetAsync((unsigned char*)d_ws + WS_BAR, 0, BAR_BYTES, stream);
#ifndef MK_PER_PHASE
#define MK_PER_PHASE 0
#endif
#if MK_PER_PHASE
    const int kmax = (DBG_K >= 0) ? DBG_K : 13;
    for (int k = 0; k <= kmax; ++k) { a.ph_lo = k; a.ph_hi = k + 1; hipLaunchKernelGGL(fwd_megakernel, dim3(grid_blocks), dim3(NTHREADS), LDS_BYTES, stream, a); }
    if (DBG_K >= 0) {
        const unsigned char* ws = (const unsigned char*)d_ws; const void* src = ws + WS_XR; int mode = 0, nch = 1;
        if (DBG_K == 5) { src = ws + WS_Z; mode = 1; nch = 4; }
        if (DBG_K == 2) { src = ws + WS_ACT; mode = 1; nch = 2; }
        if (DBG_K == 6) { src = (const unsigned char*)d_out; mode = 2; nch = 1; }
        if (DBG_K == 7) { src = ws + WS_YPOOL; mode = 1; nch = 1; }
        if (DBG_K == 8) { src = d_out; mode = 1; nch = 1; }
        if (DBG_K == 1) { src = d_out; mode = 1; nch = 1; }
        if (DBG_K == 4) { src = ws + WS_DT; mode = 0; nch = 1; }
        if (src == (const void*)d_out) { (void)hipMemcpyAsync((unsigned char*)d_ws + WS_XR, d_out, 64 * MiB, hipMemcpyDeviceToDevice, stream); src = ws + WS_XR; }
        hipLaunchKernelGGL(dbg_dump, dim3(2048), dim3(256), 0, stream, (float*)d_out, src, mode, nch);
    }
#else
    a.ph_lo = 0; a.ph_hi = 14;
    void* args[] = {&a};
    hipError_t e = hipLaunchCooperativeKernel((const void*)fwd_megakernel, dim3(grid_blocks), dim3(NTHREADS), args, LDS_BYTES, stream);
    if (e != hipSuccess) fprintf(stderr, "cooperative launch failed: %s (grid %d)\n", hipGetErrorString(e), grid_blocks);
#endif
}
```

```cpp
#include <hip/hip_runtime.h>
#include <hip/hip_cooperative_groups.h>
#include <cstdio>
namespace cg = cooperative_groups;

#define LAS __attribute__((address_space(3)))
typedef unsigned short bf16_t;
typedef short bf16x8 __attribute__((ext_vector_type(8)));
typedef float f32x4 __attribute__((ext_vector_type(4)));
typedef float f32x2 __attribute__((ext_vector_type(2)));
typedef unsigned u32x4 __attribute__((ext_vector_type(4)));
typedef unsigned u32x2 __attribute__((ext_vector_type(2)));

constexpr int BATCH = 4, SEQ = 4096, D = 1024, M = BATCH * SEQ, FF = 2816, NPROJ = 4096, DINP = 4112, DXBC = 2048, NMOD = 9 * D;
constexpr int NCHUNK = 32, NHEAD = 16;
constexpr float EPS = 1e-6f;
constexpr int NWAVES = 8, NTHREADS = 512;
#ifndef WGM_FF
#define WGM_FF 7
#endif
#ifndef WGM_IN
#define WGM_IN 6
#endif
#ifndef WGM_N1K
#define WGM_N1K 4
#endif
constexpr int LDS_BYTES = 147456;

constexpr size_t KiB = 1024, MiB = 1u << 20;
constexpr size_t WS_MOD = 624 * KiB  , WS_CDEC = 256 * KiB, WS_WDT = 512 * KiB, WS_BAR = 768 * KiB, BAR_BYTES = 128 * KiB, WS_CNT = WS_BAR + 16 * KiB, WS_BVEC = WS_BAR + 96 * KiB, WS_SSQ = 1 * MiB, WS_DT = 2 * MiB;
constexpr size_t WS_WPOOL = 4 * MiB, WS_WOUT = WS_WPOOL + MiB / 2, WS_WGU2 = WS_WOUT + 4 * MiB, WS_WD2 = WS_WGU2 + 11 * MiB, WS_WGU1 = WS_WD2 + 11 * MiB / 2,
                 WS_WD1 = WS_WGU1 + 11 * MiB, WS_WIN = WS_WD1 + 11 * MiB / 2, WS_XR = WS_WIN + 8 * MiB, WS_R2 = WS_XR + 64 * MiB;
constexpr size_t WS_ACT = WS_R2, WS_Z = WS_R2, WS_XBC = WS_R2 + 32 * MiB, WS_U = WS_R2 + 96 * MiB, WS_YPOOL = WS_U, WS_END = WS_U + 32 * MiB;
static_assert(WS_END <= 256 * MiB, "ws map");
static_assert(WS_ACT + (size_t)M * FF * 2 <= 256 * MiB, "ws map act");
constexpr size_t DO_H = 0, DO_STATES = 32 * MiB;

__device__ __forceinline__ float wave_sum(float v) {
#pragma unroll
    for (int o = 1; o < 64; o <<= 1) v += __shfl_xor(v, o);
    return v;
}
typedef __bf16 bf16x2_t __attribute__((ext_vector_type(2)));
__device__ __forceinline__ unsigned cvt_pk_bf16(float lo, float hi) { f32x2 v = {lo, hi}; bf16x2_t r = __builtin_convertvector(v, bf16x2_t); return __builtin_bit_cast(unsigned, r); }
__device__ __forceinline__ float bf_lo(unsigned u) { return __uint_as_float(u << 16); }
__device__ __forceinline__ float bf_hi(unsigned u) { return __uint_as_float(u & 0xffff0000u); }
__device__ __forceinline__ float siluf(float x) { return x * __builtin_amdgcn_rcpf(1.f + __builtin_amdgcn_exp2f(-1.44269504f * x)); }
#define LDS_WAIT() asm volatile("s_waitcnt lgkmcnt(0)" ::: "memory")

namespace pg8 {
constexpr int BM = 256, BK = 64, HALF = 128, HTB = HALF * BK * 2, STAGE_BYTES = 8 * HTB, NXCD = 8, WGM = 8;
__device__ __forceinline__ int lds_byte(int r, int c) { const int st = (r >> 4) * 2 + (c >> 5), rr = r & 15, cc = c & 31, ob = rr * 64 + cc * 2; return st * 1024 + (ob ^ (((ob >> 9) & 1) << 5)); }
__device__ __forceinline__ void stage_rc(int b, int& R, int& C) { const int st = b / 1024, sb = b % 1024, swz = sb ^ (((sb >> 9) & 1) << 5); R = (st >> 1) * 16 + swz / 64; C = (st & 1) * 32 + (swz % 64) / 2; }
struct Unit { int pm, pn; };
struct Gemm { const bf16_t* A; const bf16_t* A2; const bf16_t* Bt; int M, N, K, lda, ldb, ksplit, a_pn_off; };
struct StaticOrder {
    int nM, nN, nwg, G, c, wgm;
    __device__ void init(int M_, int N_, int G_, int c_, int wgm_ = WGM) { nM = M_ / BM; nN = N_ / BM; nwg = nM * nN; G = G_; c = c_; wgm = wgm_; }
    __device__ bool next(int i, Unit& u) const {
        const long L = (long)i * G + c; if (L >= nwg) return false;
        int wgid = (int)L; { const int q = nwg / NXCD, r = nwg % NXCD, xcd = wgid % NXCD, off = wgid / NXCD; wgid = (xcd < r ? xcd * (q + 1) : r * (q + 1) + (xcd - r) * q) + off; }
        const int nig = wgm * nN, gid = wgid / nig, fm = gid * wgm, gsz = (nM - fm) < wgm ? (nM - fm) : wgm;
        u.pm = fm + ((wgid % nig) % gsz); u.pn = (wgid % nig) / gsz; return true;
    }
};
template <class Epi>
__device__ __forceinline__ void gemm_phase(LAS unsigned char* lds, const Gemm g, const StaticOrder& S, const Epi& E) {
    int tid = threadIdx.x; asm volatile("" : "+v"(tid));
    const int wid = __builtin_amdgcn_readfirstlane(tid >> 6), lane = tid & 63, wr = wid >> 2, wc = wid & 3, fr = lane & 15, fq = lane >> 4;
    int nt = g.K / BK, ksplit = g.ksplit;
    asm volatile("" : "+s"(nt), "+s"(ksplit));
    unsigned voffA[2], voffB[2];
#pragma unroll
    for (int i = 0; i < 2; ++i) { int R, C; stage_rc(tid * 16 + i * 8192, R, C); voffA[i] = (unsigned)(R * g.lda + C) * 2u; voffB[i] = (unsigned)(R * g.ldb + C) * 2u; }
    const size_t kstep = (size_t)(BK * 2);
    const size_t hstepA = (size_t)HALF * g.lda * 2, hstepB = (size_t)HALF * g.ldb * 2;
    const size_t tstepA = 2 * hstepA, tstepB = 2 * hstepB;
    const unsigned ldsw = (unsigned)wid * 1024u;
    const int aoff = lds_byte(wr * 64 + fr, fq * 8), boff = lds_byte(wc * 32 + fr, fq * 8);
#define PG8_SA(b, h) (((b) * 2 + (h)) * HTB)
#define PG8_SB(b, h) ((4 + (b) * 2 + (h)) * HTB)
#define PG8_STAGE(bufoff, gbase, voff) do { _Pragma("unroll") for (int _i = 0; _i < 2; ++_i) \
        __builtin_amdgcn_global_load_lds((const unsigned*)((const char*)(gbase) + (voff)[_i]), (LAS unsigned*)(lds + (bufoff) + ldsw + _i * 8192), 16, 0, 0); } while (0)
#define PG8_LDA(dst, b, h) do { _Pragma("unroll") for (int m = 0; m < 4; ++m) _Pragma("unroll") for (int k = 0; k < 2; ++k) dst[m][k] = *(const LAS bf16x8*)(lds + PG8_SA(b, h) + aoff + m * 2048 + k * 1024); } while (0)
#define PG8_LDB(dst, b, h) do { _Pragma("unroll") for (int n = 0; n < 2; ++n) _Pragma("unroll") for (int k = 0; k < 2; ++k) dst[n][k] = *(const LAS bf16x8*)(lds + PG8_SB(b, h) + boff + n * 2048 + k * 1024); } while (0)
#define PG8_MMA(ai, bj, At, Bt) do { __builtin_amdgcn_s_setprio(1); _Pragma("unroll") for (int m = 0; m < 4; ++m) _Pragma("unroll") for (int n = 0; n < 2; ++n) _Pragma("unroll") for (int k = 0; k < 2; ++k) \
        acc[ai][bj][m][n] = __builtin_amdgcn_mfma_f32_16x16x32_bf16(Bt[n][k], At[m][k], acc[ai][bj][m][n], 0, 0, 0); __builtin_amdgcn_s_setprio(0); } while (0)
#define PG8_WAIT_V(n) asm volatile("s_waitcnt vmcnt(" #n ")" ::: "memory")
#define PG8_WAIT_L(n) asm volatile("s_waitcnt lgkmcnt(" #n ")" ::: "memory")
#define PG8_BAR __builtin_amdgcn_s_barrier()
#define PG8_SCHED __builtin_amdgcn_sched_barrier(0)
#define PG8_TILEA(c1, c2, t) ((t) < ksplit ? (c1) + (size_t)(t) * kstep : (c2) + (size_t)((t) - ksplit) * kstep)
    Unit cur, nxt; int ui = 0;
    if (!S.next(0, cur)) return;
    f32x4 acc[2][2][4][2];
#pragma unroll
    for (int a = 0; a < 2; ++a)
#pragma unroll
        for (int b = 0; b < 2; ++b)
#pragma unroll
            for (int m = 0; m < 4; ++m)
#pragma unroll
                for (int n = 0; n < 2; ++n) acc[a][b][m][n] = (f32x4){0.f, 0.f, 0.f, 0.f};
    bf16x8 At[4][2], B0[2][2], B1[2][2];
    const char* cA = (const char*)g.A + (size_t)cur.pm * tstepA + (size_t)cur.pn * g.a_pn_off * 2;
    const char* cA2 = (const char*)g.A2 + (size_t)cur.pm * tstepA + (size_t)cur.pn * g.a_pn_off * 2;
    const char* cB = (const char*)g.Bt + (size_t)cur.pn * tstepB;
    PG8_STAGE(PG8_SB(0, 0), cB, voffB); PG8_STAGE(PG8_SA(0, 0), cA, voffA); PG8_STAGE(PG8_SB(0, 1), cB + hstepB, voffB); PG8_STAGE(PG8_SA(0, 1), cA + hstepA, voffA);
    if (wr == 1) PG8_BAR;
    PG8_WAIT_V(4); PG8_BAR;
    PG8_STAGE(PG8_SB(1, 0), cB + kstep, voffB); PG8_STAGE(PG8_SA(1, 0), cA + kstep, voffA); PG8_STAGE(PG8_SB(1, 1), cB + hstepB + kstep, voffB);
    PG8_WAIT_V(6); PG8_BAR;
    for (;;) {
        const bool has_next = S.next(ui + 1, nxt);
        const char* nA = has_next ? (const char*)g.A + (size_t)nxt.pm * tstepA + (size_t)nxt.pn * g.a_pn_off * 2 : cA;
        const char* nA2 = has_next ? (const char*)g.A2 + (size_t)nxt.pm * tstepA + (size_t)nxt.pn * g.a_pn_off * 2 : cA2;
        const char* nB = has_next ? (const char*)g.Bt + (size_t)nxt.pn * tstepB : cB;
        for (int t = 0; t < nt; t += 2) {
            const bool last = (t == nt - 2);
            const char* a1 = PG8_TILEA(cA, cA2, t + 1);
            const char* a2 = last ? nA : PG8_TILEA(cA, cA2, t + 2); const char* b2 = last ? nB : cB + (size_t)(t + 2) * kstep;
            const char* a3 = a2 + kstep; const char* b3 = b2 + kstep;
            PG8_LDB(B0, 0, 0); PG8_SCHED; PG8_LDA(At, 0, 0); PG8_STAGE(PG8_SA(1, 1), a1 + hstepA, voffA);
            PG8_WAIT_L(8); PG8_BAR; PG8_WAIT_L(0); PG8_MMA(0, 0, At, B0); PG8_BAR; PG8_SCHED;
            PG8_LDB(B1, 0, 1); PG8_STAGE(PG8_SB(0, 0), b2, voffB);
            PG8_BAR; PG8_WAIT_L(0); PG8_MMA(0, 1, At, B1); PG8_BAR;
            PG8_LDA(At, 0, 1); PG8_STAGE(PG8_SA(0, 0), a2, voffA);
            PG8_BAR; PG8_WAIT_L(0); PG8_MMA(1, 0, At, B0); PG8_BAR; PG8_SCHED;
            PG8_STAGE(PG8_SB(0, 1), b2 + hstepB, voffB);
            PG8_WAIT_V(6); PG8_BAR; PG8_MMA(1, 1, At, B1); PG8_BAR;
            PG8_LDB(B0, 1, 0); PG8_SCHED; PG8_LDA(At, 1, 0); PG8_STAGE(PG8_SA(0, 1), a2 + hstepA, voffA);
            PG8_WAIT_L(8); PG8_BAR; PG8_WAIT_L(0); PG8_MMA(0, 0, At, B0); PG8_BAR; PG8_SCHED;
            PG8_LDB(B1, 1, 1); PG8_STAGE(PG8_SB(1, 0), b3, voffB);
            PG8_BAR; PG8_WAIT_L(0); PG8_MMA(0, 1, At, B1); PG8_BAR;
            PG8_LDA(At, 1, 1); PG8_STAGE(PG8_SA(1, 0), a3, voffA);
            PG8_BAR; PG8_WAIT_L(0); PG8_MMA(1, 0, At, B0); PG8_BAR; PG8_SCHED;
            PG8_STAGE(PG8_SB(1, 1), b3 + hstepB, voffB);
            PG8_WAIT_V(6); PG8_BAR; PG8_MMA(1, 1, At, B1); PG8_BAR;
        }
        if constexpr (!Epi::AFTER_DRAIN) E(acc, cur, wr, wc, fr, fq);
        if (!has_next) break;
#pragma unroll
        for (int a = 0; a < 2; ++a)
#pragma unroll
            for (int b = 0; b < 2; ++b)
#pragma unroll
                for (int m = 0; m < 4; ++m)
#pragma unroll
                    for (int n = 0; n < 2; ++n) acc[a][b][m][n] = (f32x4){0.f, 0.f, 0.f, 0.f};
        cur = nxt; cA = nA; cA2 = nA2; cB = nB; ++ui;
    }
    PG8_WAIT_V(0);
    if (wr == 0) PG8_BAR;
    PG8_BAR;
    if constexpr (Epi::AFTER_DRAIN) E.fused(acc, cur, wr, wc, fr, fq, lds, wid, lane);
#undef PG8_SA
#undef PG8_SB
#undef PG8_STAGE
#undef PG8_LDA
#undef PG8_LDB
#undef PG8_MMA
#undef PG8_WAIT_V
#undef PG8_WAIT_L
#undef PG8_BAR
#undef PG8_SCHED
#undef PG8_TILEA
}

struct EpiSwiGLU {
    static constexpr bool AFTER_DRAIN = false;
    bf16_t* O;
    __device__ __forceinline__ void operator()(const f32x4 (&acc)[2][2][4][2], const Unit& u, int wr, int wc, int fr, int fq) const {
        const int row0 = u.pm * BM + wr * 64 + fr, col0 = u.pn * HALF + wc * 32 + 8 * fq;
#pragma unroll
        for (int ai = 0; ai < 2; ++ai)
#pragma unroll
            for (int m = 0; m < 4; ++m) { bf16_t* rowp = O + (size_t)(row0 + ai * HALF + m * 16) * FF + col0;
                const f32x4 g0 = acc[ai][0][m][0], u0 = acc[ai][1][m][0], g1 = acc[ai][0][m][1], u1 = acc[ai][1][m][1];
                u32x4 w; w.x = cvt_pk_bf16(siluf(g0[0]) * u0[0], siluf(g0[1]) * u0[1]); w.y = cvt_pk_bf16(siluf(g0[2]) * u0[2], siluf(g0[3]) * u0[3]);
                w.z = cvt_pk_bf16(siluf(g1[0]) * u1[0], siluf(g1[1]) * u1[1]); w.w = cvt_pk_bf16(siluf(g1[2]) * u1[2], siluf(g1[3]) * u1[3]);
                *(u32x4*)rowp = w; }
    }
};
struct EpiResid {
    static constexpr bool AFTER_DRAIN = false;
    const float* base; float* out; const float* gate; float scale;
    __device__ __forceinline__ void operator()(const f32x4 (&acc)[2][2][4][2], const Unit& u, int wr, int wc, int fr, int fq) const {
        const int row0 = u.pm * BM + wr * 64 + fr, col0 = u.pn * BM + wc * 32 + 4 * fq, b = u.pm >> 4;
        f32x4 gv[2][2];
#pragma unroll
        for (int bj = 0; bj < 2; ++bj)
#pragma unroll
            for (int n = 0; n < 2; ++n) gv[bj][n] = *(const f32x4*)(gate + (size_t)b * NMOD + col0 + bj * HALF + n * 16) * scale;
#pragma unroll
        for (int ai = 0; ai < 2; ++ai)
#pragma unroll
            for (int m = 0; m < 4; ++m) { const size_t off = (size_t)(row0 + ai * HALF + m * 16) * D + col0;
#pragma unroll
                for (int bj = 0; bj < 2; ++bj)
#pragma unroll
                    for (int n = 0; n < 2; ++n) { const f32x4 bs = *(const f32x4*)(base + off + bj * HALF + n * 16);
                        *(f32x4*)(out + off + bj * HALF + n * 16) = bs + gv[bj][n] * acc[ai][bj][m][n]; } }
    }
};
struct EpiSplit {
    static constexpr bool AFTER_DRAIN = false;
    bf16_t* Z; bf16_t* XBC; bf16_t* U;
    __device__ __forceinline__ void operator()(const f32x4 (&acc)[2][2][4][2], const Unit& u, int wr, int wc, int fr, int fq) const {
        bf16_t* basep; int ld, c0;
        if (u.pn < 4) { basep = Z; ld = 1024; c0 = u.pn * BM; } else if (u.pn < 12) { basep = XBC; ld = 2048; c0 = (u.pn - 4) * BM; } else { basep = U; ld = 1024; c0 = (u.pn - 12) * BM; }
        const int row0 = u.pm * BM + wr * 64 + fr, col0 = c0 + wc * 32 + 8 * fq;
#pragma unroll
        for (int ai = 0; ai < 2; ++ai)
#pragma unroll
            for (int m = 0; m < 4; ++m) { bf16_t* rowp = basep + (size_t)(row0 + ai * HALF + m * 16) * ld + col0;
#pragma unroll
                for (int bj = 0; bj < 2; ++bj) { const f32x4 v0 = acc[ai][bj][m][0], v1 = acc[ai][bj][m][1];
                    u32x4 w; w.x = cvt_pk_bf16(v0[0], v0[1]); w.y = cvt_pk_bf16(v0[2], v0[3]); w.z = cvt_pk_bf16(v1[0], v1[1]); w.w = cvt_pk_bf16(v1[2], v1[3]);
                    *(u32x4*)(rowp + bj * HALF) = w; } }
    }
};
struct EpiFold {
    static constexpr bool AFTER_DRAIN = false;
    bf16_t* O;
    __device__ __forceinline__ void operator()(const f32x4 (&acc)[2][2][4][2], const Unit& u, int wr, int wc, int fr, int fq) const {
        const int row0 = u.pm * BM + wr * 64 + fr, col0 = 1024 + u.pn * BM + wc * 32 + 4 * fq;
#pragma unroll
        for (int ai = 0; ai < 2; ++ai)
#pragma unroll
            for (int m = 0; m < 4; ++m) { bf16_t* rowp = O + (size_t)(row0 + ai * HALF + m * 16) * 2048 + col0;
#pragma unroll
                for (int bj = 0; bj < 2; ++bj)
#pragma unroll
                    for (int n = 0; n < 2; ++n) { const f32x4 v = acc[ai][bj][m][n]; u32x2 w; w.x = cvt_pk_bf16(v[0], v[1]); w.y = cvt_pk_bf16(v[2], v[3]);
                        *(u32x2*)(rowp + bj * HALF + n * 16) = w; } }
    }
};
struct EpiPool {
    static constexpr bool AFTER_DRAIN = false;
    bf16_t* O; const float* bias; const float* scl;
    __device__ __forceinline__ void operator()(const f32x4 (&acc)[2][2][4][2], const Unit& u, int wr, int wc, int fr, int fq) const {
        const int row0 = u.pm * BM + wr * 64 + fr, col0 = u.pn * BM + wc * 32 + 4 * fq;
        f32x4 bv[2][2], sv[2][2];
#pragma unroll
        for (int bj = 0; bj < 2; ++bj)
#pragma unroll
            for (int n = 0; n < 2; ++n) { bv[bj][n] = *(const f32x4*)(bias + col0 + bj * HALF + n * 16); sv[bj][n] = *(const f32x4*)(scl + col0 + bj * HALF + n * 16); }
#pragma unroll
        for (int ai = 0; ai < 2; ++ai)
#pragma unroll
            for (int m = 0; m < 4; ++m) { bf16_t* rowp = O + (size_t)(row0 + ai * HALF + m * 16) * 1024 + col0;
#pragma unroll
                for (int bj = 0; bj < 2; ++bj)
#pragma unroll
                    for (int n = 0; n < 2; ++n) { const f32x4 v = (acc[ai][bj][m][n] + bv[bj][n]) * sv[bj][n]; u32x2 w; w.x = cvt_pk_bf16(v[0], v[1]); w.y = cvt_pk_bf16(v[2], v[3]);
                        *(u32x2*)(rowp + bj * HALF + n * 16) = w; } }
    }
};

template <bool HALF_SCALE, bool BASE_BF16> struct EpiResidNorm {
    static constexpr bool AFTER_DRAIN = true;
    const void* base; bf16_t* xout; const float* gate;
    const float* nw; const float* sh; const float* sc;
    bf16_t* hout; float* fout;
    float* ssq; unsigned* cnt;
    const float* bias;
    __device__ __forceinline__ void fused(f32x4 (&acc)[2][2][4][2], const Unit& u, int wr, int wc, int fr, int fq, LAS unsigned char* lds, int wid, int lane) const {
        const void* const base = this->base; bf16_t* const xout = this->xout; const float* const gate = this->gate; const float scale = HALF_SCALE ? 0.5f : 1.0f;
        const float* const nw = this->nw; const float* const sh = this->sh; const float* const sc = this->sc; bf16_t* const hout = this->hout; float* const fout = this->fout;
        float* const ssq = this->ssq; unsigned* const cnt = this->cnt; const float* const bias = this->bias;
        LAS float* P = (LAS float*)lds;
        LAS float* S = (LAS float*)(lds + 4096);
        const int row0 = u.pm * BM + wr * 64 + fr, col0 = u.pn * BM + wc * 32 + 8 * fq, b = u.pm >> 4;
        {
            f32x4 gv[2][2];
#pragma unroll
            for (int bj = 0; bj < 2; ++bj)
#pragma unroll
                for (int n = 0; n < 2; ++n) gv[bj][n] = *(const f32x4*)(gate + (size_t)b * NMOD + col0 + bj * HALF + n * 4) * scale;
            if (bias) {
#pragma unroll
                for (int bj = 0; bj < 2; ++bj)
#pragma unroll
                    for (int n = 0; n < 2; ++n) { const f32x4 bv = *(const f32x4*)(bias + col0 + bj * HALF + n * 4);
#pragma unroll
                        for (int ai = 0; ai < 2; ++ai)
#pragma unroll
                            for (int m = 0; m < 4; ++m) acc[ai][bj][m][n] += bv; } }
#pragma unroll
            for (int ai = 0; ai < 2; ++ai)
#pragma unroll
                for (int mh = 0; mh < 2; ++mh) {
                    f32x4 bsv[2][2][2];
#pragma unroll
                    for (int mm = 0; mm < 2; ++mm)
#pragma unroll
                        for (int bj = 0; bj < 2; ++bj) { const size_t o2 = (size_t)(row0 + ai * HALF + (mh * 2 + mm) * 16) * D + col0 + bj * HALF;
                            if (BASE_BF16) { const u32x4 q = *(const u32x4*)((const bf16_t*)base + o2);
                                bsv[mm][bj][0] = (f32x4){bf_lo(q.x), bf_hi(q.x), bf_lo(q.y), bf_hi(q.y)}; bsv[mm][bj][1] = (f32x4){bf_lo(q.z), bf_hi(q.z), bf_lo(q.w), bf_hi(q.w)}; }
                            else { bsv[mm][bj][0] = *(const f32x4*)((const float*)base + o2); bsv[mm][bj][1] = *(const f32x4*)((const float*)base + o2 + 4); } }
                    asm volatile("" ::: "memory");
#pragma unroll
                    for (int mm = 0; mm < 2; ++mm) { const int m = mh * 2 + mm; const size_t off = (size_t)(row0 + ai * HALF + m * 16) * D + col0; float sq = 0.f;
#pragma unroll
                        for (int bj = 0; bj < 2; ++bj) { u32x4 q;
#pragma unroll
                            for (int n = 0; n < 2; ++n) { const f32x4 x = bsv[mm][bj][n] + gv[bj][n] * acc[ai][bj][m][n];
                                acc[ai][bj][m][n] = x; if (n == 0) { q.x = cvt_pk_bf16(x[0], x[1]); q.y = cvt_pk_bf16(x[2], x[3]); } else { q.z = cvt_pk_bf16(x[0], x[1]); q.w = cvt_pk_bf16(x[2], x[3]); }
                                sq += (x[0] * x[0] + x[1] * x[1]) + (x[2] * x[2] + x[3] * x[3]); }
                            if (xout) *(u32x4*)(xout + off + bj * HALF) = q; }
                        sq += __shfl_xor(sq, 16); sq += __shfl_xor(sq, 32);
                        if (fq == 0) P[(ai * HALF + wr * 64 + m * 16 + fr) * 4 + wc] = sq; }
                }
        }
        asm volatile("s_waitcnt lgkmcnt(0)" ::: "memory"); __builtin_amdgcn_s_barrier(); asm volatile("" ::: "memory");
        const int tid = wid * 64 + lane;
        if (tid < 256) { const f32x4 p = *(const LAS f32x4*)(P + tid * 4);
            __hip_atomic_store(ssq + ((size_t)(u.pm * BM + tid)) * 4 + u.pn, (p[0] + p[1]) + (p[2] + p[3]), __ATOMIC_RELAXED, __HIP_MEMORY_SCOPE_AGENT); }
        asm volatile("s_waitcnt vmcnt(0)" ::: "memory");
        if (wid < 4 && lane == 0) __hip_atomic_fetch_add(cnt + 64 * u.pm, 1u, __ATOMIC_RELAXED, __HIP_MEMORY_SCOPE_AGENT);
        if (wid == 0) {
            unsigned spins = 0;
            while ((unsigned)__builtin_amdgcn_readfirstlane(__hip_atomic_load(cnt + 64 * u.pm, __ATOMIC_RELAXED, __HIP_MEMORY_SCOPE_AGENT)) < 16u) { __builtin_amdgcn_s_sleep(2); if (++spins > (1u << 22)) break; }
            __builtin_amdgcn_fence(__ATOMIC_ACQUIRE, "agent");
        }
        asm volatile("s_waitcnt vmcnt(0) lgkmcnt(0)" ::: "memory"); __builtin_amdgcn_s_barrier(); asm volatile("" ::: "memory");
        if (tid < 256) { const float* slot = ssq + ((size_t)(u.pm * BM + tid)) * 4; float t = 0.f;
#pragma unroll
            for (int q = 0; q < 4; ++q) t += __hip_atomic_load(slot + q, __ATOMIC_RELAXED, __HIP_MEMORY_SCOPE_AGENT);
            S[tid] = rsqrtf(t * (1.f / D) + EPS); }
        asm volatile("s_waitcnt vmcnt(0) lgkmcnt(0)" ::: "memory"); __builtin_amdgcn_s_barrier(); asm volatile("" ::: "memory");
        f32x4 A4[2][2], B4[2][2];
#pragma unroll
        for (int bj = 0; bj < 2; ++bj)
#pragma unroll
            for (int n = 0; n < 2; ++n) { const int col = col0 + bj * HALF + n * 4;
                A4[bj][n] = *(const f32x4*)(nw + col); B4[bj][n] = (f32x4){0.f, 0.f, 0.f, 0.f};
                if (sc) { A4[bj][n] = A4[bj][n] * (*(const f32x4*)(sc + (size_t)b * NMOD + col) + 1.f); B4[bj][n] = *(const f32x4*)(sh + (size_t)b * NMOD + col); } }
#pragma unroll
        for (int ai = 0; ai < 2; ++ai)
#pragma unroll
            for (int m = 0; m < 4; ++m) { const float rstd = S[ai * HALF + wr * 64 + m * 16 + fr];
#pragma unroll
                for (int bj = 0; bj < 2; ++bj) { const size_t off = (size_t)(row0 + ai * HALF + m * 16) * D + col0 + bj * HALF;
                    const f32x4 o0 = acc[ai][bj][m][0] * rstd * A4[bj][0] + B4[bj][0], o1 = acc[ai][bj][m][1] * rstd * A4[bj][1] + B4[bj][1];
                    if (hout) { u32x4 w; w.x = cvt_pk_bf16(o0[0], o0[1]); w.y = cvt_pk_bf16(o0[2], o0[3]); w.z = cvt_pk_bf16(o1[0], o1[1]); w.w = cvt_pk_bf16(o1[2], o1[3]); *(u32x4*)(hout + off) = w; }
                    else { *(f32x4*)(fout + off) = o0; *(f32x4*)(fout + off + 4) = o1; } } }
    }
};
}

struct Args { const float* in[25]; float* out; unsigned char* ws; int ph_lo, ph_hi; };
enum { I_X = 0, I_C, I_WADA, I_BADA, I_N1, I_G1, I_U1, I_D1, I_NMIX, I_WIN, I_CONVW, I_CONVB, I_DTB, I_ALOG, I_DSKIP, I_SSDNW, I_POOLW, I_POOLB, I_POOLS, I_WOUT, I_N2, I_G2, I_U2, I_D2, I_NF };

__device__ __forceinline__ void p0_transpose_item(const float* W, int ldw, int K, bf16_t* WT, int dst_row0, int n0, int k0, LAS float* scr, int lane, bool perm) {
    const int lr = lane >> 3, lc = (lane & 7) * 4;
    f32x4 v[8];
#pragma unroll
    for (int i = 0; i < 8; ++i) v[i] = *(const f32x4*)(W + (size_t)(k0 + 8 * i + lr) * ldw + n0 + lc);
#pragma unroll
    for (int i = 0; i < 8; ++i) { LAS float* d = scr + (8 * i + lr) * 33 + lc; d[0] = v[i].x; d[1] = v[i].y; d[2] = v[i].z; d[3] = v[i].w; }
    LDS_WAIT();
    const int c = lane & 7;
#pragma unroll
    for (int j = 0; j < 4; ++j) { const int n = (lane >> 3) + 8 * j; const LAS float* sp = scr + (8 * c) * 33 + n;
        u32x4 o; o.x = cvt_pk_bf16(sp[0 * 33], sp[1 * 33]); o.y = cvt_pk_bf16(sp[2 * 33], sp[3 * 33]); o.z = cvt_pk_bf16(sp[4 * 33], sp[5 * 33]); o.w = cvt_pk_bf16(sp[6 * 33], sp[7 * 33]);
        const int nr = perm ? (16 * ((n >> 2) & 1) + 4 * (n >> 3) + (n & 3)) : n;
        *(u32x4*)(WT + (size_t)(dst_row0 + nr) * K + k0 + 8 * c) = o; }
    LDS_WAIT();
}
__device__ __forceinline__ void p0_mat_item(const float* W, int ldw, int K, int nb, int csrc, bf16_t* WT, int drow_base, int mode, int it, LAS float* scr, int lane) {
    const int kb = it / nb, nbi = it % nb, n0 = 32 * nbi;
    int drow = drow_base + n0;
    if (mode & 1) drow = (n0 >> 7) * 256 + (n0 & 127) + drow_base;
    p0_transpose_item(W, ldw, K, WT, drow, csrc + n0, 64 * kb, scr, lane, (mode & 2) != 0);
}
__device__ __forceinline__ void p0_transposes(const Args& a, LAS unsigned char* lds, int part, int gw, int NGW, int lane, int wave) {
    unsigned char* ws = a.ws;
    LAS float* scr = (LAS float*)(lds + wave * 8448);
    constexpr int I_GU = (D / 64) * (FF / 32), I_DN = (FF / 64) * (D / 32), I_ZZ = (D / 64) * 32, I_XB = (D / 64) * 64, I_OUT = (2048 / 64) * 32, I_PW = 512, I_BV = 256;
    if (part == 0) {
        for (int it = gw; it < 2 * I_GU + I_DN; it += NGW) {
            int r = it;
            if (r < I_GU) { p0_mat_item(a.in[I_G1], FF, D, FF / 32, 0, (bf16_t*)(ws + WS_WGU1), 0, 3, r, scr, lane); continue; } r -= I_GU;
            if (r < I_GU) { p0_mat_item(a.in[I_U1], FF, D, FF / 32, 0, (bf16_t*)(ws + WS_WGU1), 128, 3, r, scr, lane); continue; } r -= I_GU;
            p0_mat_item(a.in[I_D1], D, FF, D / 32, 0, (bf16_t*)(ws + WS_WD1), 0, 2, r, scr, lane);
        }
    } else {
        constexpr int NITEMS = 2 * I_GU + I_DN + 2 * I_ZZ + I_XB + I_OUT + I_PW + I_BV;
        for (int it = gw; it < NITEMS; it += NGW) {
            int r = it;
            if (r < I_ZZ) { p0_mat_item(a.in[I_WIN], DINP, D, 32, 0, (bf16_t*)(ws + WS_WIN), 0, 2, r, scr, lane); continue; } r -= I_ZZ;
            if (r < I_XB) { p0_mat_item(a.in[I_WIN], DINP, D, 64, 1024, (bf16_t*)(ws + WS_WIN), 1024, 2, r, scr, lane); continue; } r -= I_XB;
            if (r < I_ZZ) { p0_mat_item(a.in[I_WIN], DINP, D, 32, 3088, (bf16_t*)(ws + WS_WIN), 3072, 2, r, scr, lane); continue; } r -= I_ZZ;
            if (r < I_OUT) { p0_mat_item(a.in[I_WOUT], D, 2048, 32, 0, (bf16_t*)(ws + WS_WOUT), 0, 2, r, scr, lane); continue; } r -= I_OUT;
            if (r < I_PW) {
                const int e0 = r * 512 + lane * 8, gq = e0 >> 16, d0 = e0 & 255;
                const f32x4 p0 = *(const f32x4*)(a.in[I_POOLW] + e0), p1 = *(const f32x4*)(a.in[I_POOLW] + e0 + 4);
                const f32x4 s0 = *(const f32x4*)(a.in[I_POOLS] + gq * 256 + d0), s1 = *(const f32x4*)(a.in[I_POOLS] + gq * 256 + d0 + 4);
                u32x4 o; o.x = cvt_pk_bf16(p0.x * s0.x, p0.y * s0.y); o.y = cvt_pk_bf16(p0.z * s0.z, p0.w * s0.w); o.z = cvt_pk_bf16(p1.x * s1.x, p1.y * s1.y); o.w = cvt_pk_bf16(p1.z * s1.z, p1.w * s1.w);
                *(u32x4*)((bf16_t*)(ws + WS_WPOOL) + e0) = o; continue; } r -= I_PW;
            if (r < I_BV) {
                const int cg = r & 15, kg = r >> 4, n = cg * 64 + lane; float acc = 0.f;
                const float* wp = a.in[I_WOUT] + (size_t)(1024 + kg * 64) * D + n;
#pragma unroll 16
                for (int k = 0; k < 64; ++k) acc += a.in[I_POOLB][kg * 64 + k] * a.in[I_POOLS][kg * 64 + k] * wp[(size_t)k * D];
                atomicAdd((float*)(ws + WS_BVEC) + n, acc); continue; } r -= I_BV;
            if (r < I_GU) { p0_mat_item(a.in[I_G2], FF, D, FF / 32, 0, (bf16_t*)(ws + WS_WGU2), 0, 3, r, scr, lane); continue; } r -= I_GU;
            if (r < I_GU) { p0_mat_item(a.in[I_U2], FF, D, FF / 32, 0, (bf16_t*)(ws + WS_WGU2), 128, 3, r, scr, lane); continue; } r -= I_GU;
            p0_mat_item(a.in[I_D2], D, FF, D / 32, 0, (bf16_t*)(ws + WS_WD2), 0, 2, r, scr, lane);
        }
    }
}
__device__ __forceinline__ void p0_phase(const Args& a, LAS unsigned char* lds, int tid, int lane, int wave, int G, int part) {
    unsigned char* ws = a.ws;
    unsigned* modcnt = (unsigned*)(ws + WS_CNT) + 3 * 64 * 64;
    if (part & 1) {
        LAS float* cact = (LAS float*)(lds + 69632);
        LAS float* red = (LAS float*)(lds + 69632 + 16384);
        {
            for (int i = tid; i < 4 * D; i += NTHREADS) { const float cv = a.in[I_C][i]; cact[i] = cv / (1.f + __expf(-cv)); }
            __syncthreads();
        }
        for (int it = blockIdx.x; it < 2 * (NMOD / 64); it += G) {
            const int cgp = it % (NMOD / 64), kh = it / (NMOD / 64);
            const int j = cgp * 64 + lane, kb = kh * 512 + wave * 64, c4 = (lane & 15) * 4, ksub = lane >> 4;
            f32x4 sv[4];
#pragma unroll
            for (int bb = 0; bb < 4; ++bb) sv[bb] = (f32x4){0.f, 0.f, 0.f, 0.f};
            const float* wp = a.in[I_WADA] + (size_t)(kb + ksub) * NMOD + cgp * 64 + c4;
#pragma unroll
            for (int i = 0; i < 16; ++i) { const f32x4 wv = *(const f32x4*)(wp + (size_t)(4 * i) * NMOD); const int k = kb + 4 * i + ksub;
                sv[0] += wv * cact[k]; sv[1] += wv * cact[D + k]; sv[2] += wv * cact[2 * D + k]; sv[3] += wv * cact[3 * D + k]; }
#pragma unroll
            for (int bb = 0; bb < 4; ++bb)
#pragma unroll
                for (int e = 0; e < 4; ++e) { float t = sv[bb][e]; t += __shfl_xor(t, 16); t += __shfl_xor(t, 32); sv[bb][e] = t; }
            if (ksub == 0) {
#pragma unroll
                for (int bb = 0; bb < 4; ++bb) *(LAS f32x4*)(red + (wave * 4 + bb) * 64 + c4) = sv[bb]; }
            __syncthreads();
            if (wave < 4) { float t = kh == 0 ? a.in[I_BADA][j] : 0.f;
#pragma unroll
                for (int w = 0; w < 8; ++w) t += red[(w * 4 + wave) * 64 + lane];
                atomicAdd((float*)(ws + WS_MOD) + wave * NMOD + j, t); }
            asm volatile("s_waitcnt vmcnt(0)" ::: "memory");
            __syncthreads();
            if (tid == 0) { __threadfence(); __hip_atomic_fetch_add(modcnt, 1u, __ATOMIC_RELAXED, __HIP_MEMORY_SCOPE_AGENT); }
        }
    }
    if (part & 2) for (int idx = blockIdx.x * NTHREADS + tid; idx < 16 * D / 2; idx += G * NTHREADS) { const int k = (idx >> 4) * 2, j = idx & 15;
        ((unsigned*)(ws + WS_WDT))[(j * D + k) >> 1] = cvt_pk_bf16(a.in[I_WIN][(size_t)k * DINP + 3072 + j], a.in[I_WIN][(size_t)(k + 1) * DINP + 3072 + j]); }
    if (part & 2) p0_transposes(a, lds, 0, blockIdx.x * NWAVES + wave, G * NWAVES, lane, wave);
    if (!(part & 4)) return;
    if (wave == 0) { unsigned spins = 0;
        while ((unsigned)__builtin_amdgcn_readfirstlane(__hip_atomic_load(modcnt, __ATOMIC_RELAXED, __HIP_MEMORY_SCOPE_AGENT)) < (unsigned)(2 * (NMOD / 64))) { __builtin_amdgcn_s_sleep(2); if (++spins > (1u << 22)) break; }
        __builtin_amdgcn_fence(__ATOMIC_ACQUIRE, "agent"); }
    asm volatile("s_waitcnt vmcnt(0) lgkmcnt(0)" ::: "memory");
    __syncthreads();
}

template <bool DTP>
__device__ __forceinline__ void norm_phase(LAS unsigned char* lds, const float* src, const float* nw, const float* mod, int sh_off, int sc_off, bf16_t* dst,
                                           const float* wdt, const float* dt_bias, float* DT, int tid, int lane, int wave, int G) {
    LAS f32x4* wl = (LAS f32x4*)lds;
    if (DTP) { for (int i = tid; i < 16 * D / 4; i += NTHREADS) wl[i] = ((const f32x4*)wdt)[i]; __syncthreads(); }
    const int gw = blockIdx.x * NWAVES + wave, NGW = G * NWAVES;
    for (int rg = gw; rg < M / 8; rg += NGW) {
        const int row0 = rg * 8, b = row0 >> 12;
        f32x4 Am[4], Bm[4];
#pragma unroll
        for (int j = 0; j < 4; ++j) { const int col = 4 * lane + 256 * j;
            const f32x4 w = *(const f32x4*)(nw + col), sc = *(const f32x4*)(mod + (size_t)b * NMOD + sc_off + col);
            Am[j] = w * (sc + 1.f); Bm[j] = *(const f32x4*)(mod + (size_t)b * NMOD + sh_off + col); }
#pragma unroll 1
        for (int half = 0; half < 2; ++half) {
            f32x4 o[4][4];
#pragma unroll
            for (int r = 0; r < 4; ++r) {
                const int row = row0 + half * 4 + r;
                float ss = 0.f;
#pragma unroll
                for (int j = 0; j < 4; ++j) { o[r][j] = *(const f32x4*)(src + (size_t)row * D + 4 * lane + 256 * j); ss += (o[r][j].x * o[r][j].x + o[r][j].y * o[r][j].y) + (o[r][j].z * o[r][j].z + o[r][j].w * o[r][j].w); }
                const float rstd = rsqrtf(wave_sum(ss) * (1.f / D) + EPS);
#pragma unroll
                for (int j = 0; j < 4; ++j) { o[r][j] = o[r][j] * rstd * Am[j] + Bm[j];
                    u32x2 w; w.x = cvt_pk_bf16(o[r][j].x, o[r][j].y); w.y = cvt_pk_bf16(o[r][j].z, o[r][j].w);
                    *(u32x2*)(dst + (size_t)row * D + 4 * lane + 256 * j) = w; }
            }
            if (DTP) {
                float mine = 0.f;
                __builtin_amdgcn_sched_barrier(0);
#pragma unroll 1
                for (int jj = 0; jj < 16; ++jj) {
                    f32x4 wv[4];
#pragma unroll
                    for (int j = 0; j < 4; ++j) wv[j] = wl[jj * 256 + 64 * j + lane];
#pragma unroll
                    for (int r = 0; r < 4; ++r) { float p = 0.f;
#pragma unroll
                        for (int j = 0; j < 4; ++j) p += (o[r][j].x * wv[j].x + o[r][j].y * wv[j].y) + (o[r][j].z * wv[j].z + o[r][j].w * wv[j].w);
                        const float t = wave_sum(p); if (lane == r * 16 + jj) mine = t; }
                }
                const float xv = mine + dt_bias[lane & 15];
                DT[(size_t)(row0 + half * 4 + (lane >> 4)) * 16 + (lane & 15)] = xv > 20.f ? xv : log1pf(__expf(xv));
            }
        }
    }
}
__device__ __forceinline__ void final_norm_phase(float* xio, const float* nw, int lane, int wave, int G) {
    const int gw = blockIdx.x * NWAVES + wave, NGW = G * NWAVES;
    f32x4 wv[4];
#pragma unroll
    for (int j = 0; j < 4; ++j) wv[j] = *(const f32x4*)(nw + 4 * lane + 256 * j);
    for (int rg = gw; rg < M / 4; rg += NGW) {
        f32x4 v[4][4]; float ss[4];
#pragma unroll
        for (int r = 0; r < 4; ++r)
#pragma unroll
            for (int j = 0; j < 4; ++j) v[r][j] = *(const f32x4*)(xio + (size_t)(rg * 4 + r) * D + 4 * lane + 256 * j);
#pragma unroll
        for (int r = 0; r < 4; ++r) { ss[r] = 0.f;
#pragma unroll
            for (int j = 0; j < 4; ++j) ss[r] += (v[r][j].x * v[r][j].x + v[r][j].y * v[r][j].y) + (v[r][j].z * v[r][j].z + v[r][j].w * v[r][j].w); }
#pragma unroll
        for (int r = 0; r < 4; ++r) { const float rstd = rsqrtf(wave_sum(ss[r]) * (1.f / D) + EPS);
#pragma unroll
            for (int j = 0; j < 4; ++j) *(f32x4*)(xio + (size_t)(rg * 4 + r) * D + 4 * lane + 256 * j) = v[r][j] * rstd * wv[j]; }
    }
}


__device__ __forceinline__ void dt_tail(LAS unsigned char* lds, const bf16_t* Hn, const bf16_t* WDTB, const float* dt_bias, float* DT, int G, int wave, int lane) {
    const int fr = lane & 15, fq = lane >> 4, wq = wave & 3, kh = wave >> 2;
    LAS f32x4* part = (LAS f32x4*)lds;
    for (int tg0 = 0; tg0 < M / 16; tg0 += 4 * G) {
        const int tg = tg0 + wq * G + blockIdx.x; const bool act = tg < M / 16;
        const int row0 = tg * 16;
        f32x4 d = (f32x4){0.f, 0.f, 0.f, 0.f};
        if (act) {
            const bf16_t* ap = Hn + (size_t)(row0 + fr) * D + kh * 512 + fq * 8; const bf16_t* bp = WDTB + (size_t)fr * D + kh * 512 + fq * 8;
#pragma unroll
            for (int ks = 0; ks < 16; ++ks) d = __builtin_amdgcn_mfma_f32_16x16x32_bf16(*(const bf16x8*)(ap + ks * 32), *(const bf16x8*)(bp + ks * 32), d, 0, 0, 0);
        }
        __syncthreads();
        if (kh == 1) part[wq * 64 + lane] = d;
        __syncthreads();
        if (kh == 0 && act) {
            d = d + part[wq * 64 + lane];
            const float bias = dt_bias[fr];
#pragma unroll
            for (int jj = 0; jj < 4; ++jj) { const float xv = d[jj] + bias; DT[(size_t)(row0 + fq * 4 + jj) * 16 + fr] = xv > 20.f ? xv : log1pf(__expf(xv)); }
        }
    }
}

__device__ __forceinline__ void unpack8(const u32x4 v, float (&f)[8]) { f[0] = bf_lo(v.x); f[1] = bf_hi(v.x); f[2] = bf_lo(v.y); f[3] = bf_hi(v.y); f[4] = bf_lo(v.z); f[5] = bf_hi(v.z); f[6] = bf_lo(v.w); f[7] = bf_hi(v.w); }
template <int W>
__device__ __forceinline__ void diff_rows(const bf16_t* up, bf16_t* dp, int pos0) {
    u32x4 rows[W + 8];
#pragma unroll
    for (int j = 0; j < W + 8; ++j) { rows[j] = (u32x4){0u, 0u, 0u, 0u}; if (pos0 - W + j >= 0) rows[j] = *(const u32x4*)(up + (long)(j - W) * 1024); }
    float S[8];
#pragma unroll
    for (int e = 0; e < 8; ++e) S[e] = 0.f;
#pragma unroll
    for (int j = 0; j < W; ++j) { float f[8]; unpack8(rows[j], f);
#pragma unroll
        for (int e = 0; e < 8; ++e) S[e] += f[e]; }
#pragma unroll
    for (int i = 0; i < 8; ++i) {
        float f[8], q[8]; unpack8(rows[W + i], f); unpack8(rows[i], q);
#pragma unroll
        for (int e = 0; e < 8; ++e) S[e] += f[e] - q[e];
        const int pos = pos0 + i; const float inv = 1.f / (float)(pos + 1 < W ? pos + 1 : W);
        u32x4 o; o.x = cvt_pk_bf16(S[0] * inv - f[0], S[1] * inv - f[1]); o.y = cvt_pk_bf16(S[2] * inv - f[2], S[3] * inv - f[3]);
        o.z = cvt_pk_bf16(S[4] * inv - f[4], S[5] * inv - f[5]); o.w = cvt_pk_bf16(S[6] * inv - f[6], S[7] * inv - f[7]);
        *(u32x4*)(dp + (long)i * 1024) = o;
    }
}
__device__ __forceinline__ void diff_item(const bf16_t* U, bf16_t* DIFF, int item, int lane, int wave) {
    const int grp = wave & 3, oct = grp * 32 + (lane & 31), t0 = item * 32 + (wave >> 2) * 16 + (lane >> 5) * 8, pos0 = t0 & (SEQ - 1);
    const bf16_t* up = U + (size_t)t0 * 1024 + oct * 8; bf16_t* dp = DIFF + (size_t)t0 * 1024 + oct * 8;
    if (grp == 0) diff_rows<2>(up, dp, pos0); else if (grp == 1) diff_rows<4>(up, dp, pos0); else if (grp == 2) diff_rows<8>(up, dp, pos0); else diff_rows<16>(up, dp, pos0);
}

constexpr int LP = 272;
constexpr int L_C = 0, L_B = 128 * LP, L_XT = 2 * 128 * LP, L_ACS = L_XT + 4 * 64 * LP, L_DTV = L_ACS + 2048, L_NW = L_DTV + 2048, L_SSD_END = L_NW + 1024;
static_assert(L_SSD_END <= LDS_BYTES, "ssd lds");

__device__ __forceinline__ void ssd_cumsum(LAS unsigned char* lds, const float* DT, const float* a_log, int T0, int g, int lane, int wave) {
    if (wave < 4) {
        const int h = 4 * g + wave; const float av = -__expf(a_log[h]);
        const int t = 2 * lane;
        const float d0 = DT[(size_t)(T0 + t) * 16 + h], d1 = DT[(size_t)(T0 + t + 1) * 16 + h];
        const float v0 = d0 * av, v1 = d1 * av, s = v0 + v1;
        float inc = s;
#pragma unroll
        for (int o = 1; o < 64; o <<= 1) { const float n = __shfl_up(inc, o); if (lane >= o) inc += n; }
        const float exc = inc - s;
        LAS float* acs = (LAS float*)(lds + L_ACS) + wave * 128; LAS float* dtv = (LAS float*)(lds + L_DTV) + wave * 128;
        acs[t] = exc + v0; acs[t + 1] = exc + s; dtv[t] = d0; dtv[t + 1] = d1;
    }
}
template <int MODE>
__device__ __forceinline__ void ssd_stage(LAS unsigned char* lds, const bf16_t* XBC, const float* conv_w, const float* conv_b, int T0, int c, int g, int tid) {
    const LAS float* acs = (const LAS float*)(lds + L_ACS); const LAS float* dtv = (const LAS float*)(lds + L_DTV);
    constexpr int O_LO = (MODE == 0) ? 16 : 0, NO = 64 - O_LO;
#pragma unroll 1
    for (int task = tid; task < NO * 16; task += NTHREADS) {
        const int o = O_LO + task % NO, sg = task / NO;
        const int ch = (o < 16) ? (1536 + g * 128 + o * 8) : (o < 32) ? (1024 + g * 128 + (o - 16) * 8) : (g * 256 + (o - 32) * 8);
        float w[4][8], bs[8];
#pragma unroll
        for (int k = 0; k < 4; ++k) { const f32x4 w0 = *(const f32x4*)(conv_w + k * DXBC + ch), w1 = *(const f32x4*)(conv_w + k * DXBC + ch + 4);
            w[k][0] = w0.x; w[k][1] = w0.y; w[k][2] = w0.z; w[k][3] = w0.w; w[k][4] = w1.x; w[k][5] = w1.y; w[k][6] = w1.z; w[k][7] = w1.w; }
        { const f32x4 b0 = *(const f32x4*)(conv_b + ch), b1 = *(const f32x4*)(conv_b + ch + 4);
          bs[0] = b0.x; bs[1] = b0.y; bs[2] = b0.z; bs[3] = b0.w; bs[4] = b1.x; bs[5] = b1.y; bs[6] = b1.z; bs[7] = b1.w; }
        const bf16_t* src = XBC + ((size_t)(T0 + sg * 8) - 3) * DXBC + ch;
        float out[8][8];
#pragma unroll
        for (int i = 0; i < 8; ++i)
#pragma unroll
            for (int e = 0; e < 8; ++e) out[i][e] = bs[e];
#pragma unroll
        for (int rr = 0; rr < 11; ++rr) {
            const bool valid = (c * 128 + sg * 8 - 3 + rr) >= 0;
            u32x4 rv = (u32x4){0u, 0u, 0u, 0u};
            if (valid) rv = *(const u32x4*)(src + (size_t)rr * DXBC);
            float f[8]; unpack8(rv, f);
#pragma unroll
            for (int k = 0; k < 4; ++k) { const int i = rr - k;
                if (i >= 0 && i < 8) {
#pragma unroll
                    for (int e = 0; e < 8; ++e) out[i][e] += w[k][e] * f[e]; } }
        }
#pragma unroll
        for (int i = 0; i < 8; ++i)
#pragma unroll
            for (int e = 0; e < 8; ++e) out[i][e] = siluf(out[i][e]);
        if (o >= 32) {
            const int r = (o - 32) >> 3, p0 = ((o - 32) & 7) * 8;
            float sc[8];
#pragma unroll
            for (int i = 0; i < 8; ++i) { const int s = sg * 8 + i; sc[i] = dtv[r * 128 + s]; if (MODE == 0) sc[i] *= __expf(acs[r * 128 + 127] - acs[r * 128 + s]); }
#pragma unroll
            for (int e = 0; e < 8; ++e) { u32x4 v; v.x = cvt_pk_bf16(out[0][e] * sc[0], out[1][e] * sc[1]); v.y = cvt_pk_bf16(out[2][e] * sc[2], out[3][e] * sc[3]);
                v.z = cvt_pk_bf16(out[4][e] * sc[4], out[5][e] * sc[5]); v.w = cvt_pk_bf16(out[6][e] * sc[6], out[7][e] * sc[7]);
                const int pch = p0 + e, jq = pch & 31, prow = (MODE == 1) ? ((pch & ~31) + 16 * ((jq >> 2) & 1) + 4 * (jq >> 3) + (jq & 3)) : pch;
                *(LAS u32x4*)(lds + L_XT + (r * 64 + prow) * LP + sg * 16) = v; }
        } else if (MODE == 0) {
            const int n0 = (o - 16) * 8;
#pragma unroll
            for (int e = 0; e < 8; ++e) { u32x4 v; v.x = cvt_pk_bf16(out[0][e], out[1][e]); v.y = cvt_pk_bf16(out[2][e], out[3][e]); v.z = cvt_pk_bf16(out[4][e], out[5][e]); v.w = cvt_pk_bf16(out[6][e], out[7][e]);
                const int nn = n0 + e, j = nn & 31, rowp = (nn & ~31) + 16 * ((j >> 2) & 1) + 4 * (j >> 3) + (j & 3);
                *(LAS u32x4*)(lds + L_C + rowp * LP + sg * 16) = v; }
        } else {
            const int base = (o < 16) ? L_C : L_B, n0 = (o & 15) * 8;
#pragma unroll
            for (int i = 0; i < 8; ++i) { u32x4 v; v.x = cvt_pk_bf16(out[i][0], out[i][1]); v.y = cvt_pk_bf16(out[i][2], out[i][3]); v.z = cvt_pk_bf16(out[i][4], out[i][5]); v.w = cvt_pk_bf16(out[i][6], out[i][7]);
                *(LAS u32x4*)(lds + base + (sg * 8 + i) * LP + n0 * 2) = v; }
        }
    }
}
#define MFMA16(a, b, c) __builtin_amdgcn_mfma_f32_16x16x32_bf16((a), (b), (c), 0, 0, 0)
#define LFRAG(base, row, kk) (*(const LAS bf16x8*)(lds + (base) + (row) * LP + (kk) * 2))

__device__ __forceinline__ void ssd_states_item(const Args& a, LAS unsigned char* lds, int item, int tid, int lane, int wave) {
    const int g = item & 3, c = (item >> 2) & 31, b = item >> 7, T0 = b * SEQ + c * 128, fr = lane & 15, fq = lane >> 4;
    const float* DT = (const float*)(a.ws + WS_DT);
    __syncthreads();
    ssd_cumsum(lds, DT, a.in[I_ALOG], T0, g, lane, wave);
    __syncthreads();
    if (tid < 4) ((float*)(a.ws + WS_CDEC))[(b * 32 + c) * 16 + 4 * g + tid] = __expf(((const LAS float*)(lds + L_ACS))[tid * 128 + 127]);
    ssd_stage<0>(lds, (const bf16_t*)(a.ws + WS_XBC), a.in[I_CONVW], a.in[I_CONVB], T0, c, g, tid);
    __syncthreads();
    const int r = wave >> 1, p0 = (wave & 1) * 32;
    f32x4 st[2][8];
#pragma unroll
    for (int pf = 0; pf < 2; ++pf)
#pragma unroll
        for (int nf = 0; nf < 8; ++nf) st[pf][nf] = (f32x4){0.f, 0.f, 0.f, 0.f};
#pragma unroll
    for (int ks = 0; ks < 4; ++ks) {
        bf16x8 xf[2];
#pragma unroll
        for (int pf = 0; pf < 2; ++pf) xf[pf] = LFRAG(L_XT, r * 64 + p0 + pf * 16 + fr, ks * 32 + fq * 8);
#pragma unroll
        for (int nf = 0; nf < 8; ++nf) { const bf16x8 bf = LFRAG(L_C, nf * 16 + fr, ks * 32 + fq * 8);
#pragma unroll
            for (int pf = 0; pf < 2; ++pf) st[pf][nf] = MFMA16(bf, xf[pf], st[pf][nf]); }
    }
    bf16_t* SP = (bf16_t*)((unsigned char*)a.out + DO_STATES) + ((size_t)((b * 32 + c) * 16 + 4 * g + r) * 64) * 128;
#ifndef DBG_ST
#define DBG_ST 0
#endif
#if DBG_ST == 1
#pragma unroll
    for (int pf = 0; pf < 2; ++pf)
#pragma unroll
        for (int nf = 0; nf < 8; ++nf) st[pf][nf] = (f32x4){1.f, 2.f, 3.f, 4.f};
#elif DBG_ST == 2
#pragma unroll
    for (int pf = 0; pf < 2; ++pf)
#pragma unroll
        for (int nf = 0; nf < 8; ++nf) { const bf16x8 q = LFRAG(L_XT, r * 64 + p0 + pf * 16 + fr, (nf & 3) * 32 + fq * 8); st[pf][nf] = (f32x4){(float)q[0], (float)q[1], (float)q[6], (float)q[7]}; }
#elif DBG_ST == 3
#pragma unroll
    for (int pf = 0; pf < 2; ++pf)
#pragma unroll
        for (int nf = 0; nf < 8; ++nf) { const bf16x8 q = LFRAG(L_C, nf * 16 + fr, (pf * 2) * 32 + fq * 8); st[pf][nf] = (f32x4){(float)q[0], (float)q[1], (float)q[6], (float)q[7]}; }
#endif
#pragma unroll
    for (int pf = 0; pf < 2; ++pf)
#pragma unroll
        for (int q = 0; q < 4; ++q) { const f32x4 v0 = st[pf][2 * q], v1 = st[pf][2 * q + 1]; u32x4 w; w.x = cvt_pk_bf16(v0[0], v0[1]); w.y = cvt_pk_bf16(v0[2], v0[3]); w.z = cvt_pk_bf16(v1[0], v1[1]); w.w = cvt_pk_bf16(v1[2], v1[3]);
            *(u32x4*)(SP + (size_t)(p0 + pf * 16 + fr) * 128 + q * 32 + fq * 8) = w; }
}

__device__ __forceinline__ void scan_phase(const Args& a, LAS unsigned char* lds, int tid, int G) {
    bf16_t* SP = (bf16_t*)((unsigned char*)a.out + DO_STATES);
    const float* CD = (const float*)(a.ws + WS_CDEC);
    LAS float* dl = (LAS float*)lds;
    for (int tb = blockIdx.x; tb < BATCH * NHEAD * 64 * 32 / NTHREADS; tb += G) {
        const int task = tb * NTHREADS + tid;
        const int n4 = task & 31, p = (task >> 5) & 63, h = (task >> 11) & 15, b = task >> 15;
        __syncthreads();
        if (tid < 32) dl[tid] = CD[(b * 32 + tid) * 16 + h];
        u32x2* base = (u32x2*)(SP + ((size_t)((b * 32) * 16 + h) * 64 + p) * 128 + n4 * 4);
        constexpr size_t cstride = (size_t)16 * 64 * 128 / 4;
        u32x2 sv[32];
#pragma unroll
        for (int c = 0; c < 32; ++c) sv[c] = base[c * cstride];
        __syncthreads();
        asm volatile("" ::: "memory");
        float r0 = 0.f, r1 = 0.f, r2 = 0.f, r3 = 0.f;
#pragma unroll
        for (int c = 0; c < 32; ++c) {
            const float dec = dl[c];
            u32x2 o; o.x = cvt_pk_bf16(r0, r1); o.y = cvt_pk_bf16(r2, r3);
            r0 = r0 * dec + bf_lo(sv[c].x); r1 = r1 * dec + bf_hi(sv[c].x); r2 = r2 * dec + bf_lo(sv[c].y); r3 = r3 * dec + bf_hi(sv[c].y);
            base[c * cstride] = o;
        }
    }
}

__device__ __forceinline__ void ssd_out_item(const Args& a, LAS unsigned char* lds, int item, int tid, int lane, int wave) {
    const int g = item & 3, c = (item >> 2) & 31, b = item >> 7, T0 = b * SEQ + c * 128, fr = lane & 15, fq = lane >> 4;
    const float* DT = (const float*)(a.ws + WS_DT);
    const LAS float* acs = (const LAS float*)(lds + L_ACS); const LAS float* dtv = (const LAS float*)(lds + L_DTV);
    __syncthreads();
    ssd_cumsum(lds, DT, a.in[I_ALOG], T0, g, lane, wave);
    if (wave == 7) *(LAS f32x4*)(lds + L_NW + lane * 16) = *(const f32x4*)(a.in[I_SSDNW] + g * 256 + lane * 4);
    __syncthreads();
    ssd_stage<1>(lds, (const bf16_t*)(a.ws + WS_XBC), a.in[I_CONVW], a.in[I_CONVB], T0, c, g, tid);
    __syncthreads();
    const int l0 = wave * 16, l = l0 + fr;
    f32x4 sacc[8];
#pragma unroll
    for (int sf = 0; sf < 8; ++sf) sacc[sf] = (f32x4){0.f, 0.f, 0.f, 0.f};
#pragma unroll
    for (int ks = 0; ks < 4; ++ks) { const bf16x8 cf = LFRAG(L_C, l, ks * 32 + fq * 8);
#pragma unroll
        for (int sf = 0; sf < 8; ++sf) { const bf16x8 bf = LFRAG(L_B, sf * 16 + fr, ks * 32 + fq * 8); sacc[sf] = MFMA16(bf, cf, sacc[sf]); } }
    __syncthreads();
    const int L_M = L_B + wave * 16 * LP;
    const bf16_t* PV = (const bf16_t*)((const unsigned char*)a.out + DO_STATES) + ((size_t)((b * 32 + c) * 16 + 4 * g) * 64) * 128;
    f32x4 y[4][4];
#pragma unroll
    for (int r = 0; r < 4; ++r) {
        const float al = acs[r * 128 + l];
#pragma unroll
        for (int pf = 0; pf < 4; ++pf) y[r][pf] = (f32x4){0.f, 0.f, 0.f, 0.f};
#pragma unroll
        for (int ks = 0; ks < 4; ++ks) {
            const bf16x8 cf = LFRAG(L_C, l, ks * 32 + fq * 8);
#pragma unroll
            for (int pf = 0; pf < 4; ++pf) {
                const bf16x8 pv = *(const bf16x8*)(PV + (size_t)(r * 64 + 32 * (pf >> 1) + 8 * (fr >> 2) + 4 * (pf & 1) + (fr & 3)) * 128 + ks * 32 + fq * 8);
                y[r][pf] = MFMA16(pv, cf, y[r][pf]);
            }
        }
        const float sd = __expf(al);
#pragma unroll
        for (int pf = 0; pf < 4; ++pf) y[r][pf] = y[r][pf] * sd;
#pragma unroll
        for (int sf = 0; sf < 8; ++sf) { const f32x4 as = *(const LAS f32x4*)(acs + r * 128 + sf * 16 + fq * 4); float mv[4];
#pragma unroll
            for (int jj = 0; jj < 4; ++jj) { const int s = sf * 16 + fq * 4 + jj; mv[jj] = (s <= l) ? sacc[sf][jj] * __expf(fminf(al - as[jj], 0.f)) : 0.f; }
            u32x2 w; w.x = cvt_pk_bf16(mv[0], mv[1]); w.y = cvt_pk_bf16(mv[2], mv[3]);
            *(LAS u32x2*)(lds + L_M + fr * LP + (sf * 16 + fq * 4) * 2) = w; }
        asm volatile("" ::: "memory");
#pragma unroll
        for (int ks = 0; ks < 4; ++ks) {
            const bf16x8 mf = LFRAG(L_M, fr, ks * 32 + fq * 8);
#pragma unroll
            for (int pf = 0; pf < 4; ++pf) {
                const bf16x8 xf = LFRAG(L_XT, r * 64 + pf * 16 + fr, ks * 32 + fq * 8);
                y[r][pf] = MFMA16(xf, mf, y[r][pf]);
            }
        }
        asm volatile("" ::: "memory");
    }
    const size_t tok = (size_t)(T0 + l);
    const bf16_t* Zp = (const bf16_t*)(a.ws + WS_Z) + tok * 1024 + g * 256;
    float ssq = 0.f;
#pragma unroll
    for (int r = 0; r < 4; ++r) {
        const float dsk = a.in[I_DSKIP][4 * g + r] / dtv[r * 128 + l];
#pragma unroll
        for (int q = 0; q < 2; ++q) {
            const u32x4 zz = *(const u32x4*)(Zp + r * 64 + 32 * q + 8 * fq);
            const float zf[8] = {bf_lo(zz.x), bf_hi(zz.x), bf_lo(zz.y), bf_hi(zz.y), bf_lo(zz.z), bf_hi(zz.z), bf_lo(zz.w), bf_hi(zz.w)};
#pragma unroll
            for (int h2 = 0; h2 < 2; ++h2) { const int pf = 2 * q + h2;
#pragma unroll
                for (int jj = 0; jj < 4; ++jj) {
                    const float xdt = __uint_as_float((unsigned)(*(const LAS bf16_t*)(lds + L_XT + (r * 64 + pf * 16 + fq * 4 + jj) * LP + l * 2)) << 16);
                    const float v = (y[r][pf][jj] + dsk * xdt) * siluf(zf[h2 * 4 + jj]);
                    y[r][pf][jj] = v; ssq += v * v;
                } }
        }
    }
    ssq += __shfl_xor(ssq, 16); ssq += __shfl_xor(ssq, 32);
    const float rstd = rsqrtf(ssq * (1.f / 256.f) + EPS);
    bf16_t* Yp = (bf16_t*)(a.ws + WS_U) + tok * 1024 + g * 256;
#pragma unroll
    for (int r = 0; r < 4; ++r)
#pragma unroll
        for (int q = 0; q < 2; ++q) { const int ch = r * 64 + 32 * q + 8 * fq; const f32x4 n0 = *(const LAS f32x4*)(lds + L_NW + ch * 4), n1 = *(const LAS f32x4*)(lds + L_NW + (ch + 4) * 4);
            const f32x4 v0 = y[r][2 * q], v1 = y[r][2 * q + 1];
            u32x4 w; w.x = cvt_pk_bf16(v0[0] * rstd * n0.x, v0[1] * rstd * n0.y); w.y = cvt_pk_bf16(v0[2] * rstd * n0.z, v0[3] * rstd * n0.w);
            w.z = cvt_pk_bf16(v1[0] * rstd * n1.x, v1[1] * rstd * n1.y); w.w = cvt_pk_bf16(v1[2] * rstd * n1.z, v1[3] * rstd * n1.w);
            *(u32x4*)(Yp + ch) = w; }
}


#define XB_TMO      128
#define XB_XCNT(j)  (256  + 64 * (j))
#define XB_XSUB(j)  (1280 + 64 * (j))
#define XB_XGEN(j)  (2304 + 64 * (j))
#define XB_TOP      3328
#define XB_TOPGEN   3392
#define XCD_BAR_WORDS 3456
#define XB_SPIN_CAP (1u << 18)
__device__ __forceinline__ unsigned xb_ld(unsigned* p)              { return __hip_atomic_load(p, __ATOMIC_RELAXED, __HIP_MEMORY_SCOPE_AGENT); }
__device__ __forceinline__ unsigned xb_add(unsigned* p, unsigned v) { return __hip_atomic_fetch_add(p, v, __ATOMIC_RELAXED, __HIP_MEMORY_SCOPE_AGENT); }
__device__ __forceinline__ unsigned xb_xcc_id() { return (unsigned)__builtin_amdgcn_s_getreg((3 << 11) | 20) & 0xFu; }
#define XB_SPIN(cond, bar) do { unsigned _sp = 0; while (cond) { __builtin_amdgcn_s_sleep(1); \
    if ((++_sp & 255u) == 0u) { if (xb_ld(&(bar)[XB_TMO])) break; if (_sp > XB_SPIN_CAP) { atomicAdd(&(bar)[XB_TMO], 1u); break; } } } } while (0)
struct XcdBarrier { unsigned* bar; unsigned x; volatile LAS unsigned* st; };
__device__ __forceinline__ XcdBarrier xcd_barrier_post(unsigned* bar, volatile LAS unsigned* st) {
    XcdBarrier b; b.bar = bar; b.x = xb_xcc_id(); b.st = st;
    if (threadIdx.x == 0) (void)xb_add(&bar[XB_XCNT(b.x)], 1u);
    return b;
}
__device__ __forceinline__ void xcd_barrier_complete(unsigned* bar, unsigned x, unsigned& nloc, unsigned& nx) {
    const unsigned G = gridDim.x * gridDim.y * gridDim.z;
    unsigned sum, cnt, mine, sp = 0u;
    for (;;) {
        sum = 0u; cnt = 0u; mine = 0u;
#pragma unroll
        for (unsigned j = 0; j < 16; ++j) { const unsigned c = xb_ld(&bar[XB_XCNT(j)]); sum += c; cnt += (c > 0u) ? 1u : 0u; mine = (j == x) ? c : mine; }
        if (sum == G) break;
        __builtin_amdgcn_s_sleep(1);
        if ((++sp & 255u) == 0u) { if (xb_ld(&bar[XB_TMO])) break; if (sp > XB_SPIN_CAP) { atomicAdd(&bar[XB_TMO], 1u); break; } }
    }
    nloc = mine > 0u ? mine : 1u; nx = cnt > 0u ? cnt : 1u;
}
__device__ __forceinline__ void xcd_barrier(const XcdBarrier& b) {
    asm volatile("s_waitcnt vmcnt(0)" ::: "memory");
    __syncthreads();
    if (threadIdx.x == 0) {
        unsigned* bar = b.bar;
        __builtin_amdgcn_s_waitcnt(0);
        unsigned nloc = b.st[0], nx = b.st[1];
        if (nloc == 0u) { xcd_barrier_complete(bar, b.x, nloc, nx); b.st[0] = nloc; b.st[1] = nx; }
        const unsigned old = xb_add(&bar[XB_XSUB(b.x)], 1u);
        const unsigned gen = old / nloc;
        if (old + 1u == (gen + 1u) * nloc) {
            __builtin_amdgcn_fence(__ATOMIC_RELEASE, "agent");
            asm volatile("s_waitcnt vmcnt(0)" ::: "memory");
            const unsigned og = xb_add(&bar[XB_TOP], 1u);
            const unsigned tg = og / nx;
            if (og + 1u == (tg + 1u) * nx) xb_add(&bar[XB_TOPGEN], 1u);
            else XB_SPIN(xb_ld(&bar[XB_TOPGEN]) == tg, bar);
            __builtin_amdgcn_fence(__ATOMIC_ACQUIRE, "agent");
            xb_add(&bar[XB_XGEN(b.x)], 1u);
            asm volatile("s_waitcnt vmcnt(0)" ::: "memory");
        } else {
            XB_SPIN(xb_ld(&bar[XB_XGEN(b.x)]) == gen, bar);
            __builtin_amdgcn_fence(__ATOMIC_ACQUIRE, "agent");
            asm volatile("s_waitcnt vmcnt(0)" ::: "memory");
        }
    }
    __syncthreads();
}

__global__ void __launch_bounds__(NTHREADS, 2) fwd_megakernel(Args a) {
    extern __shared__ __attribute__((aligned(16))) unsigned char lds_raw[];
    LAS unsigned char* lds = (LAS unsigned char*)lds_raw;
    cg::grid_group grid = cg::this_grid();
    const int G = gridDim.x;
#define PH_IDS() int tid = threadIdx.x; asm volatile("" : "+v"(tid)); const int lane = tid & 63, wave = __builtin_amdgcn_readfirstlane(tid >> 6); (void)lane; (void)wave
    unsigned char* ws = a.ws;
    const float* mod = (const float*)(ws + WS_MOD);
    bf16_t* H = (bf16_t*)((unsigned char*)a.out + DO_H);
    bf16_t* XRB = (bf16_t*)(ws + WS_XR);
    const int lo = a.ph_lo, hi = a.ph_hi;
#ifndef ONLYPH
#define ONLYPH -1
#endif
#define IN(k) ((ONLYPH < 0 || ONLYPH == (k)) && lo <= (k) && (k) < hi)
    volatile LAS unsigned* bst = (volatile LAS unsigned*)(lds + LDS_BYTES - 64);
    if (threadIdx.x < 16) bst[threadIdx.x] = 0u;
    __syncthreads();
    XcdBarrier xbar = xcd_barrier_post((unsigned*)(ws + WS_BAR), bst);
    if (a.ph_hi > 1000) grid.sync();
#ifndef PROBE_PH
#define PROBE_PH -1
#endif
    volatile LAS unsigned long long* stamps = (volatile LAS unsigned long long*)(lds + LDS_BYTES - 512);
    int nstamp = 0;
#define STAMP() do { if (PROBE_PH >= 0 && threadIdx.x == 0) stamps[nstamp] = __builtin_amdgcn_s_memrealtime(); ++nstamp; } while (0)
    STAMP();
#ifdef SUB5
#define SUB5STAMP() STAMP()
#else
#define SUB5STAMP() do {} while (0)
#endif
#ifdef SUBPROBE
#define SUBSTAMP() STAMP()
#else
#define SUBSTAMP() do {} while (0)
#endif
#define SEAM(k) do { if (IN(k) && IN((k) + 1)) xcd_barrier(xbar); STAMP(); } while (0)
#ifndef DUP_MASK
#define DUP_MASK 0
#endif
#define REP(k) for (int rep_ = 0; rep_ < (((DUP_MASK >> (k)) & 1) ? 2 : 1); ++rep_, (rep_ < (((DUP_MASK >> (k)) & 1) ? 2 : 1) ? xcd_barrier(xbar) : (void)0))

    if (IN(0)) REP(0) { PH_IDS(); p0_phase(a, lds, tid, lane, wave, G, 1); SUBSTAMP(); p0_phase(a, lds, tid, lane, wave, G, 2); SUBSTAMP(); p0_phase(a, lds, tid, lane, wave, G, 4); SUBSTAMP();
        norm_phase<false>(lds, a.in[I_X], a.in[I_N1], mod, 0 * D, 1 * D, H, nullptr, nullptr, nullptr, tid, lane, wave, G); }
    SEAM(0);
    if (IN(2)) REP(2) { pg8::Gemm g{H, H, (const bf16_t*)(ws + WS_WGU1), M, 2 * FF, D, D, D, 1 << 30, 0}; pg8::StaticOrder S; S.init(M, 2 * FF, G, blockIdx.x, WGM_FF);
        pg8::EpiSwiGLU E{(bf16_t*)(ws + WS_ACT)}; pg8::gemm_phase(lds, g, S, E);
        { const int nidle = G - (S.nwg % G); PH_IDS();
          if ((S.nwg % G) != 0 && (int)blockIdx.x >= G - nidle) p0_transposes(a, lds, 1, ((int)blockIdx.x - (G - nidle)) * NWAVES + wave, nidle * NWAVES, lane, wave);
          else if ((S.nwg % G) == 0) p0_transposes(a, lds, 1, blockIdx.x * NWAVES + wave, G * NWAVES, lane, wave); } }
    SEAM(2);
    if (IN(3)) REP(3) { pg8::Gemm g{(const bf16_t*)(ws + WS_ACT), (const bf16_t*)(ws + WS_ACT), (const bf16_t*)(ws + WS_WD1), M, D, FF, FF, FF, 1 << 30, 0}; pg8::StaticOrder S; S.init(M, D, G, blockIdx.x, WGM_N1K);
        pg8::EpiResidNorm<true, false> E{a.in[I_X], XRB, mod + 2 * D, a.in[I_NMIX], mod + 3 * D, mod + 4 * D, H, nullptr, (float*)(ws + WS_SSQ), (unsigned*)(ws + WS_CNT), nullptr}; pg8::gemm_phase(lds, g, S, E); }
    SEAM(3);
    if (IN(5)) REP(5) { pg8::Gemm g{H, H, (const bf16_t*)(ws + WS_WIN), M, NPROJ, D, D, D, 1 << 30, 0}; pg8::StaticOrder S; S.init(M, NPROJ, G, blockIdx.x, WGM_IN);
        pg8::EpiSplit E{(bf16_t*)(ws + WS_Z), (bf16_t*)(ws + WS_XBC), (bf16_t*)(ws + WS_U)}; pg8::gemm_phase(lds, g, S, E); SUB5STAMP();
        { PH_IDS(); dt_tail(lds, H, (const bf16_t*)(ws + WS_WDT), a.in[I_DTB], (float*)(ws + WS_DT), G, wave, lane); } }
    SEAM(5);
    if (IN(6)) REP(6) { PH_IDS();
        for (int it = blockIdx.x; it < BATCH * NCHUNK * 4; it += G) ssd_states_item(a, lds, it, tid, lane, wave);
        for (int it = blockIdx.x; it < M / 32; it += G) diff_item((const bf16_t*)(ws + WS_U), H, it, lane, wave);
    }
    SEAM(6);
    if (IN(7)) REP(7) { PH_IDS();
        scan_phase(a, lds, tid, G);
        __syncthreads();
        {
        pg8::Gemm g{(const bf16_t*)(ws + WS_WOUT) + 1024, (const bf16_t*)(ws + WS_WOUT) + 1024, (const bf16_t*)(ws + WS_WPOOL), 1024, 1024, 256, 2048, 256, 1 << 30, 256}; pg8::StaticOrder S; S.init(1024, 1024, G, blockIdx.x);
        pg8::EpiFold E{(bf16_t*)(ws + WS_WOUT)}; pg8::gemm_phase(lds, g, S, E);
        }
    }
    SEAM(7);
    if (IN(8)) REP(8) { PH_IDS(); for (int it = blockIdx.x; it < BATCH * NCHUNK * 4; it += G) ssd_out_item(a, lds, it, tid, lane, wave); }
    SEAM(8);
    if (IN(9)) REP(9) { __syncthreads();
        pg8::Gemm g{(const bf16_t*)(ws + WS_U), H, (const bf16_t*)(ws + WS_WOUT), M, D, 2048, 1024, 2048, 16, 0}; pg8::StaticOrder S; S.init(M, D, G, blockIdx.x, WGM_N1K);
        pg8::EpiResidNorm<false, true> E{XRB, XRB, mod + 5 * D, a.in[I_N2], mod + 6 * D, mod + 7 * D, H, nullptr, (float*)(ws + WS_SSQ) + 1 * M * 4, (unsigned*)(ws + WS_CNT) + 1 * 64 * 64, (const float*)(ws + WS_BVEC)}; pg8::gemm_phase(lds, g, S, E); }
    SEAM(9);
    if (IN(11)) REP(11) { pg8::Gemm g{H, H, (const bf16_t*)(ws + WS_WGU2), M, 2 * FF, D, D, D, 1 << 30, 0}; pg8::StaticOrder S; S.init(M, 2 * FF, G, blockIdx.x, WGM_FF);
        pg8::EpiSwiGLU E{(bf16_t*)(ws + WS_ACT)}; pg8::gemm_phase(lds, g, S, E); }
    SEAM(11);
    if (IN(12)) REP(12) { pg8::Gemm g{(const bf16_t*)(ws + WS_ACT), (const bf16_t*)(ws + WS_ACT), (const bf16_t*)(ws + WS_WD2), M, D, FF, FF, FF, 1 << 30, 0}; pg8::StaticOrder S; S.init(M, D, G, blockIdx.x, WGM_N1K);
        pg8::EpiResidNorm<true, true> E{XRB, nullptr, mod + 8 * D, a.in[I_NF], nullptr, nullptr, nullptr, a.out, (float*)(ws + WS_SSQ) + 2 * M * 4, (unsigned*)(ws + WS_CNT) + 2 * 64 * 64, nullptr}; pg8::gemm_phase(lds, g, S, E); }
    STAMP();
    if (PROBE_PH >= 0 && blockIdx.x == 0 && threadIdx.x == 0) {
        const unsigned long long span = stamps[PROBE_PH + 1] - stamps[PROBE_PH], t0 = __builtin_amdgcn_s_memrealtime();
        while (__builtin_amdgcn_s_memrealtime() - t0 < 4ull * span) __builtin_amdgcn_s_sleep(8);
    }
#undef IN
#undef SEAM
}


#ifndef DBG_K
#define DBG_K -1
#endif
__global__ void dbg_dump(float* out, const void* src, int mode, int nch) {
    for (size_t i = (size_t)blockIdx.x * blockDim.x + threadIdx.x; i < (size_t)M * 1024; i += (size_t)gridDim.x * blockDim.x) {
        float v = 0.f;
        if (mode == 0) v = ((const float*)src)[i];
        else if (mode == 2) v = __uint_as_float((unsigned)((const bf16_t*)src)[i + (size_t)M * 1024] << 16);
        else for (int j = 0; j < nch; ++j) v += __uint_as_float((unsigned)((const bf16_t*)src)[i + (size_t)j * M * 1024] << 16);
        out[i] = v;
    }
}
extern "C" void kernel_launch(void* const* d_in, const int* in_sizes, int n_in, void* d_out, int out_size, void* d_ws, size_t ws_size, hipStream_t stream) {
    static int grid_blocks = 0;
    if (grid_blocks == 0) {
        int dev = 0, cus = 0, per_cu = 0;
        (void)hipGetDevice(&dev);
        (void)hipDeviceGetAttribute(&cus, hipDeviceAttributeMultiprocessorCount, dev);
        if (hipFuncSetAttribute((const void*)fwd_megakernel, hipFuncAttributeMaxDynamicSharedMemorySize, LDS_BYTES) != hipSuccess) { fprintf(stderr, "hipFuncSetAttribute failed\n"); grid_blocks = -1; return; }
        if (hipOccupancyMaxActiveBlocksPerMultiprocessor(&per_cu, (const void*)fwd_megakernel, NTHREADS, LDS_BYTES) != hipSuccess || per_cu < 1) { fprintf(stderr, "occupancy query: %d blocks/CU\n", per_cu); grid_blocks = -1; return; }
        grid_blocks = cus;
        if (n_in != 25 || ws_size < WS_END) { fprintf(stderr, "unexpected problem: n_in %d ws %zu\n", n_in, ws_size); grid_blocks = -1; return; }
    }
    if (grid_blocks < 0) return;
    Args a{};
    for (int i = 0; i < 25; ++i) a.in[i] = (const float*)d_in[i];
    a.out = (float*)d_out; a.ws = (unsigned char*)d_ws;
    static_assert(WS_MOD + 144 * KiB == WS_BAR, "mod + barrier words are one memset");
    (void)hipMemsetAsync((unsigned char*)d_ws + WS_MOD, 0, 144 * KiB + BAR_BYTES, stream);
#ifndef MK_PER_PHASE
#define MK_PER_PHASE 0
#endif
#if MK_PER_PHASE
    const int kmax = (DBG_K >= 0) ? DBG_K : 13;
    for (int k = 0; k <= kmax; ++k) { a.ph_lo = k; a.ph_hi = k + 1; hipLaunchKernelGGL(fwd_megakernel, dim3(grid_blocks), dim3(NTHREADS), LDS_BYTES, stream, a); }
    if (DBG_K >= 0) {
        const unsigned char* ws = (const unsigned char*)d_ws; const void* src = ws + WS_XR; int mode = 0, nch = 1;
        if (DBG_K == 5) { src = ws + WS_Z; mode = 1; nch = 4; }
        if (DBG_K == 2) { src = ws + WS_ACT; mode = 1; nch = 2; }
        if (DBG_K == 6) { src = (const unsigned char*)d_out; mode = 2; nch = 1; }
        if (DBG_K == 7) { src = ws + WS_YPOOL; mode = 1; nch = 1; }
        if (DBG_K == 8) { src = d_out; mode = 1; nch = 1; }
        if (DBG_K == 1) { src = d_out; mode = 1; nch = 1; }
        if (DBG_K == 4) { src = ws + WS_DT; mode = 0; nch = 1; }
        if (src == (const void*)d_out) { (void)hipMemcpyAsync((unsigned char*)d_ws + WS_XR, d_out, 64 * MiB, hipMemcpyDeviceToDevice, stream); src = ws + WS_XR; }
        hipLaunchKernelGGL(dbg_dump, dim3(2048), dim3(256), 0, stream, (float*)d_out, src, mode, nch);
    }
#else
    a.ph_lo = 0; a.ph_hi = 14;
    void* args[] = {&a};
    hipError_t e = hipLaunchCooperativeKernel((const void*)fwd_megakernel, dim3(grid_blocks), dim3(NTHREADS), args, LDS_BYTES, stream);
    if (e != hipSuccess) fprintf(stderr, "cooperative launch failed: %s (grid %d)\n", hipGetErrorString(e), grid_blocks);
#endif
}
```

```cpp
#include <hip/hip_runtime.h>
#include <hip/hip_cooperative_groups.h>
#include <cstdio>
namespace cg = cooperative_groups;

#define LAS __attribute__((address_space(3)))
typedef unsigned short bf16_t;
typedef short bf16x8 __attribute__((ext_vector_type(8)));
typedef float f32x4 __attribute__((ext_vector_type(4)));
typedef float f32x2 __attribute__((ext_vector_type(2)));
typedef unsigned u32x4 __attribute__((ext_vector_type(4)));
typedef unsigned u32x2 __attribute__((ext_vector_type(2)));

constexpr int BATCH = 4, SEQ = 4096, D = 1024, M = BATCH * SEQ, FF = 2816, NPROJ = 4096, DINP = 4112, DXBC = 2048, NMOD = 9 * D;
constexpr int NCHUNK = 32, NHEAD = 16;
constexpr float EPS = 1e-6f;
constexpr int NWAVES = 8, NTHREADS = 512;
#ifndef WGM_FF
#define WGM_FF 7
#endif
#ifndef WGM_IN
#define WGM_IN 6
#endif
#ifndef WGM_N1K
#define WGM_N1K 4
#endif
constexpr int LDS_BYTES = 147456;

constexpr size_t KiB = 1024, MiB = 1u << 20;
constexpr size_t WS_MOD = 0, WS_CDEC = 256 * KiB, WS_WDT = 512 * KiB, WS_BAR = 768 * KiB, BAR_BYTES = 128 * KiB, WS_CNT = WS_BAR + 16 * KiB, WS_BVEC = WS_BAR + 96 * KiB, WS_SSQ = 1 * MiB, WS_DT = 2 * MiB;
constexpr size_t WS_WPOOL = 4 * MiB, WS_WOUT = WS_WPOOL + MiB / 2, WS_WGU2 = WS_WOUT + 4 * MiB, WS_WD2 = WS_WGU2 + 11 * MiB, WS_WGU1 = WS_WD2 + 11 * MiB / 2,
                 WS_WD1 = WS_WGU1 + 11 * MiB, WS_WIN = WS_WD1 + 11 * MiB / 2, WS_XR = WS_WIN + 8 * MiB, WS_R2 = WS_XR + 64 * MiB;
constexpr size_t WS_ACT = WS_R2, WS_Z = WS_R2, WS_XBC = WS_R2 + 32 * MiB, WS_U = WS_R2 + 96 * MiB, WS_YPOOL = WS_U, WS_END = WS_U + 32 * MiB;
static_assert(WS_END <= 256 * MiB, "ws map");
static_assert(WS_ACT + (size_t)M * FF * 2 <= 256 * MiB, "ws map act");
constexpr size_t DO_H = 0, DO_STATES = 32 * MiB;

__device__ __forceinline__ float wave_sum(float v) {
#pragma unroll
    for (int o = 1; o < 64; o <<= 1) v += __shfl_xor(v, o);
    return v;
}
typedef __bf16 bf16x2_t __attribute__((ext_vector_type(2)));
__device__ __forceinline__ unsigned cvt_pk_bf16(float lo, float hi) { f32x2 v = {lo, hi}; bf16x2_t r = __builtin_convertvector(v, bf16x2_t); return __builtin_bit_cast(unsigned, r); }
__device__ __forceinline__ float bf_lo(unsigned u) { return __uint_as_float(u << 16); }
__device__ __forceinline__ float bf_hi(unsigned u) { return __uint_as_float(u & 0xffff0000u); }
__device__ __forceinline__ float siluf(float x) { return x * __builtin_amdgcn_rcpf(1.f + __builtin_amdgcn_exp2f(-1.44269504f * x)); }
#define LDS_WAIT() asm volatile("s_waitcnt lgkmcnt(0)" ::: "memory")

namespace pg8 {
constexpr int BM = 256, BK = 64, HALF = 128, HTB = HALF * BK * 2, STAGE_BYTES = 8 * HTB, NXCD = 8, WGM = 8;
__device__ __forceinline__ int lds_byte(int r, int c) { const int st = (r >> 4) * 2 + (c >> 5), rr = r & 15, cc = c & 31, ob = rr * 64 + cc * 2; return st * 1024 + (ob ^ (((ob >> 9) & 1) << 5)); }
__device__ __forceinline__ void stage_rc(int b, int& R, int& C) { const int st = b / 1024, sb = b % 1024, swz = sb ^ (((sb >> 9) & 1) << 5); R = (st >> 1) * 16 + swz / 64; C = (st & 1) * 32 + (swz % 64) / 2; }
struct Unit { int pm, pn; };
struct Gemm { const bf16_t* A; const bf16_t* A2; const bf16_t* Bt; int M, N, K, lda, ldb, ksplit, a_pn_off; };
struct StaticOrder {
    int nM, nN, nwg, G, c, wgm;
    __device__ void init(int M_, int N_, int G_, int c_, int wgm_ = WGM) { nM = M_ / BM; nN = N_ / BM; nwg = nM * nN; G = G_; c = c_; wgm = wgm_; }
    __device__ bool next(int i, Unit& u) const {
        const long L = (long)i * G + c; if (L >= nwg) return false;
        int wgid = (int)L; { const int q = nwg / NXCD, r = nwg % NXCD, xcd = wgid % NXCD, off = wgid / NXCD; wgid = (xcd < r ? xcd * (q + 1) : r * (q + 1) + (xcd - r) * q) + off; }
        const int nig = wgm * nN, gid = wgid / nig, fm = gid * wgm, gsz = (nM - fm) < wgm ? (nM - fm) : wgm;
        u.pm = fm + ((wgid % nig) % gsz); u.pn = (wgid % nig) / gsz; return true;
    }
};
template <class Epi>
__device__ __forceinline__ void gemm_phase(LAS unsigned char* lds, const Gemm g, const StaticOrder& S, const Epi& E) {
    int tid = threadIdx.x; asm volatile("" : "+v"(tid));
    const int wid = __builtin_amdgcn_readfirstlane(tid >> 6), lane = tid & 63, wr = wid >> 2, wc = wid & 3, fr = lane & 15, fq = lane >> 4;
    int nt = g.K / BK, ksplit = g.ksplit;
    asm volatile("" : "+s"(nt), "+s"(ksplit));
    unsigned voffA[2], voffB[2];
#pragma unroll
    for (int i = 0; i < 2; ++i) { int R, C; stage_rc(tid * 16 + i * 8192, R, C); voffA[i] = (unsigned)(R * g.lda + C) * 2u; voffB[i] = (unsigned)(R * g.ldb + C) * 2u; }
    const size_t kstep = (size_t)(BK * 2);
    const size_t hstepA = (size_t)HALF * g.lda * 2, hstepB = (size_t)HALF * g.ldb * 2;
    const size_t tstepA = 2 * hstepA, tstepB = 2 * hstepB;
    const unsigned ldsw = (unsigned)wid * 1024u;
    const int aoff = lds_byte(wr * 64 + fr, fq * 8), boff = lds_byte(wc * 32 + fr, fq * 8);
#define PG8_SA(b, h) (((b) * 2 + (h)) * HTB)
#define PG8_SB(b, h) ((4 + (b) * 2 + (h)) * HTB)
#define PG8_STAGE(bufoff, gbase, voff) do { _Pragma("unroll") for (int _i = 0; _i < 2; ++_i) \
        __builtin_amdgcn_global_load_lds((const unsigned*)((const char*)(gbase) + (voff)[_i]), (LAS unsigned*)(lds + (bufoff) + ldsw + _i * 8192), 16, 0, 0); } while (0)
#define PG8_LDA(dst, b, h) do { _Pragma("unroll") for (int m = 0; m < 4; ++m) _Pragma("unroll") for (int k = 0; k < 2; ++k) dst[m][k] = *(const LAS bf16x8*)(lds + PG8_SA(b, h) + aoff + m * 2048 + k * 1024); } while (0)
#define PG8_LDB(dst, b, h) do { _Pragma("unroll") for (int n = 0; n < 2; ++n) _Pragma("unroll") for (int k = 0; k < 2; ++k) dst[n][k] = *(const LAS bf16x8*)(lds + PG8_SB(b, h) + boff + n * 2048 + k * 1024); } while (0)
#define PG8_MMA(ai, bj, At, Bt) do { __builtin_amdgcn_s_setprio(1); _Pragma("unroll") for (int m = 0; m < 4; ++m) _Pragma("unroll") for (int n = 0; n < 2; ++n) _Pragma("unroll") for (int k = 0; k < 2; ++k) \
        acc[ai][bj][m][n] = __builtin_amdgcn_mfma_f32_16x16x32_bf16(Bt[n][k], At[m][k], acc[ai][bj][m][n], 0, 0, 0); __builtin_amdgcn_s_setprio(0); } while (0)
#define PG8_WAIT_V(n) asm volatile("s_waitcnt vmcnt(" #n ")" ::: "memory")
#define PG8_WAIT_L(n) asm volatile("s_waitcnt lgkmcnt(" #n ")" ::: "memory")
#define PG8_BAR __builtin_amdgcn_s_barrier()
#define PG8_SCHED __builtin_amdgcn_sched_barrier(0)
#define PG8_TILEA(c1, c2, t) ((t) < ksplit ? (c1) + (size_t)(t) * kstep : (c2) + (size_t)((t) - ksplit) * kstep)
    Unit cur, nxt; int ui = 0;
    if (!S.next(0, cur)) return;
    f32x4 acc[2][2][4][2];
#pragma unroll
    for (int a = 0; a < 2; ++a)
#pragma unroll
        for (int b = 0; b < 2; ++b)
#pragma unroll
            for (int m = 0; m < 4; ++m)
#pragma unroll
                for (int n = 0; n < 2; ++n) acc[a][b][m][n] = (f32x4){0.f, 0.f, 0.f, 0.f};
    bf16x8 At[4][2], B0[2][2], B1[2][2];
    const char* cA = (const char*)g.A + (size_t)cur.pm * tstepA + (size_t)cur.pn * g.a_pn_off * 2;
    const char* cA2 = (const char*)g.A2 + (size_t)cur.pm * tstepA + (size_t)cur.pn * g.a_pn_off * 2;
    const char* cB = (const char*)g.Bt + (size_t)cur.pn * tstepB;
    PG8_STAGE(PG8_SB(0, 0), cB, voffB); PG8_STAGE(PG8_SA(0, 0), cA, voffA); PG8_STAGE(PG8_SB(0, 1), cB + hstepB, voffB); PG8_STAGE(PG8_SA(0, 1), cA + hstepA, voffA);
    if (wr == 1) PG8_BAR;
    PG8_WAIT_V(4); PG8_BAR;
    PG8_STAGE(PG8_SB(1, 0), cB + kstep, voffB); PG8_STAGE(PG8_SA(1, 0), cA + kstep, voffA); PG8_STAGE(PG8_SB(1, 1), cB + hstepB + kstep, voffB);
    PG8_WAIT_V(6); PG8_BAR;
    for (;;) {
        const bool has_next = S.next(ui + 1, nxt);
        const char* nA = has_next ? (const char*)g.A + (size_t)nxt.pm * tstepA + (size_t)nxt.pn * g.a_pn_off * 2 : cA;
        const char* nA2 = has_next ? (const char*)g.A2 + (size_t)nxt.pm * tstepA + (size_t)nxt.pn * g.a_pn_off * 2 : cA2;
        const char* nB = has_next ? (const char*)g.Bt + (size_t)nxt.pn * tstepB : cB;
        for (int t = 0; t < nt; t += 2) {
            const bool last = (t == nt - 2);
            const char* a1 = PG8_TILEA(cA, cA2, t + 1);
            const char* a2 = last ? nA : PG8_TILEA(cA, cA2, t + 2); const char* b2 = last ? nB : cB + (size_t)(t + 2) * kstep;
            const char* a3 = a2 + kstep; const char* b3 = b2 + kstep;
            PG8_LDB(B0, 0, 0); PG8_SCHED; PG8_LDA(At, 0, 0); PG8_STAGE(PG8_SA(1, 1), a1 + hstepA, voffA);
            PG8_WAIT_L(8); PG8_BAR; PG8_WAIT_L(0); PG8_MMA(0, 0, At, B0); PG8_BAR; PG8_SCHED;
            PG8_LDB(B1, 0, 1); PG8_STAGE(PG8_SB(0, 0), b2, voffB);
            PG8_BAR; PG8_WAIT_L(0); PG8_MMA(0, 1, At, B1); PG8_BAR;
            PG8_LDA(At, 0, 1); PG8_STAGE(PG8_SA(0, 0), a2, voffA);
            PG8_BAR; PG8_WAIT_L(0); PG8_MMA(1, 0, At, B0); PG8_BAR; PG8_SCHED;
            PG8_STAGE(PG8_SB(0, 1), b2 + hstepB, voffB);
            PG8_WAIT_V(6); PG8_BAR; PG8_MMA(1, 1, At, B1); PG8_BAR;
            PG8_LDB(B0, 1, 0); PG8_SCHED; PG8_LDA(At, 1, 0); PG8_STAGE(PG8_SA(0, 1), a2 + hstepA, voffA);
            PG8_WAIT_L(8); PG8_BAR; PG8_WAIT_L(0); PG8_MMA(0, 0, At, B0); PG8_BAR; PG8_SCHED;
            PG8_LDB(B1, 1, 1); PG8_STAGE(PG8_SB(1, 0), b3, voffB);
            PG8_BAR; PG8_WAIT_L(0); PG8_MMA(0, 1, At, B1); PG8_BAR;
            PG8_LDA(At, 1, 1); PG8_STAGE(PG8_SA(1, 0), a3, voffA);
            PG8_BAR; PG8_WAIT_L(0); PG8_MMA(1, 0, At, B0); PG8_BAR; PG8_SCHED;
            PG8_STAGE(PG8_SB(1, 1), b3 + hstepB, voffB);
            PG8_WAIT_V(6); PG8_BAR; PG8_MMA(1, 1, At, B1); PG8_BAR;
        }
        if constexpr (!Epi::AFTER_DRAIN) E(acc, cur, wr, wc, fr, fq);
        if (!has_next) break;
#pragma unroll
        for (int a = 0; a < 2; ++a)
#pragma unroll
            for (int b = 0; b < 2; ++b)
#pragma unroll
                for (int m = 0; m < 4; ++m)
#pragma unroll
                    for (int n = 0; n < 2; ++n) acc[a][b][m][n] = (f32x4){0.f, 0.f, 0.f, 0.f};
        cur = nxt; cA = nA; cA2 = nA2; cB = nB; ++ui;
    }
    PG8_WAIT_V(0);
    if (wr == 0) PG8_BAR;
    PG8_BAR;
    if constexpr (Epi::AFTER_DRAIN) E.fused(acc, cur, wr, wc, fr, fq, lds, wid, lane);
#undef PG8_SA
#undef PG8_SB
#undef PG8_STAGE
#undef PG8_LDA
#undef PG8_LDB
#undef PG8_MMA
#undef PG8_WAIT_V
#undef PG8_WAIT_L
#undef PG8_BAR
#undef PG8_SCHED
#undef PG8_TILEA
}

struct EpiSwiGLU {
    static constexpr bool AFTER_DRAIN = false;
    bf16_t* O;
    __device__ __forceinline__ void operator()(const f32x4 (&acc)[2][2][4][2], const Unit& u, int wr, int wc, int fr, int fq) const {
        const int row0 = u.pm * BM + wr * 64 + fr, col0 = u.pn * HALF + wc * 32 + 8 * fq;
#pragma unroll
        for (int ai = 0; ai < 2; ++ai)
#pragma unroll
            for (int m = 0; m < 4; ++m) { bf16_t* rowp = O + (size_t)(row0 + ai * HALF + m * 16) * FF + col0;
                const f32x4 g0 = acc[ai][0][m][0], u0 = acc[ai][1][m][0], g1 = acc[ai][0][m][1], u1 = acc[ai][1][m][1];
                u32x4 w; w.x = cvt_pk_bf16(siluf(g0[0]) * u0[0], siluf(g0[1]) * u0[1]); w.y = cvt_pk_bf16(siluf(g0[2]) * u0[2], siluf(g0[3]) * u0[3]);
                w.z = cvt_pk_bf16(siluf(g1[0]) * u1[0], siluf(g1[1]) * u1[1]); w.w = cvt_pk_bf16(siluf(g1[2]) * u1[2], siluf(g1[3]) * u1[3]);
                *(u32x4*)rowp = w; }
    }
};
struct EpiResid {
    static constexpr bool AFTER_DRAIN = false;
    const float* base; float* out; const float* gate; float scale;
    __device__ __forceinline__ void operator()(const f32x4 (&acc)[2][2][4][2], const Unit& u, int wr, int wc, int fr, int fq) const {
        const int row0 = u.pm * BM + wr * 64 + fr, col0 = u.pn * BM + wc * 32 + 4 * fq, b = u.pm >> 4;
        f32x4 gv[2][2];
#pragma unroll
        for (int bj = 0; bj < 2; ++bj)
#pragma unroll
            for (int n = 0; n < 2; ++n) gv[bj][n] = *(const f32x4*)(gate + (size_t)b * NMOD + col0 + bj * HALF + n * 16) * scale;
#pragma unroll
        for (int ai = 0; ai < 2; ++ai)
#pragma unroll
            for (int m = 0; m < 4; ++m) { const size_t off = (size_t)(row0 + ai * HALF + m * 16) * D + col0;
#pragma unroll
                for (int bj = 0; bj < 2; ++bj)
#pragma unroll
                    for (int n = 0; n < 2; ++n) { const f32x4 bs = *(const f32x4*)(base + off + bj * HALF + n * 16);
                        *(f32x4*)(out + off + bj * HALF + n * 16) = bs + gv[bj][n] * acc[ai][bj][m][n]; } }
    }
};
struct EpiSplit {
    static constexpr bool AFTER_DRAIN = false;
    bf16_t* Z; bf16_t* XBC; bf16_t* U;
    __device__ __forceinline__ void operator()(const f32x4 (&acc)[2][2][4][2], const Unit& u, int wr, int wc, int fr, int fq) const {
        bf16_t* basep; int ld, c0;
        if (u.pn < 4) { basep = Z; ld = 1024; c0 = u.pn * BM; } else if (u.pn < 12) { basep = XBC; ld = 2048; c0 = (u.pn - 4) * BM; } else { basep = U; ld = 1024; c0 = (u.pn - 12) * BM; }
        const int row0 = u.pm * BM + wr * 64 + fr, col0 = c0 + wc * 32 + 8 * fq;
#pragma unroll
        for (int ai = 0; ai < 2; ++ai)
#pragma unroll
            for (int m = 0; m < 4; ++m) { bf16_t* rowp = basep + (size_t)(row0 + ai * HALF + m * 16) * ld + col0;
#pragma unroll
                for (int bj = 0; bj < 2; ++bj) { const f32x4 v0 = acc[ai][bj][m][0], v1 = acc[ai][bj][m][1];
                    u32x4 w; w.x = cvt_pk_bf16(v0[0], v0[1]); w.y = cvt_pk_bf16(v0[2], v0[3]); w.z = cvt_pk_bf16(v1[0], v1[1]); w.w = cvt_pk_bf16(v1[2], v1[3]);
                    *(u32x4*)(rowp + bj * HALF) = w; } }
    }
};
struct EpiFold {
    static constexpr bool AFTER_DRAIN = false;
    bf16_t* O;
    __device__ __forceinline__ void operator()(const f32x4 (&acc)[2][2][4][2], const Unit& u, int wr, int wc, int fr, int fq) const {
        const int row0 = u.pm * BM + wr * 64 + fr, col0 = 1024 + u.pn * BM + wc * 32 + 4 * fq;
#pragma unroll
        for (int ai = 0; ai < 2; ++ai)
#pragma unroll
            for (int m = 0; m < 4; ++m) { bf16_t* rowp = O + (size_t)(row0 + ai * HALF + m * 16) * 2048 + col0;
#pragma unroll
                for (int bj = 0; bj < 2; ++bj)
#pragma unroll
                    for (int n = 0; n < 2; ++n) { const f32x4 v = acc[ai][bj][m][n]; u32x2 w; w.x = cvt_pk_bf16(v[0], v[1]); w.y = cvt_pk_bf16(v[2], v[3]);
                        *(u32x2*)(rowp + bj * HALF + n * 16) = w; } }
    }
};
struct EpiPool {
    static constexpr bool AFTER_DRAIN = false;
    bf16_t* O; const float* bias; const float* scl;
    __device__ __forceinline__ void operator()(const f32x4 (&acc)[2][2][4][2], const Unit& u, int wr, int wc, int fr, int fq) const {
        const int row0 = u.pm * BM + wr * 64 + fr, col0 = u.pn * BM + wc * 32 + 4 * fq;
        f32x4 bv[2][2], sv[2][2];
#pragma unroll
        for (int bj = 0; bj < 2; ++bj)
#pragma unroll
            for (int n = 0; n < 2; ++n) { bv[bj][n] = *(const f32x4*)(bias + col0 + bj * HALF + n * 16); sv[bj][n] = *(const f32x4*)(scl + col0 + bj * HALF + n * 16); }
#pragma unroll
        for (int ai = 0; ai < 2; ++ai)
#pragma unroll
            for (int m = 0; m < 4; ++m) { bf16_t* rowp = O + (size_t)(row0 + ai * HALF + m * 16) * 1024 + col0;
#pragma unroll
                for (int bj = 0; bj < 2; ++bj)
#pragma unroll
                    for (int n = 0; n < 2; ++n) { const f32x4 v = (acc[ai][bj][m][n] + bv[bj][n]) * sv[bj][n]; u32x2 w; w.x = cvt_pk_bf16(v[0], v[1]); w.y = cvt_pk_bf16(v[2], v[3]);
                        *(u32x2*)(rowp + bj * HALF + n * 16) = w; } }
    }
};

template <bool HALF_SCALE, bool BASE_BF16> struct EpiResidNorm {
    static constexpr bool AFTER_DRAIN = true;
    const void* base; bf16_t* xout; const float* gate;
    const float* nw; const float* sh; const float* sc;
    bf16_t* hout; float* fout;
    float* ssq; unsigned* cnt;
    const float* bias;
    __device__ __forceinline__ void fused(f32x4 (&acc)[2][2][4][2], const Unit& u, int wr, int wc, int fr, int fq, LAS unsigned char* lds, int wid, int lane) const {
        const void* const base = this->base; bf16_t* const xout = this->xout; const float* const gate = this->gate; const float scale = HALF_SCALE ? 0.5f : 1.0f;
        const float* const nw = this->nw; const float* const sh = this->sh; const float* const sc = this->sc; bf16_t* const hout = this->hout; float* const fout = this->fout;
        float* const ssq = this->ssq; unsigned* const cnt = this->cnt; const float* const bias = this->bias;
        LAS float* P = (LAS float*)lds;
        LAS float* S = (LAS float*)(lds + 4096);
        const int row0 = u.pm * BM + wr * 64 + fr, col0 = u.pn * BM + wc * 32 + 8 * fq, b = u.pm >> 4;
        {
            f32x4 gv[2][2];
#pragma unroll
            for (int bj = 0; bj < 2; ++bj)
#pragma unroll
                for (int n = 0; n < 2; ++n) gv[bj][n] = *(const f32x4*)(gate + (size_t)b * NMOD + col0 + bj * HALF + n * 4) * scale;
            if (bias) {
#pragma unroll
                for (int bj = 0; bj < 2; ++bj)
#pragma unroll
                    for (int n = 0; n < 2; ++n) { const f32x4 bv = *(const f32x4*)(bias + col0 + bj * HALF + n * 4);
#pragma unroll
                        for (int ai = 0; ai < 2; ++ai)
#pragma unroll
                            for (int m = 0; m < 4; ++m) acc[ai][bj][m][n] += bv; } }
#pragma unroll
            for (int ai = 0; ai < 2; ++ai)
#pragma unroll
                for (int mh = 0; mh < 2; ++mh) {
                    f32x4 bsv[2][2][2];
#pragma unroll
                    for (int mm = 0; mm < 2; ++mm)
#pragma unroll
                        for (int bj = 0; bj < 2; ++bj) { const size_t o2 = (size_t)(row0 + ai * HALF + (mh * 2 + mm) * 16) * D + col0 + bj * HALF;
                            if (BASE_BF16) { const u32x4 q = *(const u32x4*)((const bf16_t*)base + o2);
                                bsv[mm][bj][0] = (f32x4){bf_lo(q.x), bf_hi(q.x), bf_lo(q.y), bf_hi(q.y)}; bsv[mm][bj][1] = (f32x4){bf_lo(q.z), bf_hi(q.z), bf_lo(q.w), bf_hi(q.w)}; }
                            else { bsv[mm][bj][0] = *(const f32x4*)((const float*)base + o2); bsv[mm][bj][1] = *(const f32x4*)((const float*)base + o2 + 4); } }
                    asm volatile("" ::: "memory");
#pragma unroll
                    for (int mm = 0; mm < 2; ++mm) { const int m = mh * 2 + mm; const size_t off = (size_t)(row0 + ai * HALF + m * 16) * D + col0; float sq = 0.f;
#pragma unroll
                        for (int bj = 0; bj < 2; ++bj) { u32x4 q;
#pragma unroll
                            for (int n = 0; n < 2; ++n) { const f32x4 x = bsv[mm][bj][n] + gv[bj][n] * acc[ai][bj][m][n];
                                acc[ai][bj][m][n] = x; if (n == 0) { q.x = cvt_pk_bf16(x[0], x[1]); q.y = cvt_pk_bf16(x[2], x[3]); } else { q.z = cvt_pk_bf16(x[0], x[1]); q.w = cvt_pk_bf16(x[2], x[3]); }
                                sq += (x[0] * x[0] + x[1] * x[1]) + (x[2] * x[2] + x[3] * x[3]); }
                            if (xout) *(u32x4*)(xout + off + bj * HALF) = q; }
                        sq += __shfl_xor(sq, 16); sq += __shfl_xor(sq, 32);
                        if (fq == 0) P[(ai * HALF + wr * 64 + m * 16 + fr) * 4 + wc] = sq; }
                }
        }
        asm volatile("s_waitcnt lgkmcnt(0)" ::: "memory"); __builtin_amdgcn_s_barrier(); asm volatile("" ::: "memory");
        const int tid = wid * 64 + lane;
        if (tid < 256) { const f32x4 p = *(const LAS f32x4*)(P + tid * 4);
            __hip_atomic_store(ssq + ((size_t)(u.pm * BM + tid)) * 4 + u.pn, (p[0] + p[1]) + (p[2] + p[3]), __ATOMIC_RELAXED, __HIP_MEMORY_SCOPE_AGENT); }
        asm volatile("s_waitcnt vmcnt(0)" ::: "memory");
        if (wid < 4 && lane == 0) __hip_atomic_fetch_add(cnt + 64 * u.pm, 1u, __ATOMIC_RELAXED, __HIP_MEMORY_SCOPE_AGENT);
        if (wid == 0) {
            unsigned spins = 0;
            while ((unsigned)__builtin_amdgcn_readfirstlane(__hip_atomic_load(cnt + 64 * u.pm, __ATOMIC_RELAXED, __HIP_MEMORY_SCOPE_AGENT)) < 16u) { __builtin_amdgcn_s_sleep(2); if (++spins > (1u << 22)) break; }
            __builtin_amdgcn_fence(__ATOMIC_ACQUIRE, "agent");
        }
        asm volatile("s_waitcnt vmcnt(0) lgkmcnt(0)" ::: "memory"); __builtin_amdgcn_s_barrier(); asm volatile("" ::: "memory");
        if (tid < 256) { const float* slot = ssq + ((size_t)(u.pm * BM + tid)) * 4; float t = 0.f;
#pragma unroll
            for (int q = 0; q < 4; ++q) t += __hip_atomic_load(slot + q, __ATOMIC_RELAXED, __HIP_MEMORY_SCOPE_AGENT);
            S[tid] = rsqrtf(t * (1.f / D) + EPS); }
        asm volatile("s_waitcnt vmcnt(0) lgkmcnt(0)" ::: "memory"); __builtin_amdgcn_s_barrier(); asm volatile("" ::: "memory");
        f32x4 A4[2][2], B4[2][2];
#pragma unroll
        for (int bj = 0; bj < 2; ++bj)
#pragma unroll
            for (int n = 0; n < 2; ++n) { const int col = col0 + bj * HALF + n * 4;
                A4[bj][n] = *(const f32x4*)(nw + col); B4[bj][n] = (f32x4){0.f, 0.f, 0.f, 0.f};
                if (sc) { A4[bj][n] = A4[bj][n] * (*(const f32x4*)(sc + (size_t)b * NMOD + col) + 1.f); B4[bj][n] = *(const f32x4*)(sh + (size_t)b * NMOD + col); } }
#pragma unroll
        for (int ai = 0; ai < 2; ++ai)
#pragma unroll
            for (int m = 0; m < 4; ++m) { const float rstd = S[ai * HALF + wr * 64 + m * 16 + fr];
#pragma unroll
                for (int bj = 0; bj < 2; ++bj) { const size_t off = (size_t)(row0 + ai * HALF + m * 16) * D + col0 + bj * HALF;
                    const f32x4 o0 = acc[ai][bj][m][0] * rstd * A4[bj][0] + B4[bj][0], o1 = acc[ai][bj][m][1] * rstd * A4[bj][1] + B4[bj][1];
                    if (hout) { u32x4 w; w.x = cvt_pk_bf16(o0[0], o0[1]); w.y = cvt_pk_bf16(o0[2], o0[3]); w.z = cvt_pk_bf16(o1[0], o1[1]); w.w = cvt_pk_bf16(o1[2], o1[3]); *(u32x4*)(hout + off) = w; }
                    else { *(f32x4*)(fout + off) = o0; *(f32x4*)(fout + off + 4) = o1; } } }
    }
};
}

struct Args { const float* in[25]; float* out; unsigned char* ws; int ph_lo, ph_hi; };
enum { I_X = 0, I_C, I_WADA, I_BADA, I_N1, I_G1, I_U1, I_D1, I_NMIX, I_WIN, I_CONVW, I_CONVB, I_DTB, I_ALOG, I_DSKIP, I_SSDNW, I_POOLW, I_POOLB, I_POOLS, I_WOUT, I_N2, I_G2, I_U2, I_D2, I_NF };

__device__ __forceinline__ void p0_transpose_item(const float* W, int ldw, int K, bf16_t* WT, int dst_row0, int n0, int k0, LAS float* scr, int lane, bool perm) {
    const int lr = lane >> 3, lc = (lane & 7) * 4;
    f32x4 v[8];
#pragma unroll
    for (int i = 0; i < 8; ++i) v[i] = *(const f32x4*)(W + (size_t)(k0 + 8 * i + lr) * ldw + n0 + lc);
#pragma unroll
    for (int i = 0; i < 8; ++i) { LAS float* d = scr + (8 * i + lr) * 33 + lc; d[0] = v[i].x; d[1] = v[i].y; d[2] = v[i].z; d[3] = v[i].w; }
    LDS_WAIT();
    const int c = lane & 7;
#pragma unroll
    for (int j = 0; j < 4; ++j) { const int n = (lane >> 3) + 8 * j; const LAS float* sp = scr + (8 * c) * 33 + n;
        u32x4 o; o.x = cvt_pk_bf16(sp[0 * 33], sp[1 * 33]); o.y = cvt_pk_bf16(sp[2 * 33], sp[3 * 33]); o.z = cvt_pk_bf16(sp[4 * 33], sp[5 * 33]); o.w = cvt_pk_bf16(sp[6 * 33], sp[7 * 33]);
        const int nr = perm ? (16 * ((n >> 2) & 1) + 4 * (n >> 3) + (n & 3)) : n;
        *(u32x4*)(WT + (size_t)(dst_row0 + nr) * K + k0 + 8 * c) = o; }
    LDS_WAIT();
}
__device__ __forceinline__ void p0_mat_item(const float* W, int ldw, int K, int nb, int csrc, bf16_t* WT, int drow_base, int mode, int it, LAS float* scr, int lane) {
    const int kb = it / nb, nbi = it % nb, n0 = 32 * nbi;
    int drow = drow_base + n0;
    if (mode & 1) drow = (n0 >> 7) * 256 + (n0 & 127) + drow_base;
    p0_transpose_item(W, ldw, K, WT, drow, csrc + n0, 64 * kb, scr, lane, (mode & 2) != 0);
}
__device__ __forceinline__ void p0_transposes(const Args& a, LAS unsigned char* lds, int part, int gw, int NGW, int lane, int wave) {
    unsigned char* ws = a.ws;
    LAS float* scr = (LAS float*)(lds + wave * 8448);
    constexpr int I_GU = (D / 64) * (FF / 32), I_DN = (FF / 64) * (D / 32), I_ZZ = (D / 64) * 32, I_XB = (D / 64) * 64, I_OUT = (2048 / 64) * 32, I_PW = 512, I_BV = 256;
    if (part == 0) {
        for (int it = gw; it < 2 * I_GU + I_DN; it += NGW) {
            int r = it;
            if (r < I_GU) { p0_mat_item(a.in[I_G1], FF, D, FF / 32, 0, (bf16_t*)(ws + WS_WGU1), 0, 3, r, scr, lane); continue; } r -= I_GU;
            if (r < I_GU) { p0_mat_item(a.in[I_U1], FF, D, FF / 32, 0, (bf16_t*)(ws + WS_WGU1), 128, 3, r, scr, lane); continue; } r -= I_GU;
            p0_mat_item(a.in[I_D1], D, FF, D / 32, 0, (bf16_t*)(ws + WS_WD1), 0, 2, r, scr, lane);
        }
    } else {
        constexpr int NITEMS = 2 * I_GU + I_DN + 2 * I_ZZ + I_XB + I_OUT + I_PW + I_BV;
        for (int it = gw; it < NITEMS; it += NGW) {
            int r = it;
            if (r < I_ZZ) { p0_mat_item(a.in[I_WIN], DINP, D, 32, 0, (bf16_t*)(ws + WS_WIN), 0, 2, r, scr, lane); continue; } r -= I_ZZ;
            if (r < I_XB) { p0_mat_item(a.in[I_WIN], DINP, D, 64, 1024, (bf16_t*)(ws + WS_WIN), 1024, 2, r, scr, lane); continue; } r -= I_XB;
            if (r < I_ZZ) { p0_mat_item(a.in[I_WIN], DINP, D, 32, 3088, (bf16_t*)(ws + WS_WIN), 3072, 2, r, scr, lane); continue; } r -= I_ZZ;
            if (r < I_OUT) { p0_mat_item(a.in[I_WOUT], D, 2048, 32, 0, (bf16_t*)(ws + WS_WOUT), 0, 2, r, scr, lane); continue; } r -= I_OUT;
            if (r < I_PW) {
                const int e0 = r * 512 + lane * 8, gq = e0 >> 16, d0 = e0 & 255;
                const f32x4 p0 = *(const f32x4*)(a.in[I_POOLW] + e0), p1 = *(const f32x4*)(a.in[I_POOLW] + e0 + 4);
                const f32x4 s0 = *(const f32x4*)(a.in[I_POOLS] + gq * 256 + d0), s1 = *(const f32x4*)(a.in[I_POOLS] + gq * 256 + d0 + 4);
                u32x4 o; o.x = cvt_pk_bf16(p0.x * s0.x, p0.y * s0.y); o.y = cvt_pk_bf16(p0.z * s0.z, p0.w * s0.w); o.z = cvt_pk_bf16(p1.x * s1.x, p1.y * s1.y); o.w = cvt_pk_bf16(p1.z * s1.z, p1.w * s1.w);
                *(u32x4*)((bf16_t*)(ws + WS_WPOOL) + e0) = o; continue; } r -= I_PW;
            if (r < I_BV) {
                const int cg = r & 15, kg = r >> 4, n = cg * 64 + lane; float acc = 0.f;
                const float* wp = a.in[I_WOUT] + (size_t)(1024 + kg * 64) * D + n;
#pragma unroll 16
                for (int k = 0; k < 64; ++k) acc += a.in[I_POOLB][kg * 64 + k] * a.in[I_POOLS][kg * 64 + k] * wp[(size_t)k * D];
                atomicAdd((float*)(ws + WS_BVEC) + n, acc); continue; } r -= I_BV;
            if (r < I_GU) { p0_mat_item(a.in[I_G2], FF, D, FF / 32, 0, (bf16_t*)(ws + WS_WGU2), 0, 3, r, scr, lane); continue; } r -= I_GU;
            if (r < I_GU) { p0_mat_item(a.in[I_U2], FF, D, FF / 32, 0, (bf16_t*)(ws + WS_WGU2), 128, 3, r, scr, lane); continue; } r -= I_GU;
            p0_mat_item(a.in[I_D2], D, FF, D / 32, 0, (bf16_t*)(ws + WS_WD2), 0, 2, r, scr, lane);
        }
    }
}
__device__ __forceinline__ void p0_phase(const Args& a, LAS unsigned char* lds, int tid, int lane, int wave, int G, int part) {
    unsigned char* ws = a.ws;
    unsigned* modcnt = (unsigned*)(ws + WS_CNT) + 3 * 64 * 64;
    if (part & 1) {
        LAS float* cact = (LAS float*)(lds + 69632);
        LAS float* red = (LAS float*)(lds + 69632 + 16384);
        if ((int)blockIdx.x < NMOD / 64) {
            for (int i = tid; i < 4 * D; i += NTHREADS) { const float cv = a.in[I_C][i]; cact[i] = cv / (1.f + __expf(-cv)); }
            __syncthreads();
        }
        for (int it = blockIdx.x; it < NMOD / 64; it += G) {
            const int j = it * 64 + lane, kb = wave * 128, c4 = (lane & 15) * 4, ksub = lane >> 4;
            f32x4 sv[4];
#pragma unroll
            for (int bb = 0; bb < 4; ++bb) sv[bb] = (f32x4){0.f, 0.f, 0.f, 0.f};
            const float* wp = a.in[I_WADA] + (size_t)(kb + ksub) * NMOD + it * 64 + c4;
#pragma unroll 16
            for (int i = 0; i < 32; ++i) { const f32x4 wv = *(const f32x4*)(wp + (size_t)(4 * i) * NMOD); const int k = kb + 4 * i + ksub;
                sv[0] += wv * cact[k]; sv[1] += wv * cact[D + k]; sv[2] += wv * cact[2 * D + k]; sv[3] += wv * cact[3 * D + k]; }
#pragma unroll
            for (int bb = 0; bb < 4; ++bb)
#pragma unroll
                for (int e = 0; e < 4; ++e) { float t = sv[bb][e]; t += __shfl_xor(t, 16); t += __shfl_xor(t, 32); sv[bb][e] = t; }
            if (ksub == 0) {
#pragma unroll
                for (int bb = 0; bb < 4; ++bb) *(LAS f32x4*)(red + (wave * 4 + bb) * 64 + c4) = sv[bb]; }
            __syncthreads();
            if (wave < 4) { float t = a.in[I_BADA][j];
#pragma unroll
                for (int w = 0; w < 8; ++w) t += red[(w * 4 + wave) * 64 + lane];
                ((float*)(ws + WS_MOD))[wave * NMOD + j] = t; }
            asm volatile("s_waitcnt vmcnt(0)" ::: "memory");
            __syncthreads();
            if (tid == 0) { __threadfence(); __hip_atomic_fetch_add(modcnt, 1u, __ATOMIC_RELAXED, __HIP_MEMORY_SCOPE_AGENT); }
        }
    }
    if (part & 2) for (int idx = blockIdx.x * NTHREADS + tid; idx < 16 * D / 2; idx += G * NTHREADS) { const int k = (idx >> 4) * 2, j = idx & 15;
        ((unsigned*)(ws + WS_WDT))[(j * D + k) >> 1] = cvt_pk_bf16(a.in[I_WIN][(size_t)k * DINP + 3072 + j], a.in[I_WIN][(size_t)(k + 1) * DINP + 3072 + j]); }
    if (part & 2) {
        const int nmodb = (NMOD / 64 < G) ? NMOD / 64 : G, nslots = (nmodb + 3 * (G - nmodb)) * NWAVES;
        if ((int)blockIdx.x < nmodb) p0_transposes(a, lds, 0, blockIdx.x * NWAVES + wave, nslots, lane, wave);
        else for (int q = 0; q < 3; ++q) p0_transposes(a, lds, 0, nmodb * NWAVES + (((int)blockIdx.x - nmodb) * NWAVES + wave) * 3 + q, nslots, lane, wave);
    }
    if (!(part & 4)) return;
    if (wave == 0) { unsigned spins = 0;
        while ((unsigned)__builtin_amdgcn_readfirstlane(__hip_atomic_load(modcnt, __ATOMIC_RELAXED, __HIP_MEMORY_SCOPE_AGENT)) < (unsigned)(NMOD / 64)) { __builtin_amdgcn_s_sleep(2); if (++spins > (1u << 22)) break; }
        __builtin_amdgcn_fence(__ATOMIC_ACQUIRE, "agent"); }
    asm volatile("s_waitcnt vmcnt(0) lgkmcnt(0)" ::: "memory");
    __syncthreads();
}

template <bool DTP>
__device__ __forceinline__ void norm_phase(LAS unsigned char* lds, const float* src, const float* nw, const float* mod, int sh_off, int sc_off, bf16_t* dst,
                                           const float* wdt, const float* dt_bias, float* DT, int tid, int lane, int wave, int G) {
    LAS f32x4* wl = (LAS f32x4*)lds;
    if (DTP) { for (int i = tid; i < 16 * D / 4; i += NTHREADS) wl[i] = ((const f32x4*)wdt)[i]; __syncthreads(); }
    const int gw = blockIdx.x * NWAVES + wave, NGW = G * NWAVES;
    for (int rg = gw; rg < M / 8; rg += NGW) {
        const int row0 = rg * 8, b = row0 >> 12;
        f32x4 Am[4], Bm[4];
#pragma unroll
        for (int j = 0; j < 4; ++j) { const int col = 4 * lane + 256 * j;
            const f32x4 w = *(const f32x4*)(nw + col), sc = *(const f32x4*)(mod + (size_t)b * NMOD + sc_off + col);
            Am[j] = w * (sc + 1.f); Bm[j] = *(const f32x4*)(mod + (size_t)b * NMOD + sh_off + col); }
#pragma unroll 1
        for (int half = 0; half < 2; ++half) {
            f32x4 o[4][4];
#pragma unroll
            for (int r = 0; r < 4; ++r) {
                const int row = row0 + half * 4 + r;
                float ss = 0.f;
#pragma unroll
                for (int j = 0; j < 4; ++j) { o[r][j] = *(const f32x4*)(src + (size_t)row * D + 4 * lane + 256 * j); ss += (o[r][j].x * o[r][j].x + o[r][j].y * o[r][j].y) + (o[r][j].z * o[r][j].z + o[r][j].w * o[r][j].w); }
                const float rstd = rsqrtf(wave_sum(ss) * (1.f / D) + EPS);
#pragma unroll
                for (int j = 0; j < 4; ++j) { o[r][j] = o[r][j] * rstd * Am[j] + Bm[j];
                    u32x2 w; w.x = cvt_pk_bf16(o[r][j].x, o[r][j].y); w.y = cvt_pk_bf16(o[r][j].z, o[r][j].w);
                    *(u32x2*)(dst + (size_t)row * D + 4 * lane + 256 * j) = w; }
            }
            if (DTP) {
                float mine = 0.f;
                __builtin_amdgcn_sched_barrier(0);
#pragma unroll 1
                for (int jj = 0; jj < 16; ++jj) {
                    f32x4 wv[4];
#pragma unroll
                    for (int j = 0; j < 4; ++j) wv[j] = wl[jj * 256 + 64 * j + lane];
#pragma unroll
                    for (int r = 0; r < 4; ++r) { float p = 0.f;
#pragma unroll
                        for (int j = 0; j < 4; ++j) p += (o[r][j].x * wv[j].x + o[r][j].y * wv[j].y) + (o[r][j].z * wv[j].z + o[r][j].w * wv[j].w);
                        const float t = wave_sum(p); if (lane == r * 16 + jj) mine = t; }
                }
                const float xv = mine + dt_bias[lane & 15];
                DT[(size_t)(row0 + half * 4 + (lane >> 4)) * 16 + (lane & 15)] = xv > 20.f ? xv : log1pf(__expf(xv));
            }
        }
    }
}
__device__ __forceinline__ void final_norm_phase(float* xio, const float* nw, int lane, int wave, int G) {
    const int gw = blockIdx.x * NWAVES + wave, NGW = G * NWAVES;
    f32x4 wv[4];
#pragma unroll
    for (int j = 0; j < 4; ++j) wv[j] = *(const f32x4*)(nw + 4 * lane + 256 * j);
    for (int rg = gw; rg < M / 4; rg += NGW) {
        f32x4 v[4][4]; float ss[4];
#pragma unroll
        for (int r = 0; r < 4; ++r)
#pragma unroll
            for (int j = 0; j < 4; ++j) v[r][j] = *(const f32x4*)(xio + (size_t)(rg * 4 + r) * D + 4 * lane + 256 * j);
#pragma unroll
        for (int r = 0; r < 4; ++r) { ss[r] = 0.f;
#pragma unroll
            for (int j = 0; j < 4; ++j) ss[r] += (v[r][j].x * v[r][j].x + v[r][j].y * v[r][j].y) + (v[r][j].z * v[r][j].z + v[r][j].w * v[r][j].w); }
#pragma unroll
        for (int r = 0; r < 4; ++r) { const float rstd = rsqrtf(wave_sum(ss[r]) * (1.f / D) + EPS);
#pragma unroll
            for (int j = 0; j < 4; ++j) *(f32x4*)(xio + (size_t)(rg * 4 + r) * D + 4 * lane + 256 * j) = v[r][j] * rstd * wv[j]; }
    }
}


__device__ __forceinline__ void dt_tail(LAS unsigned char* lds, const bf16_t* Hn, const bf16_t* WDTB, const float* dt_bias, float* DT, int G, int wave, int lane) {
    const int fr = lane & 15, fq = lane >> 4, wq = wave & 3, kh = wave >> 2;
    LAS f32x4* part = (LAS f32x4*)lds;
    for (int tg0 = 0; tg0 < M / 16; tg0 += 4 * G) {
        const int tg = tg0 + wq * G + blockIdx.x; const bool act = tg < M / 16;
        const int row0 = tg * 16;
        f32x4 d = (f32x4){0.f, 0.f, 0.f, 0.f};
        if (act) {
            const bf16_t* ap = Hn + (size_t)(row0 + fr) * D + kh * 512 + fq * 8; const bf16_t* bp = WDTB + (size_t)fr * D + kh * 512 + fq * 8;
#pragma unroll
            for (int ks = 0; ks < 16; ++ks) d = __builtin_amdgcn_mfma_f32_16x16x32_bf16(*(const bf16x8*)(ap + ks * 32), *(const bf16x8*)(bp + ks * 32), d, 0, 0, 0);
        }
        __syncthreads();
        if (kh == 1) part[wq * 64 + lane] = d;
        __syncthreads();
        if (kh == 0 && act) {
            d = d + part[wq * 64 + lane];
            const float bias = dt_bias[fr];
#pragma unroll
            for (int jj = 0; jj < 4; ++jj) { const float xv = d[jj] + bias; DT[(size_t)(row0 + fq * 4 + jj) * 16 + fr] = xv > 20.f ? xv : log1pf(__expf(xv)); }
        }
    }
}

__device__ __forceinline__ void unpack8(const u32x4 v, float (&f)[8]) { f[0] = bf_lo(v.x); f[1] = bf_hi(v.x); f[2] = bf_lo(v.y); f[3] = bf_hi(v.y); f[4] = bf_lo(v.z); f[5] = bf_hi(v.z); f[6] = bf_lo(v.w); f[7] = bf_hi(v.w); }
template <int W>
__device__ __forceinline__ void diff_rows(const bf16_t* up, bf16_t* dp, int pos0) {
    u32x4 rows[W + 8];
#pragma unroll
    for (int j = 0; j < W + 8; ++j) { rows[j] = (u32x4){0u, 0u, 0u, 0u}; if (pos0 - W + j >= 0) rows[j] = *(const u32x4*)(up + (long)(j - W) * 1024); }
    float S[8];
#pragma unroll
    for (int e = 0; e < 8; ++e) S[e] = 0.f;
#pragma unroll
    for (int j = 0; j < W; ++j) { float f[8]; unpack8(rows[j], f);
#pragma unroll
        for (int e = 0; e < 8; ++e) S[e] += f[e]; }
#pragma unroll
    for (int i = 0; i < 8; ++i) {
        float f[8], q[8]; unpack8(rows[W + i], f); unpack8(rows[i], q);
#pragma unroll
        for (int e = 0; e < 8; ++e) S[e] += f[e] - q[e];
        const int pos = pos0 + i; const float inv = 1.f / (float)(pos + 1 < W ? pos + 1 : W);
        u32x4 o; o.x = cvt_pk_bf16(S[0] * inv - f[0], S[1] * inv - f[1]); o.y = cvt_pk_bf16(S[2] * inv - f[2], S[3] * inv - f[3]);
        o.z = cvt_pk_bf16(S[4] * inv - f[4], S[5] * inv - f[5]); o.w = cvt_pk_bf16(S[6] * inv - f[6], S[7] * inv - f[7]);
        *(u32x4*)(dp + (long)i * 1024) = o;
    }
}
__device__ __forceinline__ void diff_item(const bf16_t* U, bf16_t* DIFF, int item, int lane, int wave) {
    const int grp = wave & 3, oct = grp * 32 + (lane & 31), t0 = item * 32 + (wave >> 2) * 16 + (lane >> 5) * 8, pos0 = t0 & (SEQ - 1);
    const bf16_t* up = U + (size_t)t0 * 1024 + oct * 8; bf16_t* dp = DIFF + (size_t)t0 * 1024 + oct * 8;
    if (grp == 0) diff_rows<2>(up, dp, pos0); else if (grp == 1) diff_rows<4>(up, dp, pos0); else if (grp == 2) diff_rows<8>(up, dp, pos0); else diff_rows<16>(up, dp, pos0);
}

constexpr int LP = 272;
constexpr int L_C = 0, L_B = 128 * LP, L_XT = 2 * 128 * LP, L_ACS = L_XT + 4 * 64 * LP, L_DTV = L_ACS + 2048, L_NW = L_DTV + 2048, L_SSD_END = L_NW + 1024;
static_assert(L_SSD_END <= LDS_BYTES, "ssd lds");

__device__ __forceinline__ void ssd_cumsum(LAS unsigned char* lds, const float* DT, const float* a_log, int T0, int g, int lane, int wave) {
    if (wave < 4) {
        const int h = 4 * g + wave; const float av = -__expf(a_log[h]);
        const int t = 2 * lane;
        const float d0 = DT[(size_t)(T0 + t) * 16 + h], d1 = DT[(size_t)(T0 + t + 1) * 16 + h];
        const float v0 = d0 * av, v1 = d1 * av, s = v0 + v1;
        float inc = s;
#pragma unroll
        for (int o = 1; o < 64; o <<= 1) { const float n = __shfl_up(inc, o); if (lane >= o) inc += n; }
        const float exc = inc - s;
        LAS float* acs = (LAS float*)(lds + L_ACS) + wave * 128; LAS float* dtv = (LAS float*)(lds + L_DTV) + wave * 128;
        acs[t] = exc + v0; acs[t + 1] = exc + s; dtv[t] = d0; dtv[t + 1] = d1;
    }
}
template <int MODE>
__device__ __forceinline__ void ssd_stage(LAS unsigned char* lds, const bf16_t* XBC, const float* conv_w, const float* conv_b, int T0, int c, int g, int tid) {
    const LAS float* acs = (const LAS float*)(lds + L_ACS); const LAS float* dtv = (const LAS float*)(lds + L_DTV);
    constexpr int O_LO = (MODE == 0) ? 16 : 0, NO = 64 - O_LO;
#pragma unroll 1
    for (int task = tid; task < NO * 16; task += NTHREADS) {
        const int o = O_LO + task % NO, sg = task / NO;
        const int ch = (o < 16) ? (1536 + g * 128 + o * 8) : (o < 32) ? (1024 + g * 128 + (o - 16) * 8) : (g * 256 + (o - 32) * 8);
        float w[4][8], bs[8];
#pragma unroll
        for (int k = 0; k < 4; ++k) { const f32x4 w0 = *(const f32x4*)(conv_w + k * DXBC + ch), w1 = *(const f32x4*)(conv_w + k * DXBC + ch + 4);
            w[k][0] = w0.x; w[k][1] = w0.y; w[k][2] = w0.z; w[k][3] = w0.w; w[k][4] = w1.x; w[k][5] = w1.y; w[k][6] = w1.z; w[k][7] = w1.w; }
        { const f32x4 b0 = *(const f32x4*)(conv_b + ch), b1 = *(const f32x4*)(conv_b + ch + 4);
          bs[0] = b0.x; bs[1] = b0.y; bs[2] = b0.z; bs[3] = b0.w; bs[4] = b1.x; bs[5] = b1.y; bs[6] = b1.z; bs[7] = b1.w; }
        const bf16_t* src = XBC + ((size_t)(T0 + sg * 8) - 3) * DXBC + ch;
        float out[8][8];
#pragma unroll
        for (int i = 0; i < 8; ++i)
#pragma unroll
            for (int e = 0; e < 8; ++e) out[i][e] = bs[e];
#pragma unroll
        for (int rr = 0; rr < 11; ++rr) {
            const bool valid = (c * 128 + sg * 8 - 3 + rr) >= 0;
            u32x4 rv = (u32x4){0u, 0u, 0u, 0u};
            if (valid) rv = *(const u32x4*)(src + (size_t)rr * DXBC);
            float f[8]; unpack8(rv, f);
#pragma unroll
            for (int k = 0; k < 4; ++k) { const int i = rr - k;
                if (i >= 0 && i < 8) {
#pragma unroll
                    for (int e = 0; e < 8; ++e) out[i][e] += w[k][e] * f[e]; } }
        }
#pragma unroll
        for (int i = 0; i < 8; ++i)
#pragma unroll
            for (int e = 0; e < 8; ++e) out[i][e] = siluf(out[i][e]);
        if (o >= 32) {
            const int r = (o - 32) >> 3, p0 = ((o - 32) & 7) * 8;
            float sc[8];
#pragma unroll
            for (int i = 0; i < 8; ++i) { const int s = sg * 8 + i; sc[i] = dtv[r * 128 + s]; if (MODE == 0) sc[i] *= __expf(acs[r * 128 + 127] - acs[r * 128 + s]); }
#pragma unroll
            for (int e = 0; e < 8; ++e) { u32x4 v; v.x = cvt_pk_bf16(out[0][e] * sc[0], out[1][e] * sc[1]); v.y = cvt_pk_bf16(out[2][e] * sc[2], out[3][e] * sc[3]);
                v.z = cvt_pk_bf16(out[4][e] * sc[4], out[5][e] * sc[5]); v.w = cvt_pk_bf16(out[6][e] * sc[6], out[7][e] * sc[7]);
                const int pch = p0 + e, jq = pch & 31, prow = (MODE == 1) ? ((pch & ~31) + 16 * ((jq >> 2) & 1) + 4 * (jq >> 3) + (jq & 3)) : pch;
                *(LAS u32x4*)(lds + L_XT + (r * 64 + prow) * LP + sg * 16) = v; }
        } else if (MODE == 0) {
            const int n0 = (o - 16) * 8;
#pragma unroll
            for (int e = 0; e < 8; ++e) { u32x4 v; v.x = cvt_pk_bf16(out[0][e], out[1][e]); v.y = cvt_pk_bf16(out[2][e], out[3][e]); v.z = cvt_pk_bf16(out[4][e], out[5][e]); v.w = cvt_pk_bf16(out[6][e], out[7][e]);
                const int nn = n0 + e, j = nn & 31, rowp = (nn & ~31) + 16 * ((j >> 2) & 1) + 4 * (j >> 3) + (j & 3);
                *(LAS u32x4*)(lds + L_C + rowp * LP + sg * 16) = v; }
        } else {
            const int base = (o < 16) ? L_C : L_B, n0 = (o & 15) * 8;
#pragma unroll
            for (int i = 0; i < 8; ++i) { u32x4 v; v.x = cvt_pk_bf16(out[i][0], out[i][1]); v.y = cvt_pk_bf16(out[i][2], out[i][3]); v.z = cvt_pk_bf16(out[i][4], out[i][5]); v.w = cvt_pk_bf16(out[i][6], out[i][7]);
                *(LAS u32x4*)(lds + base + (sg * 8 + i) * LP + n0 * 2) = v; }
        }
    }
}
#define MFMA16(a, b, c) __builtin_amdgcn_mfma_f32_16x16x32_bf16((a), (b), (c), 0, 0, 0)
#define LFRAG(base, row, kk) (*(const LAS bf16x8*)(lds + (base) + (row) * LP + (kk) * 2))

__device__ __forceinline__ void ssd_states_item(const Args& a, LAS unsigned char* lds, int item, int tid, int lane, int wave) {
    const int g = item & 3, c = (item >> 2) & 31, b = item >> 7, T0 = b * SEQ + c * 128, fr = lane & 15, fq = lane >> 4;
    const float* DT = (const float*)(a.ws + WS_DT);
    __syncthreads();
    ssd_cumsum(lds, DT, a.in[I_ALOG], T0, g, lane, wave);
    __syncthreads();
    if (tid < 4) ((float*)(a.ws + WS_CDEC))[(b * 32 + c) * 16 + 4 * g + tid] = __expf(((const LAS float*)(lds + L_ACS))[tid * 128 + 127]);
    ssd_stage<0>(lds, (const bf16_t*)(a.ws + WS_XBC), a.in[I_CONVW], a.in[I_CONVB], T0, c, g, tid);
    __syncthreads();
    const int r = wave >> 1, p0 = (wave & 1) * 32;
    f32x4 st[2][8];
#pragma unroll
    for (int pf = 0; pf < 2; ++pf)
#pragma unroll
        for (int nf = 0; nf < 8; ++nf) st[pf][nf] = (f32x4){0.f, 0.f, 0.f, 0.f};
#pragma unroll
    for (int ks = 0; ks < 4; ++ks) {
        bf16x8 xf[2];
#pragma unroll
        for (int pf = 0; pf < 2; ++pf) xf[pf] = LFRAG(L_XT, r * 64 + p0 + pf * 16 + fr, ks * 32 + fq * 8);
#pragma unroll
        for (int nf = 0; nf < 8; ++nf) { const bf16x8 bf = LFRAG(L_C, nf * 16 + fr, ks * 32 + fq * 8);
#pragma unroll
            for (int pf = 0; pf < 2; ++pf) st[pf][nf] = MFMA16(bf, xf[pf], st[pf][nf]); }
    }
    bf16_t* SP = (bf16_t*)((unsigned char*)a.out + DO_STATES) + ((size_t)((b * 32 + c) * 16 + 4 * g + r) * 64) * 128;
#ifndef DBG_ST
#define DBG_ST 0
#endif
#if DBG_ST == 1
#pragma unroll
    for (int pf = 0; pf < 2; ++pf)
#pragma unroll
        for (int nf = 0; nf < 8; ++nf) st[pf][nf] = (f32x4){1.f, 2.f, 3.f, 4.f};
#elif DBG_ST == 2
#pragma unroll
    for (int pf = 0; pf < 2; ++pf)
#pragma unroll
        for (int nf = 0; nf < 8; ++nf) { const bf16x8 q = LFRAG(L_XT, r * 64 + p0 + pf * 16 + fr, (nf & 3) * 32 + fq * 8); st[pf][nf] = (f32x4){(float)q[0], (float)q[1], (float)q[6], (float)q[7]}; }
#elif DBG_ST == 3
#pragma unroll
    for (int pf = 0; pf < 2; ++pf)
#pragma unroll
        for (int nf = 0; nf < 8; ++nf) { const bf16x8 q = LFRAG(L_C, nf * 16 + fr, (pf * 2) * 32 + fq * 8); st[pf][nf] = (f32x4){(float)q[0], (float)q[1], (float)q[6], (float)q[7]}; }
#endif
#pragma unroll
    for (int pf = 0; pf < 2; ++pf)
#pragma unroll
        for (int q = 0; q < 4; ++q) { const f32x4 v0 = st[pf][2 * q], v1 = st[pf][2 * q + 1]; u32x4 w; w.x = cvt_pk_bf16(v0[0], v0[1]); w.y = cvt_pk_bf16(v0[2], v0[3]); w.z = cvt_pk_bf16(v1[0], v1[1]); w.w = cvt_pk_bf16(v1[2], v1[3]);
            *(u32x4*)(SP + (size_t)(p0 + pf * 16 + fr) * 128 + q * 32 + fq * 8) = w; }
}

__device__ __forceinline__ void scan_phase(const Args& a, LAS unsigned char* lds, int tid, int G) {
    bf16_t* SP = (bf16_t*)((unsigned char*)a.out + DO_STATES);
    const float* CD = (const float*)(a.ws + WS_CDEC);
    LAS float* dl = (LAS float*)lds;
    for (int tb = blockIdx.x; tb < BATCH * NHEAD * 64 * 32 / NTHREADS; tb += G) {
        const int task = tb * NTHREADS + tid;
        const int n4 = task & 31, p = (task >> 5) & 63, h = (task >> 11) & 15, b = task >> 15;
        __syncthreads();
        if (tid < 32) dl[tid] = CD[(b * 32 + tid) * 16 + h];
        u32x2* base = (u32x2*)(SP + ((size_t)((b * 32) * 16 + h) * 64 + p) * 128 + n4 * 4);
        constexpr size_t cstride = (size_t)16 * 64 * 128 / 4;
        u32x2 sv[32];
#pragma unroll
        for (int c = 0; c < 32; ++c) sv[c] = base[c * cstride];
        __syncthreads();
        asm volatile("" ::: "memory");
        float r0 = 0.f, r1 = 0.f, r2 = 0.f, r3 = 0.f;
#pragma unroll
        for (int c = 0; c < 32; ++c) {
            const float dec = dl[c];
            u32x2 o; o.x = cvt_pk_bf16(r0, r1); o.y = cvt_pk_bf16(r2, r3);
            r0 = r0 * dec + bf_lo(sv[c].x); r1 = r1 * dec + bf_hi(sv[c].x); r2 = r2 * dec + bf_lo(sv[c].y); r3 = r3 * dec + bf_hi(sv[c].y);
            base[c * cstride] = o;
        }
    }
}

__device__ __forceinline__ void ssd_out_item(const Args& a, LAS unsigned char* lds, int item, int tid, int lane, int wave) {
    const int g = item & 3, c = (item >> 2) & 31, b = item >> 7, T0 = b * SEQ + c * 128, fr = lane & 15, fq = lane >> 4;
    const float* DT = (const float*)(a.ws + WS_DT);
    const LAS float* acs = (const LAS float*)(lds + L_ACS); const LAS float* dtv = (const LAS float*)(lds + L_DTV);
    __syncthreads();
    ssd_cumsum(lds, DT, a.in[I_ALOG], T0, g, lane, wave);
    if (wave == 7) *(LAS f32x4*)(lds + L_NW + lane * 16) = *(const f32x4*)(a.in[I_SSDNW] + g * 256 + lane * 4);
    __syncthreads();
    ssd_stage<1>(lds, (const bf16_t*)(a.ws + WS_XBC), a.in[I_CONVW], a.in[I_CONVB], T0, c, g, tid);
    __syncthreads();
    const int l0 = wave * 16, l = l0 + fr;
    f32x4 sacc[8];
#pragma unroll
    for (int sf = 0; sf < 8; ++sf) sacc[sf] = (f32x4){0.f, 0.f, 0.f, 0.f};
#pragma unroll
    for (int ks = 0; ks < 4; ++ks) { const bf16x8 cf = LFRAG(L_C, l, ks * 32 + fq * 8);
#pragma unroll
        for (int sf = 0; sf < 8; ++sf) { const bf16x8 bf = LFRAG(L_B, sf * 16 + fr, ks * 32 + fq * 8); sacc[sf] = MFMA16(bf, cf, sacc[sf]); } }
    __syncthreads();
    const int L_M = L_B + wave * 16 * LP;
    const bf16_t* PV = (const bf16_t*)((const unsigned char*)a.out + DO_STATES) + ((size_t)((b * 32 + c) * 16 + 4 * g) * 64) * 128;
    f32x4 y[4][4];
#pragma unroll
    for (int r = 0; r < 4; ++r) {
        const float al = acs[r * 128 + l];
#pragma unroll
        for (int pf = 0; pf < 4; ++pf) y[r][pf] = (f32x4){0.f, 0.f, 0.f, 0.f};
#pragma unroll
        for (int ks = 0; ks < 4; ++ks) {
            const bf16x8 cf = LFRAG(L_C, l, ks * 32 + fq * 8);
#pragma unroll
            for (int pf = 0; pf < 4; ++pf) {
                const bf16x8 pv = *(const bf16x8*)(PV + (size_t)(r * 64 + 32 * (pf >> 1) + 8 * (fr >> 2) + 4 * (pf & 1) + (fr & 3)) * 128 + ks * 32 + fq * 8);
                y[r][pf] = MFMA16(pv, cf, y[r][pf]);
            }
        }
        const float sd = __expf(al);
#pragma unroll
        for (int pf = 0; pf < 4; ++pf) y[r][pf] = y[r][pf] * sd;
#pragma unroll
        for (int sf = 0; sf < 8; ++sf) { const f32x4 as = *(const LAS f32x4*)(acs + r * 128 + sf * 16 + fq * 4); float mv[4];
#pragma unroll
            for (int jj = 0; jj < 4; ++jj) { const int s = sf * 16 + fq * 4 + jj; mv[jj] = (s <= l) ? sacc[sf][jj] * __expf(fminf(al - as[jj], 0.f)) : 0.f; }
            u32x2 w; w.x = cvt_pk_bf16(mv[0], mv[1]); w.y = cvt_pk_bf16(mv[2], mv[3]);
            *(LAS u32x2*)(lds + L_M + fr * LP + (sf * 16 + fq * 4) * 2) = w; }
        asm volatile("" ::: "memory");
        const int jd = (l & 31) - fq * 8;
        const unsigned dbits = cvt_pk_bf16(a.in[I_DSKIP][4 * g + r] / dtv[r * 128 + l], 0.f) & 0xffffu;
        bf16x8 dg;
#pragma unroll
        for (int j = 0; j < 8; ++j) dg[j] = (short)((j == jd) ? dbits : 0u);
#pragma unroll
        for (int ks = 0; ks < 4; ++ks) {
            const bf16x8 mf = LFRAG(L_M, fr, ks * 32 + fq * 8);
#pragma unroll
            for (int pf = 0; pf < 4; ++pf) {
                const bf16x8 xf = LFRAG(L_XT, r * 64 + pf * 16 + fr, ks * 32 + fq * 8);
                y[r][pf] = MFMA16(xf, mf, y[r][pf]);
            }
        }
#pragma unroll
        for (int pf = 0; pf < 4; ++pf) { const bf16x8 xd = LFRAG(L_XT, r * 64 + pf * 16 + fr, (wave >> 1) * 32 + fq * 8); y[r][pf] = MFMA16(xd, dg, y[r][pf]); }
        asm volatile("" ::: "memory");
    }
    const size_t tok = (size_t)(T0 + l);
    const bf16_t* Zp = (const bf16_t*)(a.ws + WS_Z) + tok * 1024 + g * 256;
    float ssq = 0.f;
#pragma unroll
    for (int r = 0; r < 4; ++r) {
#pragma unroll
        for (int q = 0; q < 2; ++q) {
            const u32x4 zz = *(const u32x4*)(Zp + r * 64 + 32 * q + 8 * fq);
            const float zf[8] = {bf_lo(zz.x), bf_hi(zz.x), bf_lo(zz.y), bf_hi(zz.y), bf_lo(zz.z), bf_hi(zz.z), bf_lo(zz.w), bf_hi(zz.w)};
#pragma unroll
            for (int h2 = 0; h2 < 2; ++h2) { const int pf = 2 * q + h2;
#pragma unroll
                for (int jj = 0; jj < 4; ++jj) {
                    const float v = y[r][pf][jj] * siluf(zf[h2 * 4 + jj]);
                    y[r][pf][jj] = v; ssq += v * v;
                } }
        }
    }
    ssq += __shfl_xor(ssq, 16); ssq += __shfl_xor(ssq, 32);
    const float rstd = rsqrtf(ssq * (1.f / 256.f) + EPS);
    bf16_t* Yp = (bf16_t*)(a.ws + WS_U) + tok * 1024 + g * 256;
#pragma unroll
    for (int r = 0; r < 4; ++r)
#pragma unroll
        for (int q = 0; q < 2; ++q) { const int ch = r * 64 + 32 * q + 8 * fq; const f32x4 n0 = *(const LAS f32x4*)(lds + L_NW + ch * 4), n1 = *(const LAS f32x4*)(lds + L_NW + (ch + 4) * 4);
            const f32x4 v0 = y[r][2 * q], v1 = y[r][2 * q + 1];
            u32x4 w; w.x = cvt_pk_bf16(v0[0] * rstd * n0.x, v0[1] * rstd * n0.y); w.y = cvt_pk_bf16(v0[2] * rstd * n0.z, v0[3] * rstd * n0.w);
            w.z = cvt_pk_bf16(v1[0] * rstd * n1.x, v1[1] * rstd * n1.y); w.w = cvt_pk_bf16(v1[2] * rstd * n1.z, v1[3] * rstd * n1.w);
            *(u32x4*)(Yp + ch) = w; }
}


#define XB_TMO      128
#define XB_XCNT(j)  (256  + 64 * (j))
#define XB_XSUB(j)  (1280 + 64 * (j))
#define XB_XGEN(j)  (2304 + 64 * (j))
#define XB_TOP      3328
#define XB_TOPGEN   3392
#define XCD_BAR_WORDS 3456
#define XB_SPIN_CAP (1u << 18)
__device__ __forceinline__ unsigned xb_ld(unsigned* p)              { return __hip_atomic_load(p, __ATOMIC_RELAXED, __HIP_MEMORY_SCOPE_AGENT); }
__device__ __forceinline__ unsigned xb_add(unsigned* p, unsigned v) { return __hip_atomic_fetch_add(p, v, __ATOMIC_RELAXED, __HIP_MEMORY_SCOPE_AGENT); }
__device__ __forceinline__ unsigned xb_xcc_id() { return (unsigned)__builtin_amdgcn_s_getreg((3 << 11) | 20) & 0xFu; }
#define XB_SPIN(cond, bar) do { unsigned _sp = 0; while (cond) { __builtin_amdgcn_s_sleep(1); \
    if ((++_sp & 255u) == 0u) { if (xb_ld(&(bar)[XB_TMO])) break; if (_sp > XB_SPIN_CAP) { atomicAdd(&(bar)[XB_TMO], 1u); break; } } } } while (0)
struct XcdBarrier { unsigned* bar; unsigned x; volatile LAS unsigned* st; };
__device__ __forceinline__ XcdBarrier xcd_barrier_post(unsigned* bar, volatile LAS unsigned* st) {
    XcdBarrier b; b.bar = bar; b.x = xb_xcc_id(); b.st = st;
    if (threadIdx.x == 0) (void)xb_add(&bar[XB_XCNT(b.x)], 1u);
    return b;
}
__device__ __forceinline__ void xcd_barrier_complete(unsigned* bar, unsigned x, unsigned& nloc, unsigned& nx) {
    const unsigned G = gridDim.x * gridDim.y * gridDim.z;
    unsigned sum, cnt, mine, sp = 0u;
    for (;;) {
        sum = 0u; cnt = 0u; mine = 0u;
#pragma unroll
        for (unsigned j = 0; j < 16; ++j) { const unsigned c = xb_ld(&bar[XB_XCNT(j)]); sum += c; cnt += (c > 0u) ? 1u : 0u; mine = (j == x) ? c : mine; }
        if (sum == G) break;
        __builtin_amdgcn_s_sleep(1);
        if ((++sp & 255u) == 0u) { if (xb_ld(&bar[XB_TMO])) break; if (sp > XB_SPIN_CAP) { atomicAdd(&bar[XB_TMO], 1u); break; } }
    }
    nloc = mine > 0u ? mine : 1u; nx = cnt > 0u ? cnt : 1u;
}
__device__ __forceinline__ void xcd_barrier(const XcdBarrier& b) {
    asm volatile("s_waitcnt vmcnt(0)" ::: "memory");
    __syncthreads();
    if (threadIdx.x == 0) {
        unsigned* bar = b.bar;
        __builtin_amdgcn_s_waitcnt(0);
        unsigned nloc = b.st[0], nx = b.st[1];
        if (nloc == 0u) { xcd_barrier_complete(bar, b.x, nloc, nx); b.st[0] = nloc; b.st[1] = nx; }
        const unsigned old = xb_add(&bar[XB_XSUB(b.x)], 1u);
        const unsigned gen = old / nloc;
        if (old + 1u == (gen + 1u) * nloc) {
            __builtin_amdgcn_fence(__ATOMIC_RELEASE, "agent");
            asm volatile("s_waitcnt vmcnt(0)" ::: "memory");
            const unsigned og = xb_add(&bar[XB_TOP], 1u);
            const unsigned tg = og / nx;
            if (og + 1u == (tg + 1u) * nx) xb_add(&bar[XB_TOPGEN], 1u);
            else XB_SPIN(xb_ld(&bar[XB_TOPGEN]) == tg, bar);
            __builtin_amdgcn_fence(__ATOMIC_ACQUIRE, "agent");
            xb_add(&bar[XB_XGEN(b.x)], 1u);
            asm volatile("s_waitcnt vmcnt(0)" ::: "memory");
        } else {
            XB_SPIN(xb_ld(&bar[XB_XGEN(b.x)]) == gen, bar);
            __builtin_amdgcn_fence(__ATOMIC_ACQUIRE, "agent");
            asm volatile("s_waitcnt vmcnt(0)" ::: "memory");
        }
    }
    __syncthreads();
}

__global__ void __launch_bounds__(NTHREADS, 2) fwd_megakernel(Args a) {
    extern __shared__ __attribute__((aligned(16))) unsigned char lds_raw[];
    LAS unsigned char* lds = (LAS unsigned char*)lds_raw;
    cg::grid_group grid = cg::this_grid();
    const int G = gridDim.x;
#define PH_IDS() int tid = threadIdx.x; asm volatile("" : "+v"(tid)); const int lane = tid & 63, wave = __builtin_amdgcn_readfirstlane(tid >> 6); (void)lane; (void)wave
    unsigned char* ws = a.ws;
    const float* mod = (const float*)(ws + WS_MOD);
    bf16_t* H = (bf16_t*)((unsigned char*)a.out + DO_H);
    bf16_t* XRB = (bf16_t*)(ws + WS_XR);
    const int lo = a.ph_lo, hi = a.ph_hi;
#ifndef ONLYPH
#define ONLYPH -1
#endif
#define IN(k) ((ONLYPH < 0 || ONLYPH == (k)) && lo <= (k) && (k) < hi)
    volatile LAS unsigned* bst = (volatile LAS unsigned*)(lds + LDS_BYTES - 64);
    if (threadIdx.x < 16) bst[threadIdx.x] = 0u;
    __syncthreads();
    XcdBarrier xbar = xcd_barrier_post((unsigned*)(ws + WS_BAR), bst);
    if (a.ph_hi > 1000) grid.sync();
#ifndef PROBE_PH
#define PROBE_PH -1
#endif
    volatile LAS unsigned long long* stamps = (volatile LAS unsigned long long*)(lds + LDS_BYTES - 512);
    int nstamp = 0;
#define STAMP() do { if (PROBE_PH >= 0 && threadIdx.x == 0) stamps[nstamp] = __builtin_amdgcn_s_memrealtime(); ++nstamp; } while (0)
    STAMP();
#ifdef SUB5
#define SUB5STAMP() STAMP()
#else
#define SUB5STAMP() do {} while (0)
#endif
#ifdef SUBPROBE
#define SUBSTAMP() STAMP()
#else
#define SUBSTAMP() do {} while (0)
#endif
#define SEAM(k) do { if (IN(k) && IN((k) + 1)) xcd_barrier(xbar); STAMP(); } while (0)
#ifndef DUP_MASK
#define DUP_MASK 0
#endif
#define REP(k) for (int rep_ = 0; rep_ < (((DUP_MASK >> (k)) & 1) ? 2 : 1); ++rep_, (rep_ < (((DUP_MASK >> (k)) & 1) ? 2 : 1) ? xcd_barrier(xbar) : (void)0))

    if (IN(0)) REP(0) { PH_IDS(); p0_phase(a, lds, tid, lane, wave, G, 1); SUBSTAMP(); p0_phase(a, lds, tid, lane, wave, G, 2); SUBSTAMP(); p0_phase(a, lds, tid, lane, wave, G, 4); SUBSTAMP();
        norm_phase<false>(lds, a.in[I_X], a.in[I_N1], mod, 0 * D, 1 * D, H, nullptr, nullptr, nullptr, tid, lane, wave, G); }
    SEAM(0);
    if (IN(2)) REP(2) { pg8::Gemm g{H, H, (const bf16_t*)(ws + WS_WGU1), M, 2 * FF, D, D, D, 1 << 30, 0}; pg8::StaticOrder S; S.init(M, 2 * FF, G, blockIdx.x, WGM_FF);
        pg8::EpiSwiGLU E{(bf16_t*)(ws + WS_ACT)}; pg8::gemm_phase(lds, g, S, E);
        { const int nidle = G - (S.nwg % G); PH_IDS();
          if ((S.nwg % G) != 0 && (int)blockIdx.x >= G - nidle) p0_transposes(a, lds, 1, ((int)blockIdx.x - (G - nidle)) * NWAVES + wave, nidle * NWAVES, lane, wave);
          else if ((S.nwg % G) == 0) p0_transposes(a, lds, 1, blockIdx.x * NWAVES + wave, G * NWAVES, lane, wave); } }
    SEAM(2);
    if (IN(3)) REP(3) { pg8::Gemm g{(const bf16_t*)(ws + WS_ACT), (const bf16_t*)(ws + WS_ACT), (const bf16_t*)(ws + WS_WD1), M, D, FF, FF, FF, 1 << 30, 0}; pg8::StaticOrder S; S.init(M, D, G, blockIdx.x, WGM_N1K);
        pg8::EpiResidNorm<true, false> E{a.in[I_X], XRB, mod + 2 * D, a.in[I_NMIX], mod + 3 * D, mod + 4 * D, H, nullptr, (float*)(ws + WS_SSQ), (unsigned*)(ws + WS_CNT), nullptr}; pg8::gemm_phase(lds, g, S, E); }
    SEAM(3);
    if (IN(5)) REP(5) { pg8::Gemm g{H, H, (const bf16_t*)(ws + WS_WIN), M, NPROJ, D, D, D, 1 << 30, 0}; pg8::StaticOrder S; S.init(M, NPROJ, G, blockIdx.x, WGM_IN);
        pg8::EpiSplit E{(bf16_t*)(ws + WS_Z), (bf16_t*)(ws + WS_XBC), (bf16_t*)(ws + WS_U)}; pg8::gemm_phase(lds, g, S, E); SUB5STAMP();
        { PH_IDS(); dt_tail(lds, H, (const bf16_t*)(ws + WS_WDT), a.in[I_DTB], (float*)(ws + WS_DT), G, wave, lane); } }
    SEAM(5);
    if (IN(6)) REP(6) { PH_IDS();
        for (int it = blockIdx.x; it < BATCH * NCHUNK * 4; it += G) ssd_states_item(a, lds, it, tid, lane, wave);
        for (int it = blockIdx.x; it < M / 32; it += G) diff_item((const bf16_t*)(ws + WS_U), H, it, lane, wave);
    }
    SEAM(6);
    if (IN(7)) REP(7) { PH_IDS();
        scan_phase(a, lds, tid, G);
        __syncthreads();
        {
        pg8::Gemm g{(const bf16_t*)(ws + WS_WOUT) + 1024, (const bf16_t*)(ws + WS_WOUT) + 1024, (const bf16_t*)(ws + WS_WPOOL), 1024, 1024, 256, 2048, 256, 1 << 30, 256}; pg8::StaticOrder S; S.init(1024, 1024, G, blockIdx.x);
        pg8::EpiFold E{(bf16_t*)(ws + WS_WOUT)}; pg8::gemm_phase(lds, g, S, E);
        }
    }
    SEAM(7);
    if (IN(8)) REP(8) { PH_IDS(); for (int it = blockIdx.x; it < BATCH * NCHUNK * 4; it += G) ssd_out_item(a, lds, it, tid, lane, wave); }
    SEAM(8);
    if (IN(9)) REP(9) { __syncthreads();
        pg8::Gemm g{(const bf16_t*)(ws + WS_U), H, (const bf16_t*)(ws + WS_WOUT), M, D, 2048, 1024, 2048, 16, 0}; pg8::StaticOrder S; S.init(M, D, G, blockIdx.x, WGM_N1K);
        pg8::EpiResidNorm<false, true> E{XRB, XRB, mod + 5 * D, a.in[I_N2], mod + 6 * D, mod + 7 * D, H, nullptr, (float*)(ws + WS_SSQ) + 1 * M * 4, (unsigned*)(ws + WS_CNT) + 1 * 64 * 64, (const float*)(ws + WS_BVEC)}; pg8::gemm_phase(lds, g, S, E); }
    SEAM(9);
    if (IN(11)) REP(11) { pg8::Gemm g{H, H, (const bf16_t*)(ws + WS_WGU2), M, 2 * FF, D, D, D, 1 << 30, 0}; pg8::StaticOrder S; S.init(M, 2 * FF, G, blockIdx.x, WGM_FF);
        pg8::EpiSwiGLU E{(bf16_t*)(ws + WS_ACT)}; pg8::gemm_phase(lds, g, S, E); }
    SEAM(11);
    if (IN(12)) REP(12) { pg8::Gemm g{(const bf16_t*)(ws + WS_ACT), (const bf16_t*)(ws + WS_ACT), (const bf16_t*)(ws + WS_WD2), M, D, FF, FF, FF, 1 << 30, 0}; pg8::StaticOrder S; S.init(M, D, G, blockIdx.x, WGM_N1K);
        pg8::EpiResidNorm<true, true> E{XRB, nullptr, mod + 8 * D, a.in[I_NF], nullptr, nullptr, nullptr, a.out, (float*)(ws + WS_SSQ) + 2 * M * 4, (unsigned*)(ws + WS_CNT) + 2 * 64 * 64, nullptr}; pg8::gemm_phase(lds, g, S, E); }
    STAMP();
    if (PROBE_PH >= 0 && blockIdx.x == 0 && threadIdx.x == 0) {
        const unsigned long long span = stamps[PROBE_PH + 1] - stamps[PROBE_PH], t0 = __builtin_amdgcn_s_memrealtime();
        while (__builtin_amdgcn_s_memrealtime() - t0 < 4ull * span) __builtin_amdgcn_s_sleep(8);
    }
#undef IN
#undef SEAM
}


#ifndef DBG_K
#define DBG_K -1
#endif
__global__ void dbg_dump(float* out, const void* src, int mode, int nch) {
    for (size_t i = (size_t)blockIdx.x * blockDim.x + threadIdx.x; i < (size_t)M * 1024; i += (size_t)gridDim.x * blockDim.x) {
        float v = 0.f;
        if (mode == 0) v = ((const float*)src)[i];
        else if (mode == 2) v = __uint_as_float((unsigned)((const bf16_t*)src)[i + (size_t)M * 1024] << 16);
        else for (int j = 0; j < nch; ++j) v += __uint_as_float((unsigned)((const bf16_t*)src)[i + (size_t)j * M * 1024] << 16);
        out[i] = v;
    }
}
extern "C" void kernel_launch(void* const* d_in, const int* in_sizes, int n_in, void* d_out, int out_size, void* d_ws, size_t ws_size, hipStream_t stream) {
    static int grid_blocks = 0;
    if (grid_blocks == 0) {
        int dev = 0, cus = 0, per_cu = 0;
        (void)hipGetDevice(&dev);
        (void)hipDeviceGetAttribute(&cus, hipDeviceAttributeMultiprocessorCount, dev);
        if (hipFuncSetAttribute((const void*)fwd_megakernel, hipFuncAttributeMaxDynamicSharedMemorySize, LDS_BYTES) != hipSuccess) { fprintf(stderr, "hipFuncSetAttribute failed\n"); grid_blocks = -1; return; }
        if (hipOccupancyMaxActiveBlocksPerMultiprocessor(&per_cu, (const void*)fwd_megakernel, NTHREADS, LDS_BYTES) != hipSuccess || per_cu < 1) { fprintf(stderr, "occupancy query: %d blocks/CU\n", per_cu); grid_blocks = -1; return; }
        grid_blocks = cus;
        if (n_in != 25 || ws_size < WS_END) { fprintf(stderr, "unexpected problem: n_in %d ws %zu\n", n_in, ws_size); grid_blocks = -1; return; }
    }
    if (grid_blocks < 0) return;
    Args a{};
    for (int i = 0; i < 25; ++i) a.in[i] = (const float*)d_in[i];
    a.out = (float*)d_out; a.ws = (unsigned char*)d_ws;
    (void)hipMemsetAsync((unsigned char*)d_ws + WS_BAR, 0, BAR_BYTES, stream);
#ifndef MK_PER_PHASE
#define MK_PER_PHASE 0
#endif
#if MK_PER_PHASE
    const int kmax = (DBG_K >= 0) ? DBG_K : 13;
    for (int k = 0; k <= kmax; ++k) { a.ph_lo = k; a.ph_hi = k + 1; hipLaunchKernelGGL(fwd_megakernel, dim3(grid_blocks), dim3(NTHREADS), LDS_BYTES, stream, a); }
    if (DBG_K >= 0) {
        const unsigned char* ws = (const unsigned char*)d_ws; const void* src = ws + WS_XR; int mode = 0, nch = 1;
        if (DBG_K == 5) { src = ws + WS_Z; mode = 1; nch = 4; }
        if (DBG_K == 2) { src = ws + WS_ACT; mode = 1; nch = 2; }
        if (DBG_K == 6) { src = (const unsigned char*)d_out; mode = 2; nch = 1; }
        if (DBG_K == 7) { src = ws + WS_YPOOL; mode = 1; nch = 1; }
        if (DBG_K == 8) { src = d_out; mode = 1; nch = 1; }
        if (DBG_K == 1) { src = d_out; mode = 1; nch = 1; }
        if (DBG_K == 4) { src = ws + WS_DT; mode = 0; nch = 1; }
        if (src == (const void*)d_out) { (void)hipMemcpyAsync((unsigned char*)d_ws + WS_XR, d_out, 64 * MiB, hipMemcpyDeviceToDevice, stream); src = ws + WS_XR; }
        hipLaunchKernelGGL(dbg_dump, dim3(2048), dim3(256), 0, stream, (float*)d_out, src, mode, nch);
    }
#else
    a.ph_lo = 0; a.ph_hi = 14;
    void* args[] = {&a};
    hipError_t e = hipLaunchCooperativeKernel((const void*)fwd_megakernel, dim3(grid_blocks), dim3(NTHREADS), args, LDS_BYTES, stream);
    if (e != hipSuccess) fprintf(stderr, "cooperative launch failed: %s (grid %d)\n", hipGetErrorString(e), grid_blocks);
#endif
}
```
